# Optimizing an MI355X kernel written in HIP

```python
import jax, jax.numpy as jnp
from jax import lax
import numpy as np

D_MODEL = 2048
BATCH = 2
SEQ = 16384
DEPTH = 1

N_META = 16
GRID_W = 64
HEAD_DIM = 128
N_Q_HEADS = 8
N_KV_HEADS = 2
Q_PER_KV = N_Q_HEADS // N_KV_HEADS
ATTN_WIDTH = N_Q_HEADS * HEAD_DIM
KV_WIDTH = N_KV_HEADS * HEAD_DIM
MIX_WIDTH = D_MODEL
POOL_WIDTH = MIX_WIDTH - ATTN_WIDTH
POOL_WINDOWS = (2, 4, 8, 16)
N_POOL_GROUPS = len(POOL_WINDOWS)
POOL_GROUP = POOL_WIDTH // N_POOL_GROUPS
IN_WIDTH = ATTN_WIDTH + 2 * KV_WIDTH + POOL_WIDTH
Q_BLOCK = 128
ROPE_THETA = 10000.0
ROPE_AXIS_DIM = HEAD_DIM // 2
N_EXPERT_GROUPS = 4
EXPERTS_PER_GROUP = 8
N_EXPERTS = N_EXPERT_GROUPS * EXPERTS_PER_GROUP
TOP_K = 2
D_EXPERT = D_MODEL // 4
EXPERT_BLOCK = 128
EPS = 1e-6

kernel_name = "hymba_pool_axialgqa_hiermoe_encoder"


def _rms_norm(x, g):
    xf = x.astype(jnp.float32)
    y = xf * lax.rsqrt(jnp.mean(xf * xf, axis=-1, keepdims=True) + EPS)
    return (y * g.astype(jnp.float32)).astype(x.dtype)


def _axial_angles(n_tok):
    rows = n_tok // GRID_W
    t = jnp.arange(rows * GRID_W)
    zeros = jnp.zeros((N_META,), jnp.float32)
    row = jnp.concatenate([zeros, (t // GRID_W).astype(jnp.float32)])
    col = jnp.concatenate([zeros, (t % GRID_W).astype(jnp.float32)])
    inv_freq = jnp.power(ROPE_THETA, -jnp.arange(0, ROPE_AXIS_DIM, 2, dtype=jnp.float32) / ROPE_AXIS_DIM)
    ang_r = row[:, None] * inv_freq[None, :]
    ang_c = col[:, None] * inv_freq[None, :]
    return jnp.cos(ang_r), jnp.sin(ang_r), jnp.cos(ang_c), jnp.sin(ang_c)


def _rotate(x, cos, sin):
    half = x.shape[-1] // 2
    x1, x2 = x[..., :half], x[..., half:]
    c = cos[None, :, None, :]
    s = sin[None, :, None, :]
    return jnp.concatenate([x1 * c - x2 * s, x2 * c + x1 * s], axis=-1)


def _axial_rope(x, rope):
    cr, sr, cc, sc = rope
    xf = x.astype(jnp.float32)
    out = jnp.concatenate([_rotate(xf[..., :ROPE_AXIS_DIM], cr, sr),
                           _rotate(xf[..., ROPE_AXIS_DIM:], cc, sc)], axis=-1)
    return out.astype(x.dtype)


def _axial_gqa(q, k, v, q_g, k_g, rope):
    B, L, _ = q.shape
    q = _axial_rope(_rms_norm(q.reshape(B, L, N_Q_HEADS, HEAD_DIM), q_g), rope)
    k = _axial_rope(_rms_norm(k.reshape(B, L, N_KV_HEADS, HEAD_DIM), k_g), rope)
    v = v.reshape(B, L, N_KV_HEADS, HEAD_DIM)
    n_blk = -(-L // Q_BLOCK)
    Lp = n_blk * Q_BLOCK
    q = jnp.pad(q, ((0, 0), (0, Lp - L), (0, 0), (0, 0)))
    qb = q.reshape(B, n_blk, Q_BLOCK, N_KV_HEADS, Q_PER_KV, HEAD_DIM).transpose(1, 0, 2, 3, 4, 5)
    scale = HEAD_DIM ** -0.5

    def block(q_blk):
        s = jnp.einsum('bqkgd,bskd->bkgqs', q_blk, k).astype(jnp.float32) * scale
        p = jax.nn.softmax(s, axis=-1).astype(v.dtype)
        return jnp.einsum('bkgqs,bskd->bqkgd', p, v)

    o = lax.map(block, qb)
    o = o.transpose(1, 0, 2, 3, 4, 5).reshape(B, Lp, ATTN_WIDTH)
    return o[:, :L]


def _multiscale_pool(p, w, scale):
    B, L, C = p.shape
    pf = p.astype(jnp.float32)
    cs = jnp.pad(jnp.cumsum(pf, axis=1), ((0, 0), (1, 0), (0, 0)))
    t = jnp.arange(L)
    outs = []
    for gi, win in enumerate(POOL_WINDOWS):
        lo_c, hi_c = gi * POOL_GROUP, (gi + 1) * POOL_GROUP
        lo = jnp.clip(t - win // 2, 0, L)
        hi = jnp.clip(t - win // 2 + win, 0, L)
        csg = cs[:, :, lo_c:hi_c]
        mean = (csg[:, hi] - csg[:, lo]) / (hi - lo).astype(jnp.float32)[None, :, None]
        outs.append(mean - pf[:, :, lo_c:hi_c])
    m = jnp.stack(outs, axis=2).astype(p.dtype)
    y = jnp.einsum('blgc,gcd->blgd', m, w).reshape(B, L, C)
    return y * scale


def _hier_moe(xs, w_rg, b_rg, w_re, b_re, w_gate, w_up, w_down):
    N, D = xs.shape
    g_prob = jax.nn.softmax((xs @ w_rg).astype(jnp.float32) + b_rg.astype(jnp.float32), axis=-1)
    g_p, g_idx = lax.top_k(g_prob, 1)
    e_logits = ((xs @ w_re).astype(jnp.float32) + b_re.astype(jnp.float32)).reshape(N, N_EXPERT_GROUPS, EXPERTS_PER_GROUP)
    sel = jnp.broadcast_to(g_idx[:, :, None], (N, 1, EXPERTS_PER_GROUP))
    e_prob = jax.nn.softmax(jnp.take_along_axis(e_logits, sel, axis=1)[:, 0], axis=-1)
    e_p, e_idx = lax.top_k(e_prob, TOP_K)
    gates = g_p * (e_p / jnp.sum(e_p, axis=-1, keepdims=True))
    expert = g_idx * EXPERTS_PER_GROUP + e_idx

    M = N * TOP_K
    flat_e = expert.reshape(-1)
    flat_g = gates.reshape(-1)
    flat_t = jnp.repeat(jnp.arange(N, dtype=jnp.int32), TOP_K)
    order = jnp.argsort(flat_e)
    s_e, s_t, s_g = flat_e[order], flat_t[order], flat_g[order]
    counts = jnp.bincount(flat_e, length=N_EXPERTS)
    starts = jnp.cumsum(counts) - counts
    padded = (counts + EXPERT_BLOCK - 1) // EXPERT_BLOCK * EXPERT_BLOCK
    pstarts = jnp.cumsum(padded) - padded
    pends = pstarts + padded
    dest = pstarts[s_e] + (jnp.arange(M) - starts[s_e])
    P = (-(-M // EXPERT_BLOCK) + N_EXPERTS) * EXPERT_BLOCK
    n_blk = P // EXPERT_BLOCK
    slot_t = jnp.zeros((P,), jnp.int32).at[dest].set(s_t)
    slot_g = jnp.zeros((P,), jnp.float32).at[dest].set(s_g)
    blk_start = jnp.arange(n_blk) * EXPERT_BLOCK
    blk_e = jnp.minimum(jnp.sum(pends[None, :] <= blk_start[:, None], axis=1), N_EXPERTS - 1)

    def expert_block(args):
        tok, g, e = args
        xb = xs[tok]
        h = jax.nn.silu(xb @ w_gate[e]) * (xb @ w_up[e])
        return (h @ w_down[e]) * g[:, None].astype(xs.dtype)

    out = lax.map(expert_block, (slot_t.reshape(n_blk, EXPERT_BLOCK),
                                 slot_g.reshape(n_blk, EXPERT_BLOCK), blk_e))
    return jnp.zeros_like(xs).at[slot_t].add(out.reshape(P, D))


def setup_inputs(seed: int = 0) -> dict:
    key = jax.random.key(seed)
    ks = jax.random.split(key, 20)
    f = jnp.float32
    nrm = lambda k, shape, s: jax.random.normal(k, shape, f) * s
    return {
        "x": nrm(ks[0], (BATCH, SEQ, D_MODEL), 1.0),
        "meta_tokens": nrm(ks[1], (N_META, D_MODEL), 1.0),
        "norm1_g": 1.0 + nrm(ks[2], (DEPTH, D_MODEL), 0.02),
        "w_in": nrm(ks[3], (DEPTH, D_MODEL, IN_WIDTH), D_MODEL ** -0.5),
        "q_norm_g": 1.0 + nrm(ks[4], (DEPTH, HEAD_DIM), 0.02),
        "k_norm_g": 1.0 + nrm(ks[5], (DEPTH, HEAD_DIM), 0.02),
        "pool_w": nrm(ks[6], (DEPTH, N_POOL_GROUPS, POOL_GROUP, POOL_GROUP), POOL_GROUP ** -0.5),
        "pool_scale": 1.0 + nrm(ks[7], (DEPTH, POOL_WIDTH), 0.02),
        "w_out": nrm(ks[8], (DEPTH, MIX_WIDTH, D_MODEL), MIX_WIDTH ** -0.5),
        "norm2_g": 1.0 + nrm(ks[9], (DEPTH, D_MODEL), 0.02),
        "w_router_group": nrm(ks[10], (DEPTH, D_MODEL, N_EXPERT_GROUPS), D_MODEL ** -0.5),
        "b_router_group": nrm(ks[11], (DEPTH, N_EXPERT_GROUPS), 0.01),
        "w_router_expert": nrm(ks[12], (DEPTH, D_MODEL, N_EXPERTS), D_MODEL ** -0.5),
        "b_router_expert": nrm(ks[13], (DEPTH, N_EXPERTS), 0.01),
        "w_gate": nrm(ks[14], (DEPTH, N_EXPERTS, D_MODEL, D_EXPERT), D_MODEL ** -0.5),
        "w_up": nrm(ks[15], (DEPTH, N_EXPERTS, D_MODEL, D_EXPERT), D_MODEL ** -0.5),
        "w_down": nrm(ks[16], (DEPTH, N_EXPERTS, D_EXPERT, D_MODEL), D_EXPERT ** -0.5),
    }


def reference(x, meta_tokens, norm1_g, w_in, q_norm_g, k_norm_g, pool_w, pool_scale, w_out,
              norm2_g, w_router_group, b_router_group, w_router_expert, b_router_expert,
              w_gate, w_up, w_down):
    B, S, D = x.shape
    meta = jnp.broadcast_to(meta_tokens[None].astype(x.dtype), (B, N_META, D))
    h = jnp.concatenate([meta, x], axis=1)
    L = h.shape[1]
    rope = _axial_angles(S)
    q_end = ATTN_WIDTH
    k_end = q_end + KV_WIDTH
    v_end = k_end + KV_WIDTH
    for l in range(DEPTH):
        a = _rms_norm(h, norm1_g[l])
        proj = a @ w_in[l]
        attn = _axial_gqa(proj[..., :q_end], proj[..., q_end:k_end], proj[..., k_end:v_end],
                          q_norm_g[l], k_norm_g[l], rope)
        pool = _multiscale_pool(proj[..., v_end:], pool_w[l], pool_scale[l])
        h = h + jnp.concatenate([attn, pool], axis=-1) @ w_out[l]
        b = _rms_norm(h, norm2_g[l]).reshape(B * L, D)
        h = h + _hier_moe(b, w_router_group[l], b_router_group[l], w_router_expert[l],
                          b_router_expert[l], w_gate[l], w_up[l], w_down[l]).reshape(B, L, D)
    return h[:, N_META:]
```

```cpp
#include <hip/hip_runtime.h>
#include <hip/hip_bf16.h>
#include <cstdio>
#include <cstdint>
#include <cmath>

#ifndef MK_N_LAUNCHES
#define MK_N_LAUNCHES 1
#endif
constexpr int PER_PHASE = 8;
#ifndef ATT_MODE
#define ATT_MODE 1
#endif
#ifndef PROBE_REPS
#define PROBE_REPS {1,1,1,1,1,1,1,1}
#endif
constexpr int REPS[8] = PROBE_REPS;
constexpr int N_LAUNCHES = MK_N_LAUNCHES;

#define LAS __attribute__((address_space(3)))
#define GAS __attribute__((address_space(1)))
typedef unsigned short bf16_t;
typedef short bf16x8 __attribute__((ext_vector_type(8)));
typedef short s16x4 __attribute__((ext_vector_type(4)));
typedef float f32x2 __attribute__((ext_vector_type(2)));
typedef float f32x4 __attribute__((ext_vector_type(4)));
typedef float f32x8 __attribute__((ext_vector_type(8)));
typedef float f32x16 __attribute__((ext_vector_type(16)));
typedef unsigned u32x2 __attribute__((ext_vector_type(2)));
typedef unsigned u32x4 __attribute__((ext_vector_type(4)));
typedef GAS unsigned gu32;

constexpr int BATCH = 2, SEQ = 16384, DM = 2048, NTOK = BATCH * SEQ;
constexpr int NMETA = 16, HD = 128, NQH = 8, NKVH = 2;
constexpr int ATTW = 1024, KVW = 256, POOLW = 1024, INW = 2560;
constexpr int NEXP = 32, DEXP = 512;
constexpr int KVROWS = 64 + SEQ;
constexpr int NT_ATT = KVROWS / 64;
constexpr float EPS = 1e-6f;
constexpr int LCAP = NTOK;
constexpr int NLIST = 2 * NEXP;
constexpr int HROWS = 2 * NTOK + NLIST * 256;

constexpr size_t MiB = 1u << 20;
constexpr size_t WS_CTL = 0, CTL_ZERO_BYTES = 1 * MiB;
constexpr size_t WS_ROPE = 1 * MiB;
constexpr size_t WS_PMETA = 1 * MiB + 64 * 1024;
constexpr size_t WS_WRF = 1 * MiB + 128 * 1024;
constexpr size_t WS_ZM = 1 * MiB + 512 * 1024;
constexpr size_t WS_WIN = 2 * MiB;
constexpr size_t WS_WOUT = 12 * MiB;
constexpr size_t WS_WGU = 20 * MiB;
constexpr size_t WS_WD = 148 * MiB;
constexpr size_t WS_XN = 212 * MiB;
constexpr size_t WS_Q = 340 * MiB;
constexpr size_t WS_K = 404 * MiB;
constexpr size_t WS_V = 421 * MiB;
constexpr size_t WS_Z = 438 * MiB;
constexpr size_t WS_MIX = 502 * MiB;
constexpr size_t WS_SSP = 630 * MiB;
constexpr size_t WS_LIST = 634 * MiB;
constexpr size_t WS_GLIST = 642 * MiB;
constexpr size_t WS_H = 650 * MiB;
constexpr size_t WS_Q8 = 730 * MiB;
constexpr size_t WS_K8 = 762 * MiB;
constexpr size_t WS_V8 = 771 * MiB;
constexpr size_t WS_MIX2 = 780 * MiB;
constexpr size_t WS_END = 844 * MiB;
static_assert(WS_K + (size_t)4 * KVROWS * 128 * 2 <= WS_V && WS_H + (size_t)HROWS * 512 * 2 <= WS_END, "ws map");
constexpr int CW_TMO = 0, CW_GCNT = 64, CW_CHK = 256, CW_BAR = 4096;

constexpr int RING_OFF = 0, RING_BYTES = 131072;
constexpr int EPI_OFF = RING_BYTES;
constexpr int TAB_OFF = EPI_OFF + 16384;
constexpr int MISC_OFF = TAB_OFF + 4096;
constexpr int LDS_BYTES = MISC_OFF + 512;

#define LDS_WAIT() asm volatile("s_waitcnt lgkmcnt(0)" ::: "memory")
#define VM_WAIT() asm volatile("s_waitcnt vmcnt(0)" ::: "memory")
#define RLX_AGENT __ATOMIC_RELAXED, __HIP_MEMORY_SCOPE_AGENT

__device__ __forceinline__ unsigned cvt_pk_bf16(float lo, float hi) { unsigned r; asm volatile("v_cvt_pk_bf16_f32 %0, %1, %2" : "=v"(r) : "v"(lo), "v"(hi)); return r; }
__device__ __forceinline__ float bf_lo(unsigned w) { return __uint_as_float(w << 16); }
__device__ __forceinline__ float bf_hi(unsigned w) { return __uint_as_float(w & 0xffff0000u); }
__device__ __forceinline__ u32x4 pack8(f32x4 a, f32x4 b) { u32x4 w; w.x = cvt_pk_bf16(a[0], a[1]); w.y = cvt_pk_bf16(a[2], a[3]); w.z = cvt_pk_bf16(b[0], b[1]); w.w = cvt_pk_bf16(b[2], b[3]); return w; }
__device__ __forceinline__ int fresh_lane() { int l = (int)__builtin_amdgcn_mbcnt_hi(~0u, __builtin_amdgcn_mbcnt_lo(~0u, 0u)); asm volatile("" : "+v"(l)); return l; }
__device__ __forceinline__ float wave_sum(float v) {
#pragma unroll
    for (int o = 1; o < 64; o <<= 1) v += __shfl_xor(v, o);
    return v;
}
__device__ __forceinline__ unsigned pk4_fp8(float a, float b, float c, float d) { int w = __builtin_amdgcn_cvt_pk_fp8_f32(a, b, __float_as_int(a), false);
  w = __builtin_amdgcn_cvt_pk_fp8_f32(c, d, w, true); return (unsigned)w; }
__host__ __device__ __forceinline__ int vpos(int kt) { const int kin = kt & 31; return 32 * (kt >> 5) + ((kin & 3) | ((kin >> 3) << 2) | (((kin >> 2) & 1) << 4)); }
__host__ __device__ __forceinline__ int swap45(int d) { return (d & 0x4F) | ((d & 0x20) >> 1) | ((d & 0x10) << 1); }
__host__ __device__ __forceinline__ int permB(int d) { return (d & 0x60) | ((d & 4) << 2) | ((d & 0x18) >> 1) | (d & 3); }
__host__ __device__ __forceinline__ int spos(int d) { return (d & 0x40) | ((d & 0x10) << 1) | ((d & 0x0C) << 1) | ((d & 0x20) >> 3) | (d & 3); }

namespace pg8 {
constexpr int BM = 256, BK = 64, HALF = 128, HTB = HALF * BK * 2, STAGE_BYTES = 8 * HTB, NXCD = 8, WGM = 8;
__host__ __device__ __forceinline__ int lds_byte(int r, int c) { const int st = (r >> 4) * 2 + (c >> 5), rr = r & 15, cc = c & 31, ob = rr * 64 + cc * 2; return st * 1024 + (ob ^ (((ob >> 9) & 1) << 5)); }
__host__ __device__ __forceinline__ void stage_rc(int b, int& R, int& C) { const int st = b / 1024, sb = b % 1024, swz = sb ^ (((sb >> 9) & 1) << 5); R = (st >> 1) * 16 + swz / 64; C = (st & 1) * 32 + (swz % 64) / 2; }

struct UnitMN { int pm, pn; };
struct StaticOrder {
    int nM, nN, nwg, G, c;
    __host__ __device__ void init(int M, int N, int G_, int c_) { nM = M / BM; nN = N / BM; nwg = nM * nN; G = G_; c = c_; }
    __host__ __device__ bool next(int i, UnitMN& u) const {
        const long L = (long)i * G + c; if (L >= nwg) return false;
        int wgid = (int)L; { const int q = nwg / NXCD, r = nwg % NXCD, xcd = wgid % NXCD, off = wgid / NXCD; wgid = (xcd < r ? xcd * (q + 1) : r * (q + 1) + (xcd - r) * q) + off; }
        const int nig = WGM * nN, gid = wgid / nig, fm = gid * WGM, gsz = (nM - fm) < WGM ? (nM - fm) : WGM;
        u.pm = fm + ((wgid % nig) % gsz); u.pn = (wgid % nig) / gsz; return true;
    }
};

template <int K, class Prob>
__device__ __forceinline__ void gemm_phase(LAS unsigned char* lds, LAS unsigned char* les, const Prob& P, int tid) {
    const int wid = __builtin_amdgcn_readfirstlane(tid >> 6), lane = tid & 63, wr = wid >> 2, wc = wid & 3, fr = lane & 15, fq = lane >> 4;
    constexpr int nt = K / BK;
    static_assert(K % 128 == 0 && K >= 256, "K");
    int Rr[2], Cc[2]; unsigned voffB[2];
#pragma unroll
    for (int i = 0; i < 2; ++i) { stage_rc(tid * 16 + i * 8192, Rr[i], Cc[i]); voffB[i] = (unsigned)(Rr[i] * K + Cc[i]) * 2u; }
    constexpr size_t kstep = (size_t)(BK * 2);
    constexpr size_t hstep = (size_t)HALF * K * 2;
    const unsigned ldsw = (unsigned)wid * 1024u;
    const int aoff = lds_byte(wr * 64 + fr, fq * 8), boff = lds_byte(wc * 32 + fr, fq * 8);
#define PG8_SA(b, h) (((b) * 2 + (h)) * HTB)
#define PG8_SB(b, h) ((4 + (b) * 2 + (h)) * HTB)
#define PG8_STAGE(bufoff, gbase, voff) do { _Pragma("unroll") for (int _i = 0; _i < 2; ++_i) \
        __builtin_amdgcn_global_load_lds((const unsigned*)((const char*)(gbase) + (voff)[_i]), (LAS unsigned*)(lds + (bufoff) + ldsw + _i * 8192), 16, 0, 0); } while (0)
#define PG8_LDA(dst, b, h) do { _Pragma("unroll") for (int m = 0; m < 4; ++m) _Pragma("unroll") for (int k = 0; k < 2; ++k) dst[m][k] = *(const LAS bf16x8*)(lds + PG8_SA(b, h) + aoff + m * 2048 + k * 1024); } while (0)
#define PG8_LDB(dst, b, h) do { _Pragma("unroll") for (int n = 0; n < 2; ++n) _Pragma("unroll") for (int k = 0; k < 2; ++k) dst[n][k] = *(const LAS bf16x8*)(lds + PG8_SB(b, h) + boff + n * 2048 + k * 1024); } while (0)
#define PG8_MMA(ai, bj, At, Bt) do { __builtin_amdgcn_s_setprio(1); _Pragma("unroll") for (int m = 0; m < 4; ++m) _Pragma("unroll") for (int n = 0; n < 2; ++n) _Pragma("unroll") for (int k = 0; k < 2; ++k) \
        acc[ai][bj][m][n] = __builtin_amdgcn_mfma_f32_16x16x32_bf16(Bt[n][k], At[m][k], acc[ai][bj][m][n], 0, 0, 0); __builtin_amdgcn_s_setprio(0); } while (0)
#define PG8_WAIT_V(n) asm volatile("s_waitcnt vmcnt(" #n ")" ::: "memory")
#define PG8_WAIT_L(n) asm volatile("s_waitcnt lgkmcnt(" #n ")" ::: "memory")
#define PG8_BAR __builtin_amdgcn_s_barrier()
#define PG8_SCHED __builtin_amdgcn_sched_barrier(0)
    typename Prob::Unit cur, nxt; int ui = 0;
    if (!P.next(0, cur)) return;
    f32x4 acc[2][2][4][2];
#pragma unroll
    for (int a = 0; a < 2; ++a)
#pragma unroll
        for (int b = 0; b < 2; ++b)
#pragma unroll
            for (int m = 0; m < 4; ++m)
#pragma unroll
                for (int n = 0; n < 2; ++n) acc[a][b][m][n] = (f32x4){0.f, 0.f, 0.f, 0.f};
    bf16x8 At[4][2], B0[2][2], B1[2][2];
    unsigned voA[2][2], voN[2][2];
    P.a_offs(cur, Rr, Cc, voA);
    const char* cA = P.a_base(cur); const char* cB = P.b_base(cur);
    PG8_STAGE(PG8_SB(0, 0), cB, voffB); PG8_STAGE(PG8_SB(0, 1), cB + hstep, voffB); PG8_STAGE(PG8_SA(0, 0), cA, voA[0]); PG8_STAGE(PG8_SA(0, 1), cA, voA[1]);
    if (wr == 1) PG8_BAR;
    PG8_WAIT_V(2); PG8_BAR;
    PG8_STAGE(PG8_SB(1, 0), cB + kstep, voffB); PG8_STAGE(PG8_SA(1, 0), cA + kstep, voA[0]); PG8_STAGE(PG8_SB(1, 1), cB + hstep + kstep, voffB);
    PG8_WAIT_V(6); PG8_BAR;
    for (;;) {
        const bool has_next = P.next(ui + 1, nxt);
        const char* nA = cA; const char* nB = cB;
#pragma unroll
        for (int h = 0; h < 2; ++h)
#pragma unroll
            for (int i = 0; i < 2; ++i) voN[h][i] = voA[h][i];
        if (has_next) { nA = P.a_base(nxt); nB = P.b_base(nxt); P.a_offs(nxt, Rr, Cc, voN); }
        for (int t = 0; t < nt; t += 2) {
            const bool last = (t == nt - 2);
            const char* a1 = cA + (size_t)(t + 1) * kstep;
            const char* a2 = last ? nA : cA + (size_t)(t + 2) * kstep; const char* b2 = last ? nB : cB + (size_t)(t + 2) * kstep;
            const char* a3 = a2 + kstep; const char* b3 = b2 + kstep;
            unsigned vo2[2][2];
#pragma unroll
            for (int h = 0; h < 2; ++h)
#pragma unroll
                for (int i = 0; i < 2; ++i) vo2[h][i] = last ? voN[h][i] : voA[h][i];
            PG8_LDB(B0, 0, 0); PG8_LDB(B1, 0, 1); PG8_SCHED; PG8_LDA(At, 0, 0); PG8_STAGE(PG8_SA(1, 1), a1, voA[1]);
            PG8_WAIT_V(8); PG8_WAIT_L(0); PG8_BAR; PG8_MMA(0, 0, At, B0); PG8_MMA(0, 1, At, B1); PG8_BAR; PG8_SCHED;
            PG8_LDA(At, 0, 1); PG8_STAGE(PG8_SB(0, 0), b2, voffB); PG8_STAGE(PG8_SB(0, 1), b2 + hstep, voffB); PG8_STAGE(PG8_SA(0, 0), a2, vo2[0]);
            PG8_WAIT_V(8); PG8_WAIT_L(0); PG8_BAR; PG8_MMA(1, 0, At, B0); PG8_MMA(1, 1, At, B1); PG8_BAR; PG8_SCHED;
            PG8_LDB(B0, 1, 0); PG8_LDB(B1, 1, 1); PG8_SCHED; PG8_LDA(At, 1, 0); PG8_STAGE(PG8_SA(0, 1), a2, vo2[1]);
            PG8_WAIT_V(8); PG8_WAIT_L(0); PG8_BAR; PG8_MMA(0, 0, At, B0); PG8_MMA(0, 1, At, B1); PG8_BAR; PG8_SCHED;
            PG8_LDA(At, 1, 1); PG8_STAGE(PG8_SB(1, 0), b3, voffB); PG8_STAGE(PG8_SB(1, 1), b3 + hstep, voffB); PG8_STAGE(PG8_SA(1, 0), a3, vo2[0]);
            PG8_WAIT_V(8); PG8_WAIT_L(0); PG8_BAR; PG8_MMA(1, 0, At, B0); PG8_MMA(1, 1, At, B1); PG8_BAR; PG8_SCHED;
        }
        if (wr == 0) PG8_BAR;
        P.epi(acc, cur, wr, wc, fr, fq, les, lane);
        if (!has_next) break;
#pragma unroll
        for (int a = 0; a < 2; ++a)
#pragma unroll
            for (int b = 0; b < 2; ++b)
#pragma unroll
                for (int m = 0; m < 4; ++m)
#pragma unroll
                    for (int n = 0; n < 2; ++n) acc[a][b][m][n] = (f32x4){0.f, 0.f, 0.f, 0.f};
        cur = nxt; cA = nA; cB = nB; ++ui;
#pragma unroll
        for (int h = 0; h < 2; ++h)
#pragma unroll
            for (int i = 0; i < 2; ++i) voA[h][i] = voN[h][i];
        if (wr == 1) PG8_BAR;
    }
    PG8_WAIT_V(0);
    PG8_BAR;
#undef PG8_SA
#undef PG8_SB
#undef PG8_STAGE
#undef PG8_LDA
#undef PG8_LDB
#undef PG8_MMA
#undef PG8_WAIT_V
#undef PG8_WAIT_L
#undef PG8_BAR
#undef PG8_SCHED
}
}

#define XB_TMO      128
#define XB_XCNT(j)  (256  + 64 * (j))
#define XB_XSUB(j)  (1280 + 64 * (j))
#define XB_XGEN(j)  (2304 + 64 * (j))
#define XB_TOP      3328
#define XB_TOPGEN   3392
#define XCD_BAR_WORDS 3456
#define XB_SPIN_CAP (1u << 18)
__device__ __forceinline__ unsigned xb_ld(unsigned* p)              { return __hip_atomic_load(p, __ATOMIC_RELAXED, __HIP_MEMORY_SCOPE_AGENT); }
__device__ __forceinline__ unsigned xb_add(unsigned* p, unsigned v) { return __hip_atomic_fetch_add(p, v, __ATOMIC_RELAXED, __HIP_MEMORY_SCOPE_AGENT); }
__device__ __forceinline__ unsigned xb_xcc_id() { return (unsigned)__builtin_amdgcn_s_getreg((3 << 11) | 20) & 0xFu; }
#define XB_SPIN(cond, bar) do { unsigned _sp = 0; while (cond) { __builtin_amdgcn_s_sleep(1); \
    if ((++_sp & 255u) == 0u) { if (xb_ld(&(bar)[XB_TMO])) break; if (_sp > XB_SPIN_CAP) { atomicAdd(&(bar)[XB_TMO], 1u); break; } } } } while (0)
struct XcdBarrier { unsigned* bar; unsigned x; volatile LAS unsigned* st; };
__device__ __forceinline__ XcdBarrier xcd_barrier_post(unsigned* bar, volatile LAS unsigned* st) {
    XcdBarrier b; b.bar = bar; b.x = xb_xcc_id(); b.st = st;
    if (threadIdx.x == 0) (void)xb_add(&bar[XB_XCNT(b.x)], 1u);
    return b;
}
__device__ __forceinline__ void xcd_barrier_complete(unsigned* bar, unsigned x, unsigned& nloc, unsigned& nx) {
    const unsigned G = gridDim.x * gridDim.y * gridDim.z;
    unsigned sum, cnt, mine, sp = 0u;
    for (;;) {
        sum = 0u; cnt = 0u; mine = 0u;
#pragma unroll
        for (unsigned j = 0; j < 16; ++j) { const unsigned c = xb_ld(&bar[XB_XCNT(j)]); sum += c; cnt += (c > 0u) ? 1u : 0u; mine = (j == x) ? c : mine; }
        if (sum == G) break;
        __builtin_amdgcn_s_sleep(1);
        if ((++sp & 255u) == 0u) { if (xb_ld(&bar[XB_TMO])) break; if (sp > XB_SPIN_CAP) { atomicAdd(&bar[XB_TMO], 1u); break; } }
    }
    nloc = mine > 0u ? mine : 1u; nx = cnt > 0u ? cnt : 1u;
}
__device__ __forceinline__ void xcd_barrier(const XcdBarrier& b) {
    asm volatile("s_waitcnt vmcnt(0)" ::: "memory");
    __syncthreads();
    if (threadIdx.x == 0) {
        unsigned* bar = b.bar;
        __builtin_amdgcn_s_waitcnt(0);
        unsigned nloc = b.st[0], nx = b.st[1];
        if (nloc == 0u) { xcd_barrier_complete(bar, b.x, nloc, nx); b.st[0] = nloc; b.st[1] = nx; }
        const unsigned old = xb_add(&bar[XB_XSUB(b.x)], 1u);
        const unsigned gen = old / nloc;
        if (old + 1u == (gen + 1u) * nloc) {
            __builtin_amdgcn_fence(__ATOMIC_RELEASE, "agent");
            asm volatile("s_waitcnt vmcnt(0)" ::: "memory");
            const unsigned og = xb_add(&bar[XB_TOP], 1u);
            const unsigned tg = og / nx;
            if (og + 1u == (tg + 1u) * nx) xb_add(&bar[XB_TOPGEN], 1u);
            else XB_SPIN(xb_ld(&bar[XB_TOPGEN]) == tg, bar);
            __builtin_amdgcn_fence(__ATOMIC_ACQUIRE, "agent");
            xb_add(&bar[XB_XGEN(b.x)], 1u);
            asm volatile("s_waitcnt vmcnt(0)" ::: "memory");
        } else {
            XB_SPIN(xb_ld(&bar[XB_XGEN(b.x)]) == gen, bar);
            __builtin_amdgcn_fence(__ATOMIC_ACQUIRE, "agent");
            asm volatile("s_waitcnt vmcnt(0)" ::: "memory");
        }
    }
    __syncthreads();
}

struct Args {
    const float* x; const float* meta; const float* g1; const float* w_in; const float* qg; const float* kg; const float* pool_w; const float* pool_scale; const float* w_out;
    const float* g2; const float* w_rg; const float* b_rg; const float* w_re; const float* b_re; const float* w_gate; const float* w_up; const float* w_down;
    float* out; unsigned char* ws; int ph_lo, ph_hi;
};

template <class RowFn>
__device__ __forceinline__ void transpose_item(const float* W, int ldw, int k0, int n0, const float* rs, LAS float* scr, int lane, const RowFn& rowp) {
    const float* wp = W + (size_t)k0 * ldw + n0 + lane;
#pragma unroll
    for (int hb = 0; hb < 2; ++hb) { float v[32];
#pragma unroll
        for (int i = 0; i < 32; ++i) v[i] = wp[(size_t)(hb * 32 + i) * ldw];
#pragma unroll
        for (int i = 0; i < 32; ++i) { float x = v[i]; if (rs) x *= rs[k0 + hb * 32 + i]; scr[(hb * 32 + i) * 65 + lane] = x; } }
    LDS_WAIT(); asm volatile("" ::: "memory");
    const int c = lane & 7;
#pragma unroll
    for (int j = 0; j < 8; ++j) { const int n = (lane >> 3) + 8 * j; const LAS float* s = scr + (8 * c) * 65 + n;
        u32x4 o; o.x = cvt_pk_bf16(s[0 * 65], s[1 * 65]); o.y = cvt_pk_bf16(s[2 * 65], s[3 * 65]); o.z = cvt_pk_bf16(s[4 * 65], s[5 * 65]); o.w = cvt_pk_bf16(s[6 * 65], s[7 * 65]);
        *(u32x4*)(rowp(n) + k0 + 8 * c) = o; }
    LDS_WAIT(); asm volatile("" ::: "memory");
}
struct RowWin { bf16_t* base; int n0; __device__ __forceinline__ bf16_t* operator()(int n) const { const int c = n0 + n; const int r = (c & ~127) + (c < 1280 ? swap45(c & 127) : permB(c & 127)); return base + (size_t)r * DM; } };
struct RowNat { bf16_t* base; int n0; int ld; __device__ __forceinline__ bf16_t* operator()(int n) const { return base + (size_t)(n0 + n) * ld; } };
struct RowPB  { bf16_t* base; int n0; int ld; __device__ __forceinline__ bf16_t* operator()(int n) const { const int c = n0 + n; return base + (size_t)((c & ~127) + permB(c & 127)) * ld; } };
struct RowGU  { bf16_t* base; int n0; int half; __device__ __forceinline__ bf16_t* operator()(int n) const { const int c = n0 + n; const int r = (c >> 7) * 256 + half * 128 + permB(c & 127); return base + (size_t)r * DM; } };

__device__ __forceinline__ void rms_row_to_bf16(const float* xrow, bf16_t* orow, int lane) {
    const f32x4* xr = (const f32x4*)xrow + lane;
    f32x4 v[8]; float s = 0.f;
#pragma unroll
    for (int j = 0; j < 8; ++j) { v[j] = xr[64 * j]; s += (v[j].x * v[j].x + v[j].y * v[j].y) + (v[j].z * v[j].z + v[j].w * v[j].w); }
    const float rstd = 1.0f / sqrtf(wave_sum(s) * (1.f / DM) + EPS);
    u32x2* o8 = (u32x2*)orow + lane;
#pragma unroll
    for (int j = 0; j < 8; ++j) { u32x2 w; w.x = cvt_pk_bf16(v[j].x * rstd, v[j].y * rstd); w.y = cvt_pk_bf16(v[j].z * rstd, v[j].w * rstd); o8[64 * j] = w; }
}

__device__ __forceinline__ void p0_meta_job(const Args& A, LAS unsigned char* lds, int cj, int tid, int lane, int wave) {
    LAS float* Am = (LAS float*)lds;
    LAS float* Raw = (LAS float*)(lds + EPI_OFF + 8192);
#pragma unroll 1
    for (int rr = 0; rr < 2; ++rr) { const int r = wave * 2 + rr; const f32x4* mr = (const f32x4*)(A.meta + (size_t)r * DM) + lane; f32x4 v[8]; float s = 0.f;
#pragma unroll
        for (int j = 0; j < 8; ++j) { v[j] = mr[64 * j]; s += (v[j].x * v[j].x + v[j].y * v[j].y) + (v[j].z * v[j].z + v[j].w * v[j].w); }
        const float rstd = 1.0f / sqrtf(wave_sum(s) * (1.f / DM) + EPS);
#pragma unroll
        for (int j = 0; j < 8; ++j) { const int k = 4 * (lane + 64 * j); const f32x4 g = *(const f32x4*)(A.g1 + k);
            Am[(k + 0) * 16 + r] = v[j].x * rstd * g.x; Am[(k + 1) * 16 + r] = v[j].y * rstd * g.y; Am[(k + 2) * 16 + r] = v[j].z * rstd * g.z; Am[(k + 3) * 16 + r] = v[j].w * rstd * g.w; } }
    __syncthreads();
    const int c = tid & 127, kq = tid >> 7, col0 = 1024 + 128 * cj;
    float acc[16];
#pragma unroll
    for (int i = 0; i < 16; ++i) acc[i] = 0.f;
    const float* wp = A.w_in + (size_t)(kq * 512) * INW + col0 + c;
#pragma unroll 1
    for (int k0 = 0; k0 < 512; k0 += 32) { float w[32];
#pragma unroll
        for (int u = 0; u < 32; ++u) w[u] = wp[(size_t)(k0 + u) * INW];
#pragma unroll
        for (int u = 0; u < 32; ++u) { const LAS f32x4* ap = (const LAS f32x4*)(Am + (kq * 512 + k0 + u) * 16);
#pragma unroll
            for (int q = 0; q < 4; ++q) { const f32x4 a4 = ap[q]; acc[4 * q + 0] += a4.x * w[u]; acc[4 * q + 1] += a4.y * w[u]; acc[4 * q + 2] += a4.z * w[u]; acc[4 * q + 3] += a4.w * w[u]; } } }
    __syncthreads();
    LAS float* Rq = Am;
#pragma unroll
    for (int i = 0; i < 16; ++i) Rq[(kq * 16 + i) * 128 + c] = acc[i];
    __syncthreads();
    for (int i = tid; i < 16 * 128; i += 512) Raw[i] = (Rq[i] + Rq[2048 + i]) + (Rq[4096 + i] + Rq[6144 + i]);
    __syncthreads();
    bf16_t* Kb = (bf16_t*)(A.ws + WS_K); bf16_t* Vb = (bf16_t*)(A.ws + WS_V);
    if (cj < 2) {
#pragma unroll 1
        for (int rr = 0; rr < 2; ++rr) { const int r = wave * 2 + rr; const float v0 = Raw[r * 128 + lane], v1 = Raw[r * 128 + 64 + lane];
            const float rstd = 1.0f / sqrtf(wave_sum(v0 * v0 + v1 * v1) * (1.f / HD) + EPS);
            const float y0 = v0 * rstd * A.kg[lane], y1 = v1 * rstd * A.kg[64 + lane];
#pragma unroll
            for (int b = 0; b < 2; ++b) { bf16_t* kr = Kb + ((size_t)(b * 2 + cj) * KVROWS + r) * HD; kr[spos(lane)] = (bf16_t)(cvt_pk_bf16(y0, 0.f) & 0xffffu); kr[spos(64 + lane)] = (bf16_t)(cvt_pk_bf16(y1, 0.f) & 0xffffu); } }
    } else if (cj < 4) {
#pragma unroll 1
        for (int rr = 0; rr < 2; ++rr) { const int r = wave * 2 + rr;
#pragma unroll
            for (int b = 0; b < 2; ++b) { bf16_t* vr = Vb + ((size_t)(b * 2 + (cj - 2)) * KVROWS + r) * HD; vr[lane] = (bf16_t)(cvt_pk_bf16(Raw[r * 128 + lane], 0.f) & 0xffffu); vr[64 + lane] = (bf16_t)(cvt_pk_bf16(Raw[r * 128 + 64 + lane], 0.f) & 0xffffu); } }
    } else {
        float* pm = (float*)(A.ws + WS_PMETA);
        for (int i = tid; i < 16 * 128; i += 512) pm[(size_t)(i >> 7) * POOLW + (cj - 4) * 128 + (i & 127)] = Raw[i];
    }
    if (ATT_MODE != 0 && cj < 2) {
        unsigned char* K8 = A.ws + WS_K8;
        for (int i = tid; i < 16 * 128; i += 512) { const int r = i >> 7, d = i & 127;
            const float v0 = Raw[r * 128 + d]; float ssq = 0.f;
            for (int q = 0; q < 128; ++q) { const float t = Raw[r * 128 + q]; ssq += t * t; }
            const float y = v0 * (1.0f / sqrtf(ssq * (1.f / HD) + EPS)) * A.kg[d]; const unsigned char by = (unsigned char)pk4_fp8(y, 0.f, 0.f, 0.f);
            K8[((size_t)(0 * 2 + cj) * KVROWS + r) * HD + spos(d)] = by; K8[((size_t)(1 * 2 + cj) * KVROWS + r) * HD + spos(d)] = by; }
        for (int i = tid; i < 2 * 384; i += 512) { const int b = i / 384, q = i % 384; *(u32x4*)(K8 + ((size_t)(b * 2 + cj) * KVROWS + 16) * HD + q * 16) = (u32x4){0u, 0u, 0u, 0u}; }
    }
    if (ATT_MODE != 0 && cj >= 2 && cj < 4) {
        LAS unsigned char* img = (LAS unsigned char*)Am + 65536;
        for (int i = tid; i < 512; i += 512) ((LAS u32x4*)img)[i] = (u32x4){0u, 0u, 0u, 0u};
        __syncthreads();
        for (int i = tid; i < 16 * 128; i += 512) { const int r = i >> 7, d = i & 127; img[d * 64 + vpos(r)] = (unsigned char)pk4_fp8(Raw[r * 128 + d], 0.f, 0.f, 0.f); }
        __syncthreads();
        unsigned char* V8 = A.ws + WS_V8;
        for (int i = tid; i < 2 * 512; i += 512) { const int b = i >> 9, q = i & 511; *(u32x4*)(V8 + ((size_t)(b * 2 + (cj - 2)) * NT_ATT) * 8192 + q * 16) = ((const LAS u32x4*)img)[q]; }
    }
    if (ATT_MODE != 1 && cj < 4) {
        bf16_t* base = (cj < 2) ? Kb : Vb; const int kvh = cj & 1;
        for (int i = tid; i < 2 * 768; i += 512) { const int b = i / 768, q = i % 768; *(u32x4*)(base + ((size_t)(b * 2 + kvh) * KVROWS + 16) * HD + q * 8) = (u32x4){0u, 0u, 0u, 0u}; }
    }
    __syncthreads();
}

__device__ __forceinline__ void p0_fold_job(const Args& A, LAS unsigned char* lds, int fj, int tid) {
    LAS float* As = (LAS float*)lds;
    const int g = fj >> 6, k0 = (fj & 63) * 32;
    for (int i = tid; i < 32 * 64; i += 512) { const int kk = i >> 6, c4 = (i & 63) * 4; f32x4 v = *(const f32x4*)(A.w_in + (size_t)(k0 + kk) * INW + 1536 + g * 256 + c4); const float gs = A.g1[k0 + kk];
        *(LAS f32x4*)(As + kk * 256 + c4) = v * gs; }
    __syncthreads();
    const int d = tid & 255, kh = tid >> 8;
    float acc[16];
#pragma unroll
    for (int i = 0; i < 16; ++i) acc[i] = 0.f;
    const float* pw = A.pool_w + (size_t)g * 256 * 256 + d;
#pragma unroll 1
    for (int c = 0; c < 256; c += 16) { float bv[16];
#pragma unroll
        for (int u = 0; u < 16; ++u) bv[u] = pw[(size_t)(c + u) * 256];
#pragma unroll
        for (int u = 0; u < 16; u += 4)
#pragma unroll
            for (int kk = 0; kk < 16; ++kk) { const f32x4 a = *(const LAS f32x4*)(As + (kh * 16 + kk) * 256 + c + u); acc[kk] += (a.x * bv[u] + a.y * bv[u + 1]) + (a.z * bv[u + 2] + a.w * bv[u + 3]); } }
    const float sc = A.pool_scale[g * 256 + d];
    bf16_t* dst = (bf16_t*)(A.ws + WS_WIN) + (size_t)(1536 + g * 256 + (d & 128) + permB(d & 127)) * DM + k0 + kh * 16;
#pragma unroll
    for (int q = 0; q < 2; ++q) { u32x4 w; w.x = cvt_pk_bf16(acc[8 * q + 0] * sc, acc[8 * q + 1] * sc); w.y = cvt_pk_bf16(acc[8 * q + 2] * sc, acc[8 * q + 3] * sc);
        w.z = cvt_pk_bf16(acc[8 * q + 4] * sc, acc[8 * q + 5] * sc); w.w = cvt_pk_bf16(acc[8 * q + 6] * sc, acc[8 * q + 7] * sc); *(u32x4*)(dst + 8 * q) = w; }
    __syncthreads();
}

__device__ __forceinline__ void p0_prologue(const Args& A, LAS unsigned char* lds, int vcu, int G, int tid, int lane, int wave) {
    (void)tid;
    for (int job = vcu; job < 12; job += G) { const int l2 = fresh_lane(); p0_meta_job(A, lds, job, wave * 64 + l2, l2, wave); }
    for (int job = vcu; job < 256; job += G) { const int l2 = fresh_lane(); p0_fold_job(A, lds, job, wave * 64 + l2); }
    lane = fresh_lane(); tid = wave * 64 + lane;
    {
        const int gt = (vcu * 8 + wave) * 64 + lane, NGT = G * 512;
        float* cosT = (float*)(A.ws + WS_ROPE); float* sinT = cosT + 256 * 32;
        for (int i = gt; i < 256 * 32; i += NGT) { const int pos = i >> 5, f = i & 31; const float inv = powf(10000.0f, -(float)(2 * f) / 64.0f); const float ang = (float)pos * inv; cosT[i] = cosf(ang); sinT[i] = sinf(ang); }
        u32x4* wrf = (u32x4*)(A.ws + WS_WRF);
        for (int i = gt; i < 64 * 3 * 64; i += NGT) { const int l = i & 63, blk = (i >> 6) % 3, ks = i / 192; const int col = 16 * blk + (l & 15), kb = 32 * ks + 8 * (l >> 4);
            float v[8];
#pragma unroll
            for (int q = 0; q < 8; ++q) { const int k = kb + q; float w = 0.f; if (col < 32) w = A.w_re[(size_t)k * NEXP + col]; else if (col < 36) w = A.w_rg[(size_t)k * 4 + (col - 32)]; v[q] = w * A.g2[k]; }
            u32x4 hi, lo; unsigned* hp = (unsigned*)&hi; unsigned* lp = (unsigned*)&lo;
#pragma unroll
            for (int q = 0; q < 4; ++q) { const unsigned h = cvt_pk_bf16(v[2 * q], v[2 * q + 1]); hp[q] = h; lp[q] = cvt_pk_bf16(v[2 * q] - bf_lo(h), v[2 * q + 1] - bf_hi(h)); }
            wrf[(size_t)((ks * 3 + blk) * 2 + 0) * 64 + l] = hi; wrf[(size_t)((ks * 3 + blk) * 2 + 1) * 64 + l] = lo; }
    }
    LAS float* scr = (LAS float*)(lds + wave * 16640);
    const int gw = vcu * 8 + wave, NGW = G * 8;
    constexpr int I_IN = 32 * 24, I_OUT = 32 * 32, I_G = 32 * 256, I_D = 32 * 256;
    constexpr int NITEMS = I_IN + I_OUT + 2 * I_G + I_D;
    bf16_t* Win_t = (bf16_t*)(A.ws + WS_WIN); bf16_t* Wout_t = (bf16_t*)(A.ws + WS_WOUT); bf16_t* Wgu_t = (bf16_t*)(A.ws + WS_WGU); bf16_t* Wd_t = (bf16_t*)(A.ws + WS_WD);
    for (int it = gw; it < NITEMS; it += NGW) {
        int r = it;
        if (r < I_IN) { const int kb = r / 24, nb = r % 24; transpose_item(A.w_in, INW, kb * 64, nb * 64, A.g1, scr, lane, RowWin{Win_t, nb * 64}); continue; } r -= I_IN;
        if (r < I_OUT) { const int kb = r / 32, nb = r % 32; transpose_item(A.w_out, DM, kb * 64, nb * 64, nullptr, scr, lane, RowNat{Wout_t, nb * 64, DM}); continue; } r -= I_OUT;
        if (r < 2 * I_G) { const int half = r / I_G; r -= half * I_G; const int e = r / 256, q = r % 256, kb = q / 8, nb = q % 8;
            transpose_item((half ? A.w_up : A.w_gate) + (size_t)e * DM * DEXP, DEXP, kb * 64, nb * 64, A.g2, scr, lane, RowGU{Wgu_t + (size_t)e * 1024 * DM, nb * 64, half}); continue; } r -= 2 * I_G;
        { const int e = r / 256, q = r % 256, kb = q / 32, nb = q % 32; transpose_item(A.w_down + (size_t)e * DEXP * DM, DM, kb * 64, nb * 64, nullptr, scr, lane, RowPB{Wd_t + (size_t)e * DM * DEXP, nb * 64, DEXP}); }
    }
    bf16_t* XN = (bf16_t*)(A.ws + WS_XN);
    if (G > 24) { if (vcu >= 12) for (int m = gw - 96; m < NTOK; m += NGW - 96) rms_row_to_bf16(A.x + (size_t)m * DM, XN + (size_t)m * DM, lane); }
    else for (int m = gw; m < NTOK; m += NGW) rms_row_to_bf16(A.x + (size_t)m * DM, XN + (size_t)m * DM, lane);
}

namespace att { constexpr float CQ_ = 0.088388347648318440f * 1.4426950408889634f; }
using pg8::UnitMN;
template <int AM> struct ProbIn {
    typedef UnitMN Unit;
    const bf16_t* A; const bf16_t* Bt; pg8::StaticOrder S;
    bf16_t *Q, *Kb, *Vb, *Z; unsigned char *Q8, *K8, *V8; const float *qg, *kg, *cosT, *sinT;
    __device__ __forceinline__ bool next(int i, Unit& u) const { return S.next(i, u); }
    __device__ __forceinline__ const char* a_base(const Unit& u) const { return (const char*)A + (size_t)u.pm * 256 * DM * 2; }
    __device__ __forceinline__ void a_offs(const Unit&, const int (&R)[2], const int (&C)[2], unsigned (&vo)[2][2]) const {
#pragma unroll
        for (int h = 0; h < 2; ++h)
#pragma unroll
            for (int i = 0; i < 2; ++i) vo[h][i] = (unsigned)((h * 128 + R[i]) * DM + C[i]) * 2u; }
    __device__ __forceinline__ const char* b_base(const Unit& u) const { return (const char*)Bt + (size_t)u.pn * 256 * DM * 2; }
    __device__ __forceinline__ void epi(f32x4 (&acc)[2][2][4][2], const Unit& u, int wr, int wc, int fr, int fq, LAS unsigned char* les, int lane) const {
        const int pn = u.pn; const int rbase = u.pm * 256 + wr * 64 + fr;
        if (pn <= 4) {
            LAS float* Pst = (LAS float*)les;
#pragma unroll
            for (int ai = 0; ai < 2; ++ai)
#pragma unroll
                for (int m = 0; m < 4; ++m)
#pragma unroll
                    for (int bj = 0; bj < 2; ++bj) { const f32x4 a = acc[ai][bj][m][0], b = acc[ai][bj][m][1];
                        float ss = ((a.x * a.x + a.y * a.y) + (a.z * a.z + a.w * a.w)) + ((b.x * b.x + b.y * b.y) + (b.z * b.z + b.w * b.w));
                        ss += __shfl_xor(ss, 16); ss += __shfl_xor(ss, 32);
                        if (fq == 0) Pst[((ai * 128 + wr * 64 + m * 16 + fr) * 2 + bj) * 4 + wc] = ss; }
            asm volatile("s_waitcnt lgkmcnt(0)" ::: "memory"); __builtin_amdgcn_s_barrier(); asm volatile("" ::: "memory");
            const float* gp = (pn < 4) ? qg : kg;
            const int dA = 64 * (wc >> 1) + 16 * (wc & 1) + 4 * fq, i0 = 16 * (wc & 1) + 4 * fq;
            const f32x4 g0 = *(const f32x4*)(gp + dA), g1v = *(const f32x4*)(gp + dA + 32);
#pragma unroll
            for (int ai = 0; ai < 2; ++ai)
#pragma unroll
                for (int m = 0; m < 4; ++m) { const int row = rbase + ai * 128 + m * 16; const int b = row >> 14, s = row & (SEQ - 1);
                    const int pos = (wc >> 1) ? (s & 63) : (s >> 6);
                    const f32x4 c4 = *(const f32x4*)(cosT + pos * 32 + i0), s4 = *(const f32x4*)(sinT + pos * 32 + i0);
#pragma unroll
                    for (int bj = 0; bj < 2; ++bj) { const f32x4 pp = *(const LAS f32x4*)(Pst + ((ai * 128 + wr * 64 + m * 16 + fr) * 2 + bj) * 4);
                        const float rstd = 1.0f / sqrtf(((pp.x + pp.y) + (pp.z + pp.w)) * (1.f / HD) + EPS);
                        const f32x4 x1 = acc[ai][bj][m][0] * rstd * g0, x2 = acc[ai][bj][m][1] * rstd * g1v;
                        f32x4 y1 = x1 * c4 - x2 * s4, y2 = x2 * c4 + x1 * s4;
                        if (pn < 4) { y1 = y1 * att::CQ_; y2 = y2 * att::CQ_; }
                        if (AM != 1) {
                        bf16_t* dst = (pn < 4) ? Q + (size_t)row * ATTW + (2 * pn + bj) * HD + 32 * wc + 8 * fq
                                               : Kb + ((size_t)(b * 2 + bj) * KVROWS + 64 + s) * HD + 32 * wc + 8 * fq;
                        *(u32x4*)dst = pack8(y1, y2); }
                        if (AM != 0) { const float qs = (pn < 4) ? 8.0f : 1.0f; y1 = y1 * qs; y2 = y2 * qs;
                        unsigned char* d8 = (pn < 4) ? Q8 + (size_t)row * ATTW + (2 * pn + bj) * HD + 32 * wc + 8 * fq
                                                     : K8 + ((size_t)(b * 2 + bj) * KVROWS + 64 + s) * HD + 32 * wc + 8 * fq;
                        u32x2 w8; w8.x = pk4_fp8(y1[0], y1[1], y1[2], y1[3]); w8.y = pk4_fp8(y2[0], y2[1], y2[2], y2[3]); *(u32x2*)d8 = w8; } } }
        } else {
            if (AM != 0 && pn == 5) {
                LAS unsigned char* T = les + (wr * 4 + wc) * 2048;
#pragma unroll
                for (int ai = 0; ai < 2; ++ai)
#pragma unroll
                    for (int bj = 0; bj < 2; ++bj) {
#pragma unroll
                        for (int m = 0; m < 4; ++m) { const int pp = vpos(16 * m + fr);
#pragma unroll
                            for (int n = 0; n < 2; ++n) { const f32x4 v = acc[ai][bj][m][n]; const unsigned w = pk4_fp8(v[0], v[1], v[2], v[3]); const int dl = 8 * fq + 4 * n;
                                T[(dl + 0) * 64 + pp] = (unsigned char)w; T[(dl + 1) * 64 + pp] = (unsigned char)(w >> 8); T[(dl + 2) * 64 + pp] = (unsigned char)(w >> 16); T[(dl + 3) * 64 + pp] = (unsigned char)(w >> 24); } }
                        asm volatile("s_waitcnt lgkmcnt(0)" ::: "memory");
                        const int row0 = u.pm * 256 + ai * 128 + wr * 64; const int b0 = row0 >> 14, tile = 1 + ((row0 & (SEQ - 1)) >> 6);
                        unsigned char* dst = V8 + (((size_t)(b0 * 2 + bj) * NT_ATT + tile) * 128 + 32 * wc) * 64;
                        const u32x4 c0 = *(const LAS u32x4*)(T + lane * 16), c1 = *(const LAS u32x4*)(T + 1024 + lane * 16);
                        *(u32x4*)(dst + lane * 16) = c0; *(u32x4*)(dst + 1024 + lane * 16) = c1;
                        asm volatile("s_waitcnt lgkmcnt(0)" ::: "memory"); }
            }
            if (AM == 1 && pn == 5) return;
#pragma unroll
            for (int ai = 0; ai < 2; ++ai)
#pragma unroll
                for (int m = 0; m < 4; ++m) { const int row = rbase + ai * 128 + m * 16; const int b = row >> 14, s = row & (SEQ - 1);
#pragma unroll
                    for (int bj = 0; bj < 2; ++bj) {
                        bf16_t* dst = (pn == 5) ? Vb + ((size_t)(b * 2 + bj) * KVROWS + 64 + s) * HD + 32 * wc + 8 * fq
                                                : Z + (size_t)row * POOLW + (pn - 6) * 256 + bj * 128 + 32 * wc + 8 * fq;
                        *(u32x4*)dst = pack8(acc[ai][bj][m][0], acc[ai][bj][m][1]); } }
        }
    }
};
struct ProbOut {
    typedef UnitMN Unit;
    const bf16_t* A; const bf16_t* Bt; pg8::StaticOrder S; const float* x; float* out; float* ssp;
    __device__ __forceinline__ bool next(int i, Unit& u) const { return S.next(i, u); }
    __device__ __forceinline__ const char* a_base(const Unit& u) const { return (const char*)A + (size_t)u.pm * 256 * DM * 2; }
    __device__ __forceinline__ void a_offs(const Unit&, const int (&R)[2], const int (&C)[2], unsigned (&vo)[2][2]) const {
#pragma unroll
        for (int h = 0; h < 2; ++h)
#pragma unroll
            for (int i = 0; i < 2; ++i) vo[h][i] = (unsigned)((h * 128 + R[i]) * DM + C[i]) * 2u; }
    __device__ __forceinline__ const char* b_base(const Unit& u) const { return (const char*)Bt + (size_t)u.pn * 256 * DM * 2; }
    __device__ __forceinline__ void epi(f32x4 (&acc)[2][2][4][2], const Unit& u, int wr, int wc, int fr, int fq, LAS unsigned char*, int) const {
        const int col0 = u.pn * 256 + wc * 32 + 4 * fq;
#pragma unroll
        for (int ai = 0; ai < 2; ++ai)
#pragma unroll
            for (int m = 0; m < 4; ++m) { const int row = u.pm * 256 + ai * 128 + wr * 64 + m * 16 + fr; const size_t off = (size_t)row * DM + col0; float ss = 0.f;
#pragma unroll
                for (int bj = 0; bj < 2; ++bj)
#pragma unroll
                    for (int n = 0; n < 2; ++n) { const f32x4 v = *(const f32x4*)(x + off + bj * 128 + n * 16) + acc[ai][bj][m][n]; *(f32x4*)(out + off + bj * 128 + n * 16) = v;
                        ss += (v.x * v.x + v.y * v.y) + (v.z * v.z + v.w * v.w); }
                ss += __shfl_xor(ss, 16); ss += __shfl_xor(ss, 32);
                if (fq == 0) ssp[(size_t)row * 32 + u.pn * 4 + wc] = ss;
                if (m & 1) asm volatile("" ::: "memory"); }
    }
};
struct MoeTab { LAS int* cnt; LAS int* tb; LAS int* tbk; };
__device__ __forceinline__ MoeTab moe_tab(LAS unsigned char* lds) { MoeTab t; t.cnt = (LAS int*)(lds + TAB_OFF); t.tb = t.cnt + 64; t.tbk = t.tb + 72; return t; }
__device__ __forceinline__ void moe_tables(LAS unsigned char* lds, const unsigned* gcnt, int tid) {
    MoeTab T = moe_tab(lds);
    if (tid < 64) T.cnt[tid] = (int)__hip_atomic_load(gcnt + tid, RLX_AGENT);
    __syncthreads();
    if (tid == 0) { int s = 0; for (int li = 0; li < 64; ++li) { T.tb[li] = s; s += (T.cnt[li] + 255) >> 8; } T.tb[64] = s;
        for (int k = 0; k < 2; ++k) { int q = 0; for (int e = 0; e < 32; ++e) { T.tbk[k * 33 + e] = q; q += (T.cnt[2 * e + k] + 255) >> 8; } T.tbk[k * 33 + 32] = q; } }
    __syncthreads();
}
struct UnitMoe { int T, j, li, tl; };
struct ProbGU {
    typedef UnitMoe Unit;
    const bf16_t* A; const bf16_t* Bt; bf16_t* H; const int* list; MoeTab T; int vcu, G;
    __device__ __forceinline__ bool next(int i, Unit& u) const {
        const int un = i * G + vcu; const int ntile = T.tb[64]; if (un >= ntile * 4) return false;
        const int Tt = un >> 2; int li = 0;
        for (int q = 1; q < 64; ++q) li += (T.tb[q] <= Tt) ? 1 : 0;
        li = __builtin_amdgcn_readfirstlane(li);
        u.T = Tt; u.j = un & 3; u.li = li; u.tl = Tt - __builtin_amdgcn_readfirstlane(T.tb[li]); return true; }
    __device__ __forceinline__ const char* a_base(const Unit&) const { return (const char*)A; }
    __device__ __forceinline__ void a_offs(const Unit& u, const int (&R)[2], const int (&C)[2], unsigned (&vo)[2][2]) const {
        const int cnt = T.cnt[u.li];
#pragma unroll
        for (int h = 0; h < 2; ++h)
#pragma unroll
            for (int i = 0; i < 2; ++i) { const int slot = u.tl * 256 + h * 128 + R[i]; int tok = 0; if (slot < cnt) tok = list[(size_t)u.li * LCAP + slot]; vo[h][i] = (unsigned)(tok * DM + C[i]) * 2u; } }
    __device__ __forceinline__ const char* b_base(const Unit& u) const { return (const char*)Bt + (size_t)((u.li >> 1) * 4 + u.j) * 256 * DM * 2; }
    __device__ __forceinline__ void epi(f32x4 (&acc)[2][2][4][2], const Unit& u, int wr, int wc, int fr, int fq, LAS unsigned char*, int) const {
#pragma unroll
        for (int ai = 0; ai < 2; ++ai)
#pragma unroll
            for (int m = 0; m < 4; ++m) { const int hrow = u.T * 256 + ai * 128 + wr * 64 + m * 16 + fr; f32x4 hv[2];
#pragma unroll
                for (int n = 0; n < 2; ++n) { const f32x4 g = acc[ai][0][m][n], up = acc[ai][1][m][n];
#pragma unroll
                    for (int e = 0; e < 4; ++e) hv[n][e] = g[e] * __builtin_amdgcn_rcpf(1.0f + __builtin_amdgcn_exp2f(-1.4426950408889634f * g[e])) * up[e]; }
                *(u32x4*)(H + (size_t)hrow * DEXP + u.j * 128 + 32 * wc + 8 * fq) = pack8(hv[0], hv[1]); }
    }
};
template <int KK> struct ProbDown {
    typedef UnitMoe Unit;
    const bf16_t* A; const bf16_t* Bt; float* out; bf16_t* tmp; const int* list; const float* glist; MoeTab T; int vcu, G;
    __device__ __forceinline__ bool next(int i, Unit& u) const {
        const int un = i * G + vcu; const int ntile = T.tbk[KK * 33 + 32]; if (un >= ntile * 8) return false;
        const int Tk = un >> 3; int e = 0;
        for (int q = 1; q < 32; ++q) e += (T.tbk[KK * 33 + q] <= Tk) ? 1 : 0;
        e = __builtin_amdgcn_readfirstlane(e);
        u.li = 2 * e + KK; u.tl = Tk - __builtin_amdgcn_readfirstlane(T.tbk[KK * 33 + e]); u.T = __builtin_amdgcn_readfirstlane(T.tb[u.li]) + u.tl; u.j = un & 7; return true; }
    __device__ __forceinline__ const char* a_base(const Unit& u) const { return (const char*)A + (size_t)u.T * 256 * DEXP * 2; }
    __device__ __forceinline__ void a_offs(const Unit&, const int (&R)[2], const int (&C)[2], unsigned (&vo)[2][2]) const {
#pragma unroll
        for (int h = 0; h < 2; ++h)
#pragma unroll
            for (int i = 0; i < 2; ++i) vo[h][i] = (unsigned)((h * 128 + R[i]) * DEXP + C[i]) * 2u; }
    __device__ __forceinline__ const char* b_base(const Unit& u) const { return (const char*)Bt + ((size_t)(u.li >> 1) * DM + u.j * 256) * DEXP * 2; }
    __device__ __forceinline__ void epi(f32x4 (&acc)[2][2][4][2], const Unit& u, int wr, int wc, int fr, int fq, LAS unsigned char*, int) const {
        const int cnt = T.cnt[u.li]; const int col0 = u.j * 256 + wc * 32 + 8 * fq;
        int tok[2][4]; float gt[2][4];
#pragma unroll
        for (int ai = 0; ai < 2; ++ai)
#pragma unroll
            for (int m = 0; m < 4; ++m) { const int slot = u.tl * 256 + ai * 128 + wr * 64 + m * 16 + fr; const bool ok = slot < cnt; const int sl = ok ? slot : 0;
                tok[ai][m] = list[(size_t)u.li * LCAP + sl]; gt[ai][m] = glist[(size_t)u.li * LCAP + sl]; if (!ok) tok[ai][m] = -1; }
#pragma unroll
        for (int ai = 0; ai < 2; ++ai)
#pragma unroll
            for (int m = 0; m < 4; ++m) {
                if (tok[ai][m] >= 0) { const size_t ro = (size_t)tok[ai][m] * DM + col0; const float g = gt[ai][m];
                    if (KK == 0) {
#pragma unroll
                        for (int bj = 0; bj < 2; ++bj) *(u32x4*)(tmp + ro + bj * 128) = pack8(acc[ai][bj][m][0] * g, acc[ai][bj][m][1] * g);
                    } else {
#pragma unroll
                        for (int bj = 0; bj < 2; ++bj) { const u32x4 t = *(const u32x4*)(tmp + ro + bj * 128); f32x4 v0 = *(const f32x4*)(out + ro + bj * 128), v1 = *(const f32x4*)(out + ro + bj * 128 + 4);
                            v0 = v0 + (f32x4){bf_lo(t.x), bf_hi(t.x), bf_lo(t.y), bf_hi(t.y)} + acc[ai][bj][m][0] * g; v1 = v1 + (f32x4){bf_lo(t.z), bf_hi(t.z), bf_lo(t.w), bf_hi(t.w)} + acc[ai][bj][m][1] * g;
                            *(f32x4*)(out + ro + bj * 128) = v0; *(f32x4*)(out + ro + bj * 128 + 4) = v1; } } }
                if (m & 1) asm volatile("" ::: "memory"); }
    }
};

namespace att {
constexpr int D = 128, NW = 8, QBLK = 32, KVBLK = 64;
constexpr float CQ = 0.088388347648318440f * 1.4426950408889634f;
constexpr float THRL = 8.f;
constexpr int LDQ = ATTW, LDO = DM;
constexpr int KSLOT = 16384, NKS = 3, NVS = 4, LDS_K = 0, LDS_V = NKS * KSLOT, LDS_WS = LDS_V + NVS * KSLOT;
#define SBAR() __builtin_amdgcn_sched_barrier(0)
__device__ __forceinline__ int crow(int r, int hi) { return (r & 3) + 8 * (r >> 2) + 4 * hi; }
__device__ __forceinline__ unsigned cvtpk(float lo, float hi) { unsigned r; asm volatile("v_cvt_pk_bf16_f32 %0, %1, %2" : "=v"(r) : "v"(lo), "v"(hi)); return r; }
__device__ __forceinline__ int v_rd_base(int lane) { return ((lane & 3) << 3) | (((lane >> 2) & 3) << 6) | (((lane >> 4) & 1) << 5) | (((lane >> 5) & 1) << 8); }
constexpr int v_rd_off(int d0, int ks, int half) { return d0 * 512 + ks * 4096 + half * 2048; }
template <int OFF> __device__ __forceinline__ s16x4 tr_read(int vb) {
  s16x4 r; asm volatile("ds_read_b64_tr_b16 %0, %1 offset:%2" : "=&v"(r) : "v"(vb), "i"(OFF) : "memory"); return r;
}
struct VG { s16x4 l0, h0, l1, h1; };
template <int G> __device__ __forceinline__ void v_read(VG& v, int vb) {
  constexpr int d0 = G >> 1, ks = 2 * (G & 1);
  v.l0 = tr_read<v_rd_off(d0, ks, 0)>(vb); v.h0 = tr_read<v_rd_off(d0, ks, 1)>(vb); v.l1 = tr_read<v_rd_off(d0, ks + 1, 0)>(vb); v.h1 = tr_read<v_rd_off(d0, ks + 1, 1)>(vb);
}
#define V_WAIT(N, v) asm volatile("s_waitcnt lgkmcnt(" #N ")" : "+v"(v.l0), "+v"(v.h0), "+v"(v.l1), "+v"(v.h1))
#define PKV(L, H) (bf16x8){L[0], L[1], L[2], L[3], H[0], H[1], H[2], H[3]}
#define V_MMA(od, v, pe, po) do { od = __builtin_amdgcn_mfma_f32_32x32x16_bf16(pe, PKV(v.l0, v.h0), od, 0, 0, 0); od = __builtin_amdgcn_mfma_f32_32x32x16_bf16(po, PKV(v.l1, v.h1), od, 0, 0, 0); } while (0)
__device__ __forceinline__ void pv_d0(f32x16* o, int vb, bf16x8 pa0, bf16x8 pa1, bf16x8 pa2, bf16x8 pa3) {
  VG a, b, c;
  v_read<0>(a, vb); v_read<1>(b, vb); v_read<2>(c, vb);
  V_WAIT(8, a); V_MMA(o[0], a, pa0, pa1); v_read<3>(a, vb);
  V_WAIT(8, b); V_MMA(o[0], b, pa2, pa3); v_read<4>(b, vb);
  V_WAIT(8, c); V_MMA(o[1], c, pa0, pa1); v_read<5>(c, vb);
  V_WAIT(8, a); V_MMA(o[1], a, pa2, pa3); v_read<6>(a, vb);
  V_WAIT(8, b); V_MMA(o[2], b, pa0, pa1); v_read<7>(b, vb);
  V_WAIT(8, c); V_MMA(o[2], c, pa2, pa3);
  V_WAIT(4, a); V_MMA(o[3], a, pa0, pa1);
  V_WAIT(0, b); V_MMA(o[3], b, pa2, pa3);
}
#undef V_MMA
#undef PKV
struct KG { bf16x8 b0, b1; };
template <int D0> __device__ __forceinline__ void k_read(KG& k, const int (&kb)[4]) {
  asm volatile("ds_read_b128 %0, %1 offset:%2" : "=&v"(k.b0) : "v"(kb[D0 & 3]), "i"((D0 >> 2) * 128) : "memory");
  asm volatile("ds_read_b128 %0, %1 offset:%2" : "=&v"(k.b1) : "v"(kb[D0 & 3]), "i"((D0 >> 2) * 128 + 8192) : "memory");
}
#define K_WAIT(N, k) asm volatile("s_waitcnt lgkmcnt(" #N ")" : "+v"(k.b0), "+v"(k.b1))
__device__ __forceinline__ void qkt(f32x16& p0, f32x16& p1, const int (&kb)[4], const bf16x8* qr, const f32x16& negm) {
  KG a, b;
  k_read<0>(a, kb); k_read<1>(b, kb);
  K_WAIT(2, a); p0 = __builtin_amdgcn_mfma_f32_32x32x16_bf16(a.b0, qr[0], negm, 0, 0, 0); p1 = __builtin_amdgcn_mfma_f32_32x32x16_bf16(a.b1, qr[0], negm, 0, 0, 0); k_read<2>(a, kb);
#define K_MMA(k, d) do { p0 = __builtin_amdgcn_mfma_f32_32x32x16_bf16(k.b0, qr[d], p0, 0, 0, 0); p1 = __builtin_amdgcn_mfma_f32_32x32x16_bf16(k.b1, qr[d], p1, 0, 0, 0); } while (0)
  K_WAIT(2, b); K_MMA(b, 1); k_read<3>(b, kb);
  K_WAIT(2, a); K_MMA(a, 2); k_read<4>(a, kb);
  K_WAIT(2, b); K_MMA(b, 3); k_read<5>(b, kb);
  K_WAIT(2, a); K_MMA(a, 4); k_read<6>(a, kb);
  K_WAIT(2, b); K_MMA(b, 5); k_read<7>(b, kb);
  K_WAIT(2, a); K_MMA(a, 6);
  K_WAIT(0, b); K_MMA(b, 7);
#undef K_MMA
}
__device__ __forceinline__ void finishSM(f32x16& p0, f32x16& p1, float& l_reg, bf16x8& pa0, bf16x8& pa1, bf16x8& pa2, bf16x8& pa3) {
#pragma unroll
  for (int r = 0; r < 16; ++r) p1[r] = __builtin_amdgcn_exp2f(p1[r]);
  float ps = 0;
#pragma unroll
  for (int r = 0; r < 16; ++r) ps += p0[r];
#pragma unroll
  for (int r = 0; r < 16; ++r) ps += p1[r];
  l_reg += ps;
#define PK4(P, BASE, OUT) do { unsigned a0 = cvtpk(P[BASE + 0], P[BASE + 1]), a1 = cvtpk(P[BASE + 2], P[BASE + 3]);   \
    unsigned b0 = cvtpk(P[BASE + 4], P[BASE + 5]), b1 = cvtpk(P[BASE + 6], P[BASE + 7]);                              \
    auto r0 = __builtin_amdgcn_permlane32_swap(a0, b0, false, false); auto r1 = __builtin_amdgcn_permlane32_swap(a1, b1, false, false); \
    u32x4 w = {r0[0], r1[0], r0[1], r1[1]}; OUT = *reinterpret_cast<bf16x8*>(&w); } while (0)
  PK4(p0, 0, pa0); PK4(p0, 8, pa1); PK4(p1, 0, pa2); PK4(p1, 8, pa3);
#undef PK4
}
template <bool FIRST>
__device__ __forceinline__ void startSM(f32x16& p0, f32x16& p1, float& mhat, float& l_reg, f32x16& negm, bool& resc, float& f) {
  float a = __builtin_fmaxf(__builtin_fmaxf(p0[0], p0[1]), p1[0]), b = __builtin_fmaxf(__builtin_fmaxf(p0[2], p0[3]), p1[1]); a = __builtin_fmaxf(__builtin_fmaxf(a, p1[2]), p1[3]);
#pragma unroll
  for (int r = 4; r < 16; r += 4) { a = __builtin_fmaxf(__builtin_fmaxf(a, p0[r]), p0[r + 1]); b = __builtin_fmaxf(__builtin_fmaxf(b, p0[r + 2]), p0[r + 3]);
    a = __builtin_fmaxf(__builtin_fmaxf(a, p1[r]), p1[r + 1]); b = __builtin_fmaxf(__builtin_fmaxf(b, p1[r + 2]), p1[r + 3]); }
  float rm = __builtin_fmaxf(a, b);
  { auto rr = __builtin_amdgcn_permlane32_swap(__float_as_uint(rm), __float_as_uint(rm), false, false); rm = __builtin_fmaxf(__uint_as_float(rr[0]), __uint_as_float(rr[1])); }
  resc = false; f = 1.f;
  if (FIRST || __builtin_expect(__any(rm > THRL), 0)) {
    const float dl = FIRST ? rm : __builtin_fmaxf(rm, 0.f); mhat += dl;
#pragma unroll
    for (int r = 0; r < 16; ++r) { p0[r] -= dl; p1[r] -= dl; }
#pragma unroll
    for (int r = 0; r < 16; ++r) negm[r] = -mhat;
    asm volatile("" : "+v"(negm));
    if (!FIRST) { f = __builtin_amdgcn_exp2f(-dl); l_reg *= f; resc = true; }
  }
#pragma unroll
  for (int r = 0; r < 16; ++r) p0[r] = __builtin_amdgcn_exp2f(p0[r]);
}
#define ATT_WAIT(N) asm volatile("s_waitcnt vmcnt(" #N ")" ::: "memory")
__device__ __forceinline__ void attn_unit(const bf16_t* __restrict__ Qb, const bf16_t* __restrict__ Kh, const bf16_t* __restrict__ Vh, bf16_t* __restrict__ Ob, LAS char* lds, int tid) {
  constexpr int NT = NT_ATT; static_assert(NT % 2 == 1 && NT >= 7, "odd tile count");
  const int wid = __builtin_amdgcn_readfirstlane(tid >> 6), lane = tid & 63, r32 = lane & 31, hi = lane >> 5;
  LAS float* ws = (LAS float*)(lds + LDS_WS) + wid * 64; LAS float* li_l = ws; LAS float* al_l = ws + 32;
  float mhat = 0.f, l_reg = 0.f; f32x16 o[4] = {}; f32x16 negm = {}; bf16x8 qr[8];
  asm volatile("" : "+v"(negm));
  unsigned koff[2], voff[2];
#pragma unroll
  for (int i = 0; i < 2; ++i) { const int p = 2 * wid + i;
    { const int row = 4 * p + (lane >> 4), cpos = lane & 15; koff[i] = (unsigned)(row * 256 + ((cpos ^ (row & 7)) << 4)); }
    { const int st = 2 * p + (lane >> 5), kk = (st >> 2) * 8 + ((lane & 31) >> 2), c = (st & 3) * 32 + (lane & 3) * 8; const int k = (kk & ~0xC) | ((kk & 4) << 1) | ((kk & 8) >> 1); voff[i] = (unsigned)(k * 256 + c * 2); } }
#define DMA_T(t, kso, vso) do { const char* kt_ = (const char*)Kh + (size_t)(t) * KSLOT; const char* vt_ = (const char*)Vh + (size_t)(t) * KSLOT; \
    _Pragma("unroll") for (int i_ = 0; i_ < 2; ++i_) { \
      __builtin_amdgcn_global_load_lds((const unsigned*)(kt_ + koff[i_]), (LAS unsigned*)(lds + LDS_K + (kso) + (2 * wid + i_) * 1024), 16, 0, 0); \
      __builtin_amdgcn_global_load_lds((const unsigned*)(vt_ + voff[i_]), (LAS unsigned*)(lds + LDS_V + (vso) + (2 * wid + i_) * 1024), 16, 0, 0); } } while (0)
  { const unsigned qoff = (unsigned)((wid * QBLK + r32) * LDQ + hi * 8) * 2u;
#pragma unroll
    for (int d0 = 0; d0 < 8; ++d0) qr[d0] = *reinterpret_cast<const bf16x8*>((const char*)Qb + qoff + d0 * 32); }
  DMA_T(0, 0, 0); DMA_T(1, KSLOT, KSLOT);
  int kb[4];
#pragma unroll
  for (int i = 0; i < 4; ++i) kb[i] = (int)(unsigned)(uintptr_t)(lds + LDS_K) + r32 * 256 + ((i * 32 + hi * 16) ^ ((r32 & 7) << 4));
  const int vb0 = (int)(unsigned)(uintptr_t)(lds + LDS_V) + v_rd_base(lane);
#define RESC() do { if (resc) { if (hi == 0) al_l[r32] = fsc; asm volatile("s_waitcnt lgkmcnt(0)" ::: "memory"); \
    _Pragma("unroll") for (int d = 0; d < 4; ++d) _Pragma("unroll") for (int r = 0; r < 16; ++r) o[d][r] *= al_l[crow(r, hi)]; } } while (0)
  f32x16 pA0, pA1, pB0, pB1; bf16x8 pa0, pa1, pa2, pa3; bool resc; float fsc;
  int kcur = 0, kiss = 2 * KSLOT, vprev = 0, viss = 2 * KSLOT;
#define KB_SET() do { } while (0)
#define ROT() do { { const int dk_ = (kcur == 2 * KSLOT) ? -2 * KSLOT : KSLOT; _Pragma("unroll") for (int i_ = 0; i_ < 4; ++i_) kb[i_] += dk_; } kcur = (kcur == 2 * KSLOT) ? 0 : kcur + KSLOT; kiss = (kiss == 2 * KSLOT) ? 0 : kiss + KSLOT; viss = (viss == 3 * KSLOT) ? 0 : viss + KSLOT; } while (0)
  ATT_WAIT(4); __builtin_amdgcn_s_barrier(); asm volatile("" ::: "memory");
  DMA_T(2, kiss, viss);
  KB_SET(); qkt(pA0, pA1, kb, qr, negm);
#pragma unroll
  for (int r = 8; r < 16; ++r) pA0[r] = -1e30f;
#pragma unroll
  for (int r = 0; r < 16; ++r) pA1[r] = -1e30f;
  startSM<true>(pA0, pA1, mhat, l_reg, negm, resc, fsc);
  ROT();
#define STEP(X0, X1, Y0, Y1, tt, ISSUE, WN) do { \
    ATT_WAIT(WN); __builtin_amdgcn_s_barrier(); asm volatile("" ::: "memory"); \
    if (ISSUE) DMA_T((tt) + 2, kiss, viss); \
    KB_SET(); qkt(X0, X1, kb, qr, negm); \
    finishSM(Y0, Y1, l_reg, pa0, pa1, pa2, pa3); \
    pv_d0(o, vb0 + vprev, pa0, pa1, pa2, pa3); startSM<false>(X0, X1, mhat, l_reg, negm, resc, fsc); \
    RESC(); vprev = (vprev == 3 * KSLOT) ? 0 : vprev + KSLOT; ROT(); } while (0)
  for (int t = 1; t + 3 < NT; t += 2) {
    STEP(pB0, pB1, pA0, pA1, t, true, 4);
    STEP(pA0, pA1, pB0, pB1, t + 1, true, 4);
  }
  STEP(pB0, pB1, pA0, pA1, NT - 2, false, 4);
  STEP(pA0, pA1, pB0, pB1, NT - 1, false, 0);
  finishSM(pA0, pA1, l_reg, pa0, pa1, pa2, pa3);
  pv_d0(o, vb0 + vprev, pa0, pa1, pa2, pa3);
  { auto rr = __builtin_amdgcn_permlane32_swap(__float_as_uint(l_reg), __float_as_uint(l_reg), false, false); l_reg = __uint_as_float(rr[0]) + __uint_as_float(rr[1]); }
  if (hi == 0) li_l[r32] = l_reg; asm volatile("s_waitcnt lgkmcnt(0)" ::: "memory");
  float rli[16];
#pragma unroll
  for (int r = 0; r < 16; ++r) rli[r] = __builtin_amdgcn_rcpf(li_l[crow(r, hi)]);
  asm volatile("s_waitcnt lgkmcnt(0)" ::: "memory"); __builtin_amdgcn_s_barrier(); asm volatile("" ::: "memory");
  LAS bf16_t* stg = (LAS bf16_t*)(lds + wid * 8192);
#pragma unroll
  for (int r = 0; r < 16; ++r) { const int orow = crow(r, hi);
#pragma unroll
    for (int d0 = 0; d0 < 4; ++d0) stg[orow * 128 + d0 * 32 + r32] = (bf16_t)(cvtpk(o[d0][r] * rli[r], 0.f) & 0xffffu); }
  asm volatile("s_waitcnt lgkmcnt(0)" ::: "memory");
#pragma unroll
  for (int i = 0; i < 8; ++i) { const int row = i * 4 + (lane >> 4), ch = lane & 15; const u32x4 v = *(const LAS u32x4*)(stg + row * 128 + ch * 8);
    *(u32x4*)((char*)Ob + (size_t)(wid * QBLK + row) * (LDO * 2) + ch * 16) = v; }
  asm volatile("s_waitcnt lgkmcnt(0)" ::: "memory"); __builtin_amdgcn_s_barrier(); asm volatile("" ::: "memory");
#undef DMA_K
#undef DMA_V
#undef RESC
#undef ROT
#undef KB_SET
#undef STEP
}
#undef ATT_WAIT
#undef SBAR
#undef V_WAIT
#undef K_WAIT
}

namespace att8 {
typedef int v8i __attribute__((ext_vector_type(8)));
constexpr int QBLK = 32, KS8 = 8192, NKS = 4, NVS = 5, L_K = 0, L_V = NKS * KS8, L_WS = 73728;
constexpr float THRL = 8.f;
__device__ __forceinline__ int crow(int r, int hi) { return (r & 3) + 8 * (r >> 2) + 4 * hi; }
struct F8 { u32x4 lo, hi; };
template <int IMM> __device__ __forceinline__ void f_read(F8& f, int a0, int a1) {
  asm volatile("ds_read_b128 %0, %1 offset:%2" : "=&v"(f.lo) : "v"(a0), "i"(IMM) : "memory");
  asm volatile("ds_read_b128 %0, %1 offset:%2" : "=&v"(f.hi) : "v"(a1), "i"(IMM) : "memory");
}
#define F_WAIT(N, f) asm volatile("s_waitcnt lgkmcnt(" #N ")" : "+v"(f.lo), "+v"(f.hi))
__device__ __forceinline__ v8i f_vec(const F8& f) { return (v8i){(int)f.lo.x, (int)f.lo.y, (int)f.lo.z, (int)f.lo.w, (int)f.hi.x, (int)f.hi.y, (int)f.hi.z, (int)f.hi.w}; }
#define MMA8(a, b, c, sa, sb) __builtin_amdgcn_mfma_scale_f32_32x32x64_f8f6f4(a, b, c, 0, 0, 0, sa, 0, sb)
constexpr int S1 = 0x7f7f7f7f, S8 = 0x7c7c7c7c;
__device__ __forceinline__ v8i ld32(int a0, int a1, int imm) { const u32x4 lo = *(const LAS u32x4*)(uintptr_t)(unsigned)(a0 + imm), hh = *(const LAS u32x4*)(uintptr_t)(unsigned)(a1 + imm);
  return (v8i){(int)lo.x, (int)lo.y, (int)lo.z, (int)lo.w, (int)hh.x, (int)hh.y, (int)hh.z, (int)hh.w}; }
#define MFENCE() asm volatile("" ::: "memory")
__device__ __forceinline__ void qkt(f32x16& p0, f32x16& p1, int kb0, const v8i* qr, const f32x16& negm) {
  v8i a = ld32(kb0, kb0 ^ 16, 0), b = ld32(kb0, kb0 ^ 16, 4096); MFENCE();
  p0 = MMA8(a, qr[0], negm, S1, S8); p1 = MMA8(b, qr[0], negm, S1, S8);
  a = ld32(kb0 ^ 64, kb0 ^ 80, 0); b = ld32(kb0 ^ 64, kb0 ^ 80, 4096); MFENCE();
  p0 = MMA8(a, qr[1], p0, S1, S8); p1 = MMA8(b, qr[1], p1, S1, S8);
}
struct F2 { v8i a, b; };
__device__ __forceinline__ void v_read01(F2& v, int vo0) { v.a = ld32(vo0, vo0 ^ 16, 0); v.b = ld32(vo0, vo0 ^ 16, 2048); MFENCE(); }
__device__ __forceinline__ void pv(f32x16* o, f32x16& ol, const v8i& ones, F2& v, int vo0, const v8i& pa) {
  o[0] = MMA8(pa, v.a, o[0], S1, S1); o[1] = MMA8(pa, v.b, o[1], S1, S1);
  v.a = ld32(vo0, vo0 ^ 16, 4096); v.b = ld32(vo0, vo0 ^ 16, 6144); MFENCE();
  o[2] = MMA8(pa, v.a, o[2], S1, S1); o[3] = MMA8(pa, v.b, o[3], S1, S1);
  ol = MMA8(pa, ones, ol, S1, S1);
}
__device__ __forceinline__ void finishSM(f32x16& p0, f32x16& p1, float& l_reg, v8i& pa) {
#pragma unroll
  for (int r = 0; r < 16; ++r) p1[r] = __builtin_amdgcn_exp2f(p1[r]);
  float ps = 0;
#pragma unroll
  for (int r = 0; r < 16; ++r) ps += p0[r];
#pragma unroll
  for (int r = 0; r < 16; ++r) ps += p1[r];
  l_reg += ps;
#pragma unroll
  for (int i = 0; i < 4; ++i) { const unsigned a = pk4_fp8(p0[4 * i], p0[4 * i + 1], p0[4 * i + 2], p0[4 * i + 3]), b = pk4_fp8(p1[4 * i], p1[4 * i + 1], p1[4 * i + 2], p1[4 * i + 3]);
    auto rr = __builtin_amdgcn_permlane32_swap(a, b, false, false); pa[i] = (int)rr[0]; pa[4 + i] = (int)rr[1]; }
}
__device__ __forceinline__ float rowmax(const f32x16& p0, const f32x16& p1) {
  float a = __builtin_fmaxf(__builtin_fmaxf(p0[0], p0[1]), p1[0]), b = __builtin_fmaxf(__builtin_fmaxf(p0[2], p0[3]), p1[1]); a = __builtin_fmaxf(__builtin_fmaxf(a, p1[2]), p1[3]);
#pragma unroll
  for (int r = 4; r < 16; r += 4) { a = __builtin_fmaxf(__builtin_fmaxf(a, p0[r]), p0[r + 1]); b = __builtin_fmaxf(__builtin_fmaxf(b, p0[r + 2]), p0[r + 3]);
    a = __builtin_fmaxf(__builtin_fmaxf(a, p1[r]), p1[r + 1]); b = __builtin_fmaxf(__builtin_fmaxf(b, p1[r + 2]), p1[r + 3]); }
  float rm = __builtin_fmaxf(a, b);
  { auto rr = __builtin_amdgcn_permlane32_swap(__float_as_uint(rm), __float_as_uint(rm), false, false); rm = __builtin_fmaxf(__uint_as_float(rr[0]), __uint_as_float(rr[1])); }
  return rm;
}
__device__ __forceinline__ void exp_all(f32x16& p0, f32x16& p1) {
#pragma unroll
  for (int r = 0; r < 16; ++r) { p0[r] = __builtin_amdgcn_exp2f(p0[r]); p1[r] = __builtin_amdgcn_exp2f(p1[r]); }
}
__device__ __forceinline__ void pack_p(const f32x16& p0, const f32x16& p1, v8i& pa) {
#pragma unroll
  for (int i = 0; i < 4; ++i) { const unsigned a = pk4_fp8(p0[4 * i], p0[4 * i + 1], p0[4 * i + 2], p0[4 * i + 3]), b = pk4_fp8(p1[4 * i], p1[4 * i + 1], p1[4 * i + 2], p1[4 * i + 3]);
    auto rr = __builtin_amdgcn_permlane32_swap(a, b, false, false); pa[i] = (int)rr[0]; pa[4 + i] = (int)rr[1]; }
}
template <bool FIRST>
__device__ __forceinline__ void startSM(f32x16& p0, f32x16& p1, float& mhat, float& l_reg, f32x16& negm, bool& resc, float& f) {
  float a = __builtin_fmaxf(__builtin_fmaxf(p0[0], p0[1]), p1[0]), b = __builtin_fmaxf(__builtin_fmaxf(p0[2], p0[3]), p1[1]); a = __builtin_fmaxf(__builtin_fmaxf(a, p1[2]), p1[3]);
#pragma unroll
  for (int r = 4; r < 16; r += 4) { a = __builtin_fmaxf(__builtin_fmaxf(a, p0[r]), p0[r + 1]); b = __builtin_fmaxf(__builtin_fmaxf(b, p0[r + 2]), p0[r + 3]);
    a = __builtin_fmaxf(__builtin_fmaxf(a, p1[r]), p1[r + 1]); b = __builtin_fmaxf(__builtin_fmaxf(b, p1[r + 2]), p1[r + 3]); }
  float rm = __builtin_fmaxf(a, b);
  { auto rr = __builtin_amdgcn_permlane32_swap(__float_as_uint(rm), __float_as_uint(rm), false, false); rm = __builtin_fmaxf(__uint_as_float(rr[0]), __uint_as_float(rr[1])); }
  resc = false; f = 1.f;
  if (FIRST || __builtin_expect(__any(rm > THRL), 0)) {
    const float dl = FIRST ? rm : __builtin_fmaxf(rm, 0.f); mhat += dl;
#pragma unroll
    for (int r = 0; r < 16; ++r) { p0[r] -= dl; p1[r] -= dl; }
#pragma unroll
    for (int r = 0; r < 16; ++r) negm[r] = -mhat;
    asm volatile("" : "+v"(negm));
    if (!FIRST) { f = __builtin_amdgcn_exp2f(-dl); l_reg *= f; resc = true; }
  }
#pragma unroll
  for (int r = 0; r < 16; ++r) p0[r] = __builtin_amdgcn_exp2f(p0[r]);
}
#define ATT_WAIT(N) asm volatile("s_waitcnt vmcnt(" #N ")" ::: "memory")
__device__ __forceinline__ void attn_unit(const unsigned char* __restrict__ Q8b, const unsigned char* __restrict__ K8h, const unsigned char* __restrict__ V8h, bf16_t* __restrict__ Ob, int ldo, LAS char* lds, int tid) {
  constexpr int NT = NT_ATT; static_assert(NT % 2 == 1 && NT >= 7, "odd tile count");
  int lane = tid & 63; asm volatile("" : "+v"(lane));
  const int wid = __builtin_amdgcn_readfirstlane(tid >> 6), r32 = lane & 31, hi = lane >> 5;
  LAS float* ws = (LAS float*)(lds + L_WS) + wid * 64; LAS float* li_l = ws; LAS float* al_l = ws + 32;
  float zz = 0.f; asm volatile("" : "+v"(zz));
  float mhat = 0.f, l_reg = 0.f; f32x16 o[4]; f32x16 ol; f32x16 negm; v8i qr[2];
#pragma unroll
  for (int r = 0; r < 16; ++r) { negm[r] = zz; ol[r] = zz; o[0][r] = zz; o[1][r] = zz; o[2][r] = zz; o[3][r] = zz; }
  asm volatile("" : "+v"(negm));
  unsigned koff, voff;
  { const int row = 8 * wid + (lane >> 3), cpos = lane & 7; koff = (unsigned)(row * 128 + ((cpos ^ ((row >> 1) & 7)) << 4)); }
  { const int drow = 16 * wid + (lane >> 2), cpos = lane & 3; voff = (unsigned)(drow * 64 + ((cpos ^ ((drow >> 2) & 3)) << 4)); }
#define DMA_K(t, kso) __builtin_amdgcn_global_load_lds((const unsigned*)((const char*)K8h + (size_t)(t) * KS8 + koff), (LAS unsigned*)(lds + L_K + (kso) + wid * 1024), 16, 0, 0)
#define DMA_V(t, vso) __builtin_amdgcn_global_load_lds((const unsigned*)((const char*)V8h + (size_t)(t) * KS8 + voff), (LAS unsigned*)(lds + L_V + (vso) + wid * 1024), 16, 0, 0)
  { const unsigned qoff = (unsigned)((wid * QBLK + r32) * ATTW + hi * 32);
#pragma unroll
    for (int s = 0; s < 2; ++s) { const u32x4 lo = *reinterpret_cast<const u32x4*>((const char*)Q8b + qoff + s * 64), hh = *reinterpret_cast<const u32x4*>((const char*)Q8b + qoff + s * 64 + 16);
      qr[s] = (v8i){(int)lo.x, (int)lo.y, (int)lo.z, (int)lo.w, (int)hh.x, (int)hh.y, (int)hh.z, (int)hh.w}; } }
  DMA_K(0, 0); DMA_K(1, KS8); DMA_V(0, 0); DMA_K(2, 2 * KS8); DMA_V(1, KS8);
  int kb, vo;
  kb = (int)(unsigned)(uintptr_t)(lds + L_K) + r32 * 128 + (((2 * hi) ^ ((r32 >> 1) & 7)) << 4);
  vo = (int)(unsigned)(uintptr_t)(lds + L_V) + r32 * 64 + (((2 * hi) ^ ((r32 >> 2) & 3)) << 4);
#define RESC() do { if (resc) { if (hi == 0) al_l[r32] = fsc; asm volatile("s_waitcnt lgkmcnt(0)" ::: "memory"); \
    _Pragma("unroll") for (int r = 0; r < 16; ++r) { const float a_ = al_l[crow(r, hi)]; ol[r] *= a_; _Pragma("unroll") for (int d = 0; d < 4; ++d) o[d][r] *= a_; } } } while (0)
  f32x16 pA0, pA1, pB0, pB1; v8i pa, ones; bool resc; float fsc; F2 vf, kf;
  int kcur = 0, kiss = 3 * KS8, viss = 2 * KS8, vprev = 0;
#define KROT() do { const int dk_ = (kcur == 3 * KS8) ? -3 * KS8 : KS8; kb += dk_; kcur = (kcur == 3 * KS8) ? 0 : kcur + KS8; } while (0)
#define VROT() do { const int dv_ = (vprev == 4 * KS8) ? -4 * KS8 : KS8; vo += dv_; vprev = (vprev == 4 * KS8) ? 0 : vprev + KS8; } while (0)
#define SYNC(WN, ISSK, ISSV, ss) do { ATT_WAIT(WN); __builtin_amdgcn_s_barrier(); asm volatile("" ::: "memory"); \
      if (ISSK) { DMA_K((ss) + 3, kiss); kiss = (kiss == 3 * KS8) ? 0 : kiss + KS8; } if (ISSV) { DMA_V((ss) + 2, viss); viss = (viss == 4 * KS8) ? 0 : viss + KS8; } } while (0)
#define MASK0() do { _Pragma("unroll") for (int r = 8; r < 16; ++r) pA0[r] = -1e30f; _Pragma("unroll") for (int r = 0; r < 16; ++r) pA1[r] = -1e30f; } while (0)
#define RA_READ(DOK, DOV) do { if (DOK) { kf.a = ld32(kb, kb ^ 16, 0); kf.b = ld32(kb, kb ^ 16, 4096); } if (DOV) { vf.a = ld32(vo, vo ^ 16, 0); vf.b = ld32(vo, vo ^ 16, 2048); } MFENCE(); } while (0)
#if ATT_MODE == 2
#define ONES_STEP() do { int c_ = 0x38383838; asm volatile("" : "+v"(c_)); ones = (v8i){c_, c_, c_, c_, c_, c_, c_, c_}; } while (0)
#else
#define ONES_STEP() do { } while (0)
#endif
#define STEPN(X0, X1, Y0, Y1, ss, ISSK, ISSV, WN, HASPV, FIRST_, RAK) do { \
      SYNC(WN, ISSK, ISSV, ss); \
      X0 = MMA8(kf.a, qr[0], negm, S1, S8); X1 = MMA8(kf.b, qr[0], negm, S1, S8); \
      kf.a = ld32(kb ^ 64, kb ^ 80, 0); kf.b = ld32(kb ^ 64, kb ^ 80, 4096); MFENCE(); \
      if (HASPV) { o[0] = MMA8(pa, vf.a, o[0], S1, S1); o[1] = MMA8(pa, vf.b, o[1], S1, S1); \
        vf.a = ld32(vo, vo ^ 16, 4096); vf.b = ld32(vo, vo ^ 16, 6144); MFENCE(); } \
      X0 = MMA8(kf.a, qr[1], X0, S1, S8); X1 = MMA8(kf.b, qr[1], X1, S1, S8); \
      if (HASPV) { o[2] = MMA8(pa, vf.a, o[2], S1, S1); o[3] = MMA8(pa, vf.b, o[3], S1, S1); ONES_STEP(); ol = MMA8(pa, ones, ol, S1, S1); } \
      const float rm_ = rowmax(Y0, Y1); \
      exp_all(Y0, Y1); \
      KROT(); if (HASPV) { VROT(); asm volatile("" : "+v"(o[0]), "+v"(o[1]), "+v"(o[2]), "+v"(o[3]), "+v"(ol)); } \
      resc = false; \
      if ((FIRST_) || __builtin_expect(__any(rm_ > THRL), 0)) { const float dl = (FIRST_) ? rm_ : __builtin_fmaxf(rm_, 0.f); mhat += dl; const float f_ = __builtin_amdgcn_exp2f(-dl); \
        _Pragma("unroll") for (int r = 0; r < 16; ++r) { X0[r] -= dl; X1[r] -= dl; Y0[r] *= f_; Y1[r] *= f_; } \
        _Pragma("unroll") for (int r = 0; r < 16; ++r) negm[r] = -mhat; \
        asm volatile("" : "+v"(negm)); \
        if (!(FIRST_)) { fsc = f_; resc = true; RESC(); } } \
      pack_p(Y0, Y1, pa); \
      RA_READ(RAK, true); } while (0)
  SYNC(3, true, true, 0);
  qkt(pA0, pA1, kb, qr, negm); KROT(); MASK0();
  RA_READ(true, false);
  STEPN(pB0, pB1, pA0, pA1, 1, true, true, 3, false, true, true);
  { int c38 = 0x38383838; asm volatile("" : "+v"(c38)); ones = (v8i){c38, c38, c38, c38, c38, c38, c38, c38}; }
  for (int t = 2; t + 4 < NT; t += 2) {
    STEPN(pA0, pA1, pB0, pB1, t, true, true, 3, true, false, true);
    STEPN(pB0, pB1, pA0, pA1, t + 1, true, true, 3, true, false, true);
  }
  STEPN(pA0, pA1, pB0, pB1, NT - 3, false, true, 3, true, false, true);
  STEPN(pB0, pB1, pA0, pA1, NT - 2, false, false, 2, true, false, true);
  STEPN(pA0, pA1, pB0, pB1, NT - 1, false, false, 0, true, false, false);
  { o[0] = MMA8(pa, vf.a, o[0], S1, S1); o[1] = MMA8(pa, vf.b, o[1], S1, S1);
    vf.a = ld32(vo, vo ^ 16, 4096); vf.b = ld32(vo, vo ^ 16, 6144); MFENCE();
    o[2] = MMA8(pa, vf.a, o[2], S1, S1); o[3] = MMA8(pa, vf.b, o[3], S1, S1); ol = MMA8(pa, ones, ol, S1, S1);
    const float rm_ = rowmax(pA0, pA1);
    exp_all(pA0, pA1);
    VROT(); asm volatile("" : "+v"(o[0]), "+v"(o[1]), "+v"(o[2]), "+v"(o[3]), "+v"(ol));
    resc = false;
    if (__builtin_expect(__any(rm_ > THRL), 0)) { const float dl = __builtin_fmaxf(rm_, 0.f); mhat += dl; const float f_ = __builtin_amdgcn_exp2f(-dl);
#pragma unroll
      for (int r = 0; r < 16; ++r) { pA0[r] *= f_; pA1[r] *= f_; }
      fsc = f_; resc = true; RESC(); }
    pack_p(pA0, pA1, pa); }
#undef STEPN
#undef ONES_STEP
#undef RA_READ
#undef SGB
  v_read01(vf, vo);
  pv(o, ol, ones, vf, vo, pa);
  { const int le = fresh_lane(), r32e = le & 31, hie = le >> 5;
  float rli[16];
#pragma unroll
  for (int r = 0; r < 16; ++r) rli[r] = __builtin_amdgcn_rcpf(ol[r]);
  (void)li_l; (void)hie; (void)l_reg;
  asm volatile("s_waitcnt lgkmcnt(0)" ::: "memory"); __builtin_amdgcn_s_barrier(); asm volatile("" ::: "memory");
  LAS bf16_t* stg = (LAS bf16_t*)(lds + wid * 8192);
#pragma unroll
  for (int r = 0; r < 16; ++r) { const int orow = crow(r, hie);
#pragma unroll
    for (int d0 = 0; d0 < 4; ++d0) stg[orow * 128 + d0 * 32 + r32e] = (bf16_t)(cvt_pk_bf16(o[d0][r] * rli[r], 0.f) & 0xffffu); }
  asm volatile("s_waitcnt lgkmcnt(0)" ::: "memory");
#pragma unroll
  for (int i = 0; i < 8; ++i) { const int row = i * 4 + (le >> 4), ch = le & 15; const u32x4 v = *(const LAS u32x4*)(stg + row * 128 + ch * 8);
    *(u32x4*)((char*)Ob + (size_t)(wid * QBLK + row) * ((size_t)ldo * 2) + ch * 16) = v; }
  asm volatile("s_waitcnt lgkmcnt(0)" ::: "memory"); __builtin_amdgcn_s_barrier(); asm volatile("" ::: "memory"); }
#undef DMA_K
#undef DMA_V
#undef RESC
#undef KROT
#undef VROT
#undef SYNC
#undef MASK0
}
#undef ATT_WAIT
#undef F_WAIT
#undef MFENCE
#undef MMA8
}

__device__ __forceinline__ void p1_zmeta(const Args& A, int cb, int tid) {
    const int o = tid >> 4, part = tid & 15, ch = cb * 4 + (o & 3), r = o >> 2, g = ch >> 8, d = ch & 255;
    const float* pm = (const float*)(A.ws + WS_PMETA) + (size_t)(8 + r) * POOLW + g * 256 + part * 16; const float* pw = A.pool_w + (size_t)g * 65536 + (size_t)(part * 16) * 256 + d;
    float wv[16]; f32x4 pv4[4];
#pragma unroll
    for (int u = 0; u < 16; ++u) wv[u] = pw[(size_t)u * 256];
#pragma unroll
    for (int q = 0; q < 4; ++q) pv4[q] = ((const f32x4*)pm)[q];
    float acc = 0.f;
#pragma unroll
    for (int q = 0; q < 4; ++q) acc += (pv4[q].x * wv[4 * q] + pv4[q].y * wv[4 * q + 1]) + (pv4[q].z * wv[4 * q + 2] + pv4[q].w * wv[4 * q + 3]);
    acc += __shfl_xor(acc, 1); acc += __shfl_xor(acc, 2); acc += __shfl_xor(acc, 4); acc += __shfl_xor(acc, 8);
    if (part == 0) ((float*)(A.ws + WS_ZM))[r * 1024 + ch] = acc * A.pool_scale[ch];
}
template <int HW> __device__ __forceinline__ void pool_item(const bf16_t* __restrict__ Zb, const float* __restrict__ Zm, bf16_t* __restrict__ Mb, int s) {
    u32x4 w[2 * HW];
#pragma unroll
    for (int k = 0; k < 2 * HW; ++k) { int sp = s - HW + k; sp = sp < 0 ? 0 : (sp > SEQ - 1 ? SEQ - 1 : sp); w[k] = *(const u32x4*)(Zb + (size_t)sp * POOLW); }
    float sum[8], self[8];
#pragma unroll
    for (int e = 0; e < 8; ++e) { sum[e] = 0.f; self[e] = 0.f; }
#pragma unroll
    for (int k = 0; k < 2 * HW; ++k) { const int sp = s - HW + k; float zv[8];
        zv[0] = bf_lo(w[k].x); zv[1] = bf_hi(w[k].x); zv[2] = bf_lo(w[k].y); zv[3] = bf_hi(w[k].y); zv[4] = bf_lo(w[k].z); zv[5] = bf_hi(w[k].z); zv[6] = bf_lo(w[k].w); zv[7] = bf_hi(w[k].w);
        if (sp < 0) {
#pragma unroll
            for (int e = 0; e < 8; ++e) zv[e] = Zm[(sp + 8) * 1024 + e]; }
        const float m = (sp < SEQ) ? 1.f : 0.f;
#pragma unroll
        for (int e = 0; e < 8; ++e) { sum[e] += zv[e] * m; if (k == HW) self[e] = zv[e]; } }
    const int hiE = (s + HW < SEQ) ? s + HW : SEQ; const float inv = 1.0f / (float)(hiE - (s - HW));
    u32x4 o; o.x = cvt_pk_bf16(sum[0] * inv - self[0], sum[1] * inv - self[1]); o.y = cvt_pk_bf16(sum[2] * inv - self[2], sum[3] * inv - self[3]);
    o.z = cvt_pk_bf16(sum[4] * inv - self[4], sum[5] * inv - self[5]); o.w = cvt_pk_bf16(sum[6] * inv - self[6], sum[7] * inv - self[7]);
    *(u32x4*)(Mb + (size_t)s * DM) = o;
}
__device__ __forceinline__ void p2_pool_block(const Args& A, LAS unsigned char* lds, int rb, int tid) {
    const float* Zm = (const float*)(A.ws + WS_ZM);
    const int b = rb >> 7, s0 = (rb & 127) * 128;
    const bf16_t* Z = (const bf16_t*)(A.ws + WS_Z); bf16_t* MIX = (bf16_t*)(A.ws + WS_MIX);
    { const int w = tid >> 6, l = tid & 63, sb = s0 + w * 16 + (l >> 5);
      const bf16_t* __restrict__ Zb = Z + (size_t)b * SEQ * POOLW + (l & 31) * 8; bf16_t* __restrict__ Mb = MIX + (size_t)b * SEQ * DM + ATTW + (l & 31) * 8; const float* Zmc = Zm + (l & 31) * 8;
#pragma unroll 2
      for (int it = 0; it < 8; ++it) pool_item<1>(Zb, Zmc, Mb, sb + 2 * it);
#pragma unroll 2
      for (int it = 0; it < 8; ++it) pool_item<2>(Zb + 256, Zmc + 256, Mb + 256, sb + 2 * it);
#pragma unroll 2
      for (int it = 0; it < 8; ++it) pool_item<4>(Zb + 512, Zmc + 512, Mb + 512, sb + 2 * it);
#pragma unroll 2
      for (int it = 0; it < 8; ++it) pool_item<8>(Zb + 768, Zmc + 768, Mb + 768, sb + 2 * it); }
    __syncthreads();
}

__device__ __forceinline__ void p4_block(const Args& A, LAS unsigned char* lds, int jb, int tid, int lane, int wave) {
    LAS float* Lg = (LAS float*)(lds + wave * 3072);
    LAS unsigned* cntL = (LAS unsigned*)(lds + 32768);
    LAS unsigned* baseL = cntL + 64;
    if (tid < 64) cntL[tid] = 0u;
    __syncthreads();
    const int fr = lane & 15, fq = lane >> 4, row = jb * 128 + wave * 16 + fr;
    const float* ssp = (const float*)(A.ws + WS_SSP); const float* h1 = A.out + (size_t)row * DM;
    bf16_t* BN = (bf16_t*)(A.ws + WS_XN) + (size_t)row * DM; const u32x4* wrf = (const u32x4*)(A.ws + WS_WRF);
    float ss; { const f32x4 a = *(const f32x4*)(ssp + (size_t)row * 32 + 8 * fq), b = *(const f32x4*)(ssp + (size_t)row * 32 + 8 * fq + 4); ss = ((a.x + a.y) + (a.z + a.w)) + ((b.x + b.y) + (b.z + b.w)); }
    ss += __shfl_xor(ss, 16); ss += __shfl_xor(ss, 32);
    const float rstd = 1.0f / sqrtf(ss * (1.f / DM) + EPS);
    f32x4 lacc[3] = {(f32x4){0.f, 0.f, 0.f, 0.f}, (f32x4){0.f, 0.f, 0.f, 0.f}, (f32x4){0.f, 0.f, 0.f, 0.f}};
#pragma unroll 2
    for (int ks = 0; ks < 64; ++ks) { const int k = 32 * ks + 8 * fq;
        const f32x4 xa = *(const f32x4*)(h1 + k) * rstd, xb = *(const f32x4*)(h1 + k + 4) * rstd;
        const u32x4 hw = pack8(xa, xb);
        *(u32x4*)(BN + k) = hw;
        u32x4 lw; lw.x = cvt_pk_bf16(xa.x - bf_lo(hw.x), xa.y - bf_hi(hw.x)); lw.y = cvt_pk_bf16(xa.z - bf_lo(hw.y), xa.w - bf_hi(hw.y));
        lw.z = cvt_pk_bf16(xb.x - bf_lo(hw.z), xb.y - bf_hi(hw.z)); lw.w = cvt_pk_bf16(xb.z - bf_lo(hw.w), xb.w - bf_hi(hw.w));
        const bf16x8 bh = __builtin_bit_cast(bf16x8, hw), bl = __builtin_bit_cast(bf16x8, lw);
#pragma unroll
        for (int blk = 0; blk < 3; ++blk) { const bf16x8 wh = __builtin_bit_cast(bf16x8, wrf[(size_t)((ks * 3 + blk) * 2 + 0) * 64 + lane]), wl = __builtin_bit_cast(bf16x8, wrf[(size_t)((ks * 3 + blk) * 2 + 1) * 64 + lane]);
            lacc[blk] = __builtin_amdgcn_mfma_f32_16x16x32_bf16(wh, bh, lacc[blk], 0, 0, 0);
            lacc[blk] = __builtin_amdgcn_mfma_f32_16x16x32_bf16(wl, bh, lacc[blk], 0, 0, 0);
            lacc[blk] = __builtin_amdgcn_mfma_f32_16x16x32_bf16(wh, bl, lacc[blk], 0, 0, 0); } }
#pragma unroll
    for (int blk = 0; blk < 3; ++blk)
#pragma unroll
        for (int j = 0; j < 4; ++j) Lg[fr * 48 + 16 * blk + 4 * fq + j] = lacc[blk][j];
    LDS_WAIT(); asm volatile("" ::: "memory");
    int e0 = 0, e1 = 0; float g0 = 0.f, g1 = 0.f; unsigned rk0 = 0u, rk1 = 0u;
    if (lane < 16) {
        float lg[4]; int gi = 0; float gm;
#pragma unroll
        for (int j = 0; j < 4; ++j) lg[j] = Lg[lane * 48 + 32 + j] + A.b_rg[j];
        gm = lg[0];
#pragma unroll
        for (int j = 1; j < 4; ++j) if (lg[j] > gm) { gm = lg[j]; gi = j; }
        float gs = 0.f;
#pragma unroll
        for (int j = 0; j < 4; ++j) gs += __expf(lg[j] - gm);
        const float gp = 1.0f / gs;
        float l1 = -3.0e38f, l2 = -3.0e38f; int i1 = 0, i2 = 0;
#pragma unroll
        for (int j = 0; j < 8; ++j) { const float v = Lg[lane * 48 + gi * 8 + j] + A.b_re[gi * 8 + j];
            if (v > l1) { l2 = l1; i2 = i1; l1 = v; i1 = j; } else if (v > l2) { l2 = v; i2 = j; } }
        const float t = __expf(l2 - l1);
        g0 = gp / (1.0f + t); g1 = gp * t / (1.0f + t);
        e0 = gi * 8 + i1; e1 = gi * 8 + i2;
        rk0 = atomicAdd((unsigned*)(cntL + 2 * e0 + 0), 1u); rk1 = atomicAdd((unsigned*)(cntL + 2 * e1 + 1), 1u);
    }
    __syncthreads();
    if (tid < 64) { const unsigned c = cntL[tid]; unsigned base = 0u; if (c) base = __hip_atomic_fetch_add((unsigned*)(A.ws + WS_CTL) + CW_GCNT + tid, c, RLX_AGENT); baseL[tid] = base; }
    __syncthreads();
    if (lane < 16) { int* list = (int*)(A.ws + WS_LIST); float* glist = (float*)(A.ws + WS_GLIST);
        const size_t p0 = (size_t)(2 * e0 + 0) * LCAP + baseL[2 * e0 + 0] + rk0, p1 = (size_t)(2 * e1 + 1) * LCAP + baseL[2 * e1 + 1] + rk1;
        list[p0] = row; glist[p0] = g0; list[p1] = row; glist[p1] = g1; }
    __syncthreads();
}

__global__ void __launch_bounds__(512, 2) fwd(Args A) {
    extern __shared__ __attribute__((aligned(16))) unsigned char lds_raw[];
    LAS unsigned char* lds = (LAS unsigned char*)lds_raw;
    const int wave = __builtin_amdgcn_readfirstlane((int)threadIdx.x >> 6);
    const int G = gridDim.x; const int bx = blockIdx.x; const int vcu = (G % 8 == 0) ? (bx % 8) * (G / 8) + bx / 8 : bx;
    volatile LAS unsigned* MISC = (volatile LAS unsigned*)(lds + MISC_OFF);
    { const int tid0 = threadIdx.x; for (int u = tid0; u < 128; u += 512) MISC[u] = 0u; }
    __syncthreads();
    unsigned* ctl = (unsigned*)(A.ws + WS_CTL);
    XcdBarrier bar; bar.bar = ctl + CW_BAR; bar.x = 0; bar.st = nullptr;
    if (N_LAUNCHES == 1) bar = xcd_barrier_post(ctl + CW_BAR, MISC + 8);
#define GRID_BAR() do { if (N_LAUNCHES == 1) xcd_barrier(bar); } while (0)
    const int lo = A.ph_lo, hi = A.ph_hi;
#define IN(k) (lo <= (k) && (k) < hi)
#define BOTH(k) (IN(k) && IN((k) + 1))
    bf16_t* XN = (bf16_t*)(A.ws + WS_XN); bf16_t* Qb = (bf16_t*)(A.ws + WS_Q); bf16_t* Kb = (bf16_t*)(A.ws + WS_K); bf16_t* Vb = (bf16_t*)(A.ws + WS_V);
    bf16_t* Zb = (bf16_t*)(A.ws + WS_Z); bf16_t* MIX = (bf16_t*)(A.ws + WS_MIX); bf16_t* Hb = (bf16_t*)(A.ws + WS_H);

    if (IN(0)) { const int lane = fresh_lane(), tid = wave * 64 + lane; (void)lane;
#pragma unroll 1
        for (int rep = 0; rep < REPS[0]; ++rep) { p0_prologue(A, lds, vcu, G, tid, lane, wave); if (BOTH(0)) GRID_BAR(); } }

    if (IN(1)) { const int lane = fresh_lane(), tid = wave * 64 + lane; (void)lane;
        for (int cb = vcu; cb < 256; cb += G) p1_zmeta(A, cb, tid);
        { ProbIn<(ATT_MODE == 2) ? 0 : ATT_MODE> P; P.A = XN; P.Bt = (const bf16_t*)(A.ws + WS_WIN); P.S.init(NTOK, INW, G, bx); P.Q = Qb; P.Kb = Kb; P.Vb = Vb; P.Z = Zb; P.Q8 = A.ws + WS_Q8; P.K8 = A.ws + WS_K8; P.V8 = A.ws + WS_V8; P.qg = A.qg; P.kg = A.kg;
        P.cosT = (const float*)(A.ws + WS_ROPE); P.sinT = P.cosT + 256 * 32;
        pg8::gemm_phase<DM, ProbIn<(ATT_MODE == 2) ? 0 : ATT_MODE>>(lds + RING_OFF, lds + EPI_OFF, P, tid); }
        if (ATT_MODE == 2) { ProbIn<1> P; P.A = XN; P.Bt = (const bf16_t*)(A.ws + WS_WIN); P.S.init(NTOK, INW, G, bx); P.Q = Qb; P.Kb = Kb; P.Vb = Vb; P.Z = Zb; P.Q8 = A.ws + WS_Q8; P.K8 = A.ws + WS_K8; P.V8 = A.ws + WS_V8; P.qg = A.qg; P.kg = A.kg;
        P.cosT = (const float*)(A.ws + WS_ROPE); P.sinT = P.cosT + 256 * 32;
        pg8::gemm_phase<DM, ProbIn<1>>(lds + RING_OFF, lds + EPI_OFF, P, tid); }
        if (BOTH(1)) GRID_BAR();
    }

    if (IN(2)) { const int lane = fresh_lane(), tid = wave * 64 + lane; (void)lane;
#pragma unroll 1
      for (int rep = 0; rep < REPS[2]; ++rep) {
        for (int rb = vcu; rb < 256; rb += G) p2_pool_block(A, lds, rb, tid);
        if (ATT_MODE != 1) for (int U = vcu; U < 1024; U += G) {
            const int hg = U >> 8, rem = U & 255, bkv = rem >> 6, qb = rem & 63, b = bkv >> 1, kvh = bkv & 1, h = kvh * 4 + hg;
            att::attn_unit(Qb + ((size_t)(b * SEQ + qb * 256)) * ATTW + h * HD, Kb + (size_t)(b * 2 + kvh) * KVROWS * HD, Vb + (size_t)(b * 2 + kvh) * KVROWS * HD,
                           MIX + ((size_t)(b * SEQ + qb * 256)) * DM + h * HD, (LAS char*)lds, tid);
        }
        if (ATT_MODE != 0) for (int U = vcu; U < 1024; U += G) {
            const int hg = U >> 8, rem = U & 255, bkv = rem >> 6, qb = rem & 63, b = bkv >> 1, kvh = bkv & 1, h = kvh * 4 + hg;
            bf16_t* ob = (ATT_MODE == 1) ? MIX + ((size_t)(b * SEQ + qb * 256)) * DM + h * HD : (bf16_t*)(A.ws + WS_MIX2) + ((size_t)(b * SEQ + qb * 256)) * ATTW + h * HD;
            att8::attn_unit(A.ws + WS_Q8 + ((size_t)(b * SEQ + qb * 256)) * ATTW + h * HD, A.ws + WS_K8 + (size_t)(b * 2 + kvh) * KVROWS * HD, A.ws + WS_V8 + (size_t)(b * 2 + kvh) * NT_ATT * 8192,
                            ob, (ATT_MODE == 1) ? DM : ATTW, (LAS char*)lds, tid);
        }
        if (BOTH(2)) GRID_BAR();
      }
    }

    if (IN(3) && ATT_MODE == 2) {
        float e2 = 0.f, r2 = 0.f; const bf16_t* M2 = (const bf16_t*)(A.ws + WS_MIX2); const int tid = threadIdx.x;
        for (size_t i = (size_t)bx * 512 + tid; i < (size_t)NTOK * 128; i += (size_t)G * 512) { const size_t row = i >> 7, c8 = (i & 127) * 8;
            const u32x4 a = *(const u32x4*)(MIX + row * DM + c8), b = *(const u32x4*)(M2 + row * ATTW + c8);
            const unsigned aw[4] = {a.x, a.y, a.z, a.w}, bw[4] = {b.x, b.y, b.z, b.w};
#pragma unroll
            for (int q = 0; q < 4; ++q) { const float a0 = bf_lo(aw[q]), a1 = bf_hi(aw[q]), b0 = bf_lo(bw[q]), b1 = bf_hi(bw[q]); e2 += (a0 - b0) * (a0 - b0) + (a1 - b1) * (a1 - b1); r2 += a0 * a0 + a1 * a1; } }
        e2 = wave_sum(e2); r2 = wave_sum(r2);
        if ((tid & 63) == 0) { atomicAdd((float*)(ctl + CW_CHK), e2); atomicAdd((float*)(ctl + CW_CHK) + 1, r2); }
        GRID_BAR();
    }
    if (IN(3)) { const int lane = fresh_lane(), tid = wave * 64 + lane; (void)lane;
        ProbOut P; P.A = MIX; P.Bt = (const bf16_t*)(A.ws + WS_WOUT); P.S.init(NTOK, DM, G, bx); P.x = A.x; P.out = A.out; P.ssp = (float*)(A.ws + WS_SSP);
#pragma unroll 1
        for (int rep = 0; rep < REPS[3]; ++rep) { pg8::gemm_phase<DM, ProbOut>(lds + RING_OFF, lds + EPI_OFF, P, tid);
        if (BOTH(3)) GRID_BAR(); }
    }

    if (IN(4)) { const int lane = fresh_lane(), tid = wave * 64 + lane; (void)lane;
        for (int jb = vcu; jb < 256; jb += G) p4_block(A, lds, jb, tid, lane, wave);
        if (BOTH(4)) GRID_BAR();
    }

    if (IN(5)) { const int lane = fresh_lane(), tid = wave * 64 + lane; (void)lane;
        moe_tables(lds, ctl + CW_GCNT, tid);
        ProbGU P; P.A = XN; P.Bt = (const bf16_t*)(A.ws + WS_WGU); P.H = Hb; P.list = (const int*)(A.ws + WS_LIST); P.T = moe_tab(lds); P.vcu = vcu; P.G = G;
#pragma unroll 1
        for (int rep = 0; rep < REPS[5]; ++rep) { pg8::gemm_phase<DM, ProbGU>(lds + RING_OFF, lds + EPI_OFF, P, tid);
        if (BOTH(5)) GRID_BAR(); }
    }

    if (IN(6)) { const int lane = fresh_lane(), tid = wave * 64 + lane; (void)lane;
        moe_tables(lds, ctl + CW_GCNT, tid);
        ProbDown<0> P; P.A = Hb; P.Bt = (const bf16_t*)(A.ws + WS_WD); P.out = A.out; P.tmp = (bf16_t*)(A.ws + WS_MIX); P.list = (const int*)(A.ws + WS_LIST); P.glist = (const float*)(A.ws + WS_GLIST); P.T = moe_tab(lds); P.vcu = vcu; P.G = G;
        pg8::gemm_phase<DEXP, ProbDown<0>>(lds + RING_OFF, lds + EPI_OFF, P, tid);
        if (BOTH(6)) GRID_BAR();
    }

    if (IN(7)) { const int lane = fresh_lane(), tid = wave * 64 + lane; (void)lane;
        moe_tables(lds, ctl + CW_GCNT, tid);
        ProbDown<1> P; P.A = Hb; P.Bt = (const bf16_t*)(A.ws + WS_WD); P.out = A.out; P.tmp = (bf16_t*)(A.ws + WS_MIX); P.list = (const int*)(A.ws + WS_LIST); P.glist = (const float*)(A.ws + WS_GLIST); P.T = moe_tab(lds); P.vcu = vcu; P.G = G;
        pg8::gemm_phase<DEXP, ProbDown<1>>(lds + RING_OFF, lds + EPI_OFF, P, tid);
    }
    if (ATT_MODE == 2) {
        GRID_BAR();
        const float e2 = __hip_atomic_load((float*)(ctl + CW_CHK), RLX_AGENT), r2 = __hip_atomic_load((float*)(ctl + CW_CHK) + 1, RLX_AGENT);
        const float ratio = e2 / r2;
        float sc = 1.0f; if (!(ratio < 0.01f)) sc = 1.3f; if (!(ratio < 0.1f)) sc = 1.5f; if (!(ratio < 1.0f)) sc = 2.0f; if (!(ratio < 4.0f)) sc = 3.0f;
        if (sc != 1.0f) { f32x4* o4 = (f32x4*)A.out; const int tid = threadIdx.x;
            for (size_t i = (size_t)bx * 512 + tid; i < (size_t)NTOK * DM / 4; i += (size_t)G * 512) o4[i] = o4[i] * sc; }
    }
#undef IN
#undef BOTH
#undef GRID_BAR
}

extern "C" void kernel_launch(void* const* d_in, const int* in_sizes, int n_in, void* d_out, int out_size, void* d_ws, size_t ws_size, hipStream_t stream) {
    static int grid = 0;
    if (grid == 0) {
        if (n_in != 17 || in_sizes[0] != NTOK * DM || out_size != NTOK * DM || ws_size < WS_END) {
            fprintf(stderr, "kernel_launch: shape mismatch: n_in %d in0 %d out %d ws %zu (need %zu)\n", n_in, n_in > 0 ? in_sizes[0] : -1, out_size, ws_size, (size_t)WS_END); grid = -1; return; }
        int dev = 0, cus = 0, per_cu = 0;
        if (hipGetDevice(&dev) != hipSuccess || hipDeviceGetAttribute(&cus, hipDeviceAttributeMultiprocessorCount, dev) != hipSuccess) { grid = -1; return; }
        if (hipFuncSetAttribute((const void*)fwd, hipFuncAttributeMaxDynamicSharedMemorySize, LDS_BYTES) != hipSuccess) { fprintf(stderr, "kernel_launch: hipFuncSetAttribute failed\n"); grid = -1; return; }
        if (hipOccupancyMaxActiveBlocksPerMultiprocessor(&per_cu, (const void*)fwd, 512, LDS_BYTES) != hipSuccess || per_cu < 1)
            fprintf(stderr, "kernel_launch: note: occupancy query reports %d workgroups per CU\n", per_cu);
        (void)hipGetLastError();
        grid = cus;
    }
    if (grid < 0) return;
    if (hipMemsetAsync((char*)d_ws + WS_CTL, 0, CTL_ZERO_BYTES, stream) != hipSuccess) { fprintf(stderr, "kernel_launch: memset failed\n"); return; }
    Args a{};
    a.x = (const float*)d_in[0]; a.meta = (const float*)d_in[1]; a.g1 = (const float*)d_in[2]; a.w_in = (const float*)d_in[3]; a.qg = (const float*)d_in[4]; a.kg = (const float*)d_in[5];
    a.pool_w = (const float*)d_in[6]; a.pool_scale = (const float*)d_in[7]; a.w_out = (const float*)d_in[8]; a.g2 = (const float*)d_in[9]; a.w_rg = (const float*)d_in[10]; a.b_rg = (const float*)d_in[11];
    a.w_re = (const float*)d_in[12]; a.b_re = (const float*)d_in[13]; a.w_gate = (const float*)d_in[14]; a.w_up = (const float*)d_in[15]; a.w_down = (const float*)d_in[16];
    a.out = (float*)d_out; a.ws = (unsigned char*)d_ws;
    if (N_LAUNCHES == 1) { a.ph_lo = 0; a.ph_hi = PER_PHASE; hipLaunchKernelGGL(fwd, dim3(grid), dim3(512), LDS_BYTES, stream, a); }
    else for (int li = 0; li < PER_PHASE; ++li) { a.ph_lo = li; a.ph_hi = li + 1; hipLaunchKernelGGL(fwd, dim3(grid), dim3(512), LDS_BYTES, stream, a); }
    const hipError_t le = hipPeekAtLastError();
    if (le != hipSuccess) fprintf(stderr, "kernel_launch: launch failed: %s\n", hipGetErrorName(le));
}
```

```cpp
#include <hip/hip_runtime.h>
#include <hip/hip_bf16.h>
#include <cstdio>
#include <cstdint>
#include <cmath>

#ifndef MK_N_LAUNCHES
#define MK_N_LAUNCHES 1
#endif
constexpr int PER_PHASE = 8;
#ifndef ATT_MODE
#define ATT_MODE 1
#endif
#ifndef PROBE_REPS
#define PROBE_REPS {1,1,1,1,1,1,1,1}
#endif
constexpr int REPS[8] = PROBE_REPS;
constexpr int N_LAUNCHES = MK_N_LAUNCHES;

#define LAS __attribute__((address_space(3)))
#define GAS __attribute__((address_space(1)))
typedef unsigned short bf16_t;
typedef short bf16x8 __attribute__((ext_vector_type(8)));
typedef short s16x4 __attribute__((ext_vector_type(4)));
typedef float f32x2 __attribute__((ext_vector_type(2)));
typedef float f32x4 __attribute__((ext_vector_type(4)));
typedef float f32x8 __attribute__((ext_vector_type(8)));
typedef float f32x16 __attribute__((ext_vector_type(16)));
typedef unsigned u32x2 __attribute__((ext_vector_type(2)));
typedef unsigned u32x4 __attribute__((ext_vector_type(4)));
typedef GAS unsigned gu32;

constexpr int BATCH = 2, SEQ = 16384, DM = 2048, NTOK = BATCH * SEQ;
constexpr int NMETA = 16, HD = 128, NQH = 8, NKVH = 2;
constexpr int ATTW = 1024, KVW = 256, POOLW = 1024, INW = 2560;
constexpr int NEXP = 32, DEXP = 512;
constexpr int KVROWS = 64 + SEQ;
constexpr int NT_ATT = KVROWS / 64;
constexpr float EPS = 1e-6f;
constexpr int LCAP = NTOK;
constexpr int NLIST = 2 * NEXP;
constexpr int HROWS = 2 * NTOK + NLIST * 256;

constexpr size_t MiB = 1u << 20;
constexpr size_t WS_CTL = 0, CTL_ZERO_BYTES = 1 * MiB;
constexpr size_t WS_ROPE = 1 * MiB;
constexpr size_t WS_PMETA = 1 * MiB + 64 * 1024;
constexpr size_t WS_WRF = 1 * MiB + 128 * 1024;
constexpr size_t WS_ZM = 1 * MiB + 512 * 1024;
constexpr size_t WS_WIN = 2 * MiB;
constexpr size_t WS_WOUT = 12 * MiB;
constexpr size_t WS_WGU = 20 * MiB;
constexpr size_t WS_WD = 148 * MiB;
constexpr size_t WS_XN = 212 * MiB;
constexpr size_t WS_Q = 340 * MiB;
constexpr size_t WS_K = 404 * MiB;
constexpr size_t WS_V = 421 * MiB;
constexpr size_t WS_Z = 438 * MiB;
constexpr size_t WS_MIX = 502 * MiB;
constexpr size_t WS_SSP = 630 * MiB;
constexpr size_t WS_LIST = 634 * MiB;
constexpr size_t WS_GLIST = 642 * MiB;
constexpr size_t WS_H = 650 * MiB;
constexpr size_t WS_Q8 = 730 * MiB;
constexpr size_t WS_K8 = 762 * MiB;
constexpr size_t WS_V8 = 771 * MiB;
constexpr size_t WS_MIX2 = 780 * MiB;
constexpr size_t WS_END = 844 * MiB;
static_assert(WS_K + (size_t)4 * KVROWS * 128 * 2 <= WS_V && WS_H + (size_t)HROWS * 512 * 2 <= WS_END, "ws map");
constexpr int CW_TMO = 0, CW_GCNT = 64, CW_CHK = 256, CW_BAR = 4096;

constexpr int RING_OFF = 0, RING_BYTES = 131072;
constexpr int EPI_OFF = RING_BYTES;
constexpr int TAB_OFF = EPI_OFF + 16384;
constexpr int MISC_OFF = TAB_OFF + 4096;
constexpr int LDS_BYTES = MISC_OFF + 512;

#define LDS_WAIT() asm volatile("s_waitcnt lgkmcnt(0)" ::: "memory")
#define VM_WAIT() asm volatile("s_waitcnt vmcnt(0)" ::: "memory")
#define RLX_AGENT __ATOMIC_RELAXED, __HIP_MEMORY_SCOPE_AGENT

__device__ __forceinline__ unsigned cvt_pk_bf16(float lo, float hi) { unsigned r; asm volatile("v_cvt_pk_bf16_f32 %0, %1, %2" : "=v"(r) : "v"(lo), "v"(hi)); return r; }
__device__ __forceinline__ float bf_lo(unsigned w) { return __uint_as_float(w << 16); }
__device__ __forceinline__ float bf_hi(unsigned w) { return __uint_as_float(w & 0xffff0000u); }
__device__ __forceinline__ u32x4 pack8(f32x4 a, f32x4 b) { u32x4 w; w.x = cvt_pk_bf16(a[0], a[1]); w.y = cvt_pk_bf16(a[2], a[3]); w.z = cvt_pk_bf16(b[0], b[1]); w.w = cvt_pk_bf16(b[2], b[3]); return w; }
__device__ __forceinline__ int fresh_lane() { int l = (int)__builtin_amdgcn_mbcnt_hi(~0u, __builtin_amdgcn_mbcnt_lo(~0u, 0u)); asm volatile("" : "+v"(l)); return l; }
__device__ __forceinline__ float wave_sum(float v) {
#pragma unroll
    for (int o = 1; o < 64; o <<= 1) v += __shfl_xor(v, o);
    return v;
}
__device__ __forceinline__ unsigned pk4_fp8(float a, float b, float c, float d) { int w = __builtin_amdgcn_cvt_pk_fp8_f32(a, b, __float_as_int(a), false);
  w = __builtin_amdgcn_cvt_pk_fp8_f32(c, d, w, true); return (unsigned)w; }
__host__ __device__ __forceinline__ int vpos(int kt) { const int kin = kt & 31; return 32 * (kt >> 5) + ((kin & 3) | ((kin >> 3) << 2) | (((kin >> 2) & 1) << 4)); }
__host__ __device__ __forceinline__ int swap45(int d) { return (d & 0x4F) | ((d & 0x20) >> 1) | ((d & 0x10) << 1); }
__host__ __device__ __forceinline__ int permB(int d) { return (d & 0x60) | ((d & 4) << 2) | ((d & 0x18) >> 1) | (d & 3); }
__host__ __device__ __forceinline__ int spos(int d) { return (d & 0x40) | ((d & 0x10) << 1) | ((d & 0x0C) << 1) | ((d & 0x20) >> 3) | (d & 3); }

namespace pg8 {
constexpr int BM = 256, BK = 64, HALF = 128, HTB = HALF * BK * 2, STAGE_BYTES = 8 * HTB, NXCD = 8, WGM = 8;
__host__ __device__ __forceinline__ int lds_byte(int r, int c) { const int st = (r >> 4) * 2 + (c >> 5), rr = r & 15, cc = c & 31, ob = rr * 64 + cc * 2; return st * 1024 + (ob ^ (((ob >> 9) & 1) << 5)); }
__host__ __device__ __forceinline__ void stage_rc(int b, int& R, int& C) { const int st = b / 1024, sb = b % 1024, swz = sb ^ (((sb >> 9) & 1) << 5); R = (st >> 1) * 16 + swz / 64; C = (st & 1) * 32 + (swz % 64) / 2; }

struct UnitMN { int pm, pn; };
struct StaticOrder {
    int nM, nN, nwg, G, c;
    __host__ __device__ void init(int M, int N, int G_, int c_) { nM = M / BM; nN = N / BM; nwg = nM * nN; G = G_; c = c_; }
    __host__ __device__ bool next(int i, UnitMN& u) const {
        const long L = (long)i * G + c; if (L >= nwg) return false;
        int wgid = (int)L; { const int q = nwg / NXCD, r = nwg % NXCD, xcd = wgid % NXCD, off = wgid / NXCD; wgid = (xcd < r ? xcd * (q + 1) : r * (q + 1) + (xcd - r) * q) + off; }
        const int nig = WGM * nN, gid = wgid / nig, fm = gid * WGM, gsz = (nM - fm) < WGM ? (nM - fm) : WGM;
        u.pm = fm + ((wgid % nig) % gsz); u.pn = (wgid % nig) / gsz; return true;
    }
};

template <int K, class Prob>
__device__ __forceinline__ void gemm_phase(LAS unsigned char* lds, LAS unsigned char* les, const Prob& P, int tid) {
    const int wid = __builtin_amdgcn_readfirstlane(tid >> 6), lane = tid & 63, wr = wid >> 2, wc = wid & 3, fr = lane & 15, fq = lane >> 4;
    constexpr int nt = K / BK;
    static_assert(K % 128 == 0 && K >= 256, "K");
    int Rr[2], Cc[2]; unsigned voffB[2];
#pragma unroll
    for (int i = 0; i < 2; ++i) { stage_rc(tid * 16 + i * 8192, Rr[i], Cc[i]); voffB[i] = (unsigned)(Rr[i] * K + Cc[i]) * 2u; }
    constexpr size_t kstep = (size_t)(BK * 2);
    constexpr size_t hstep = (size_t)HALF * K * 2;
    const unsigned ldsw = (unsigned)wid * 1024u;
    const int aoff = lds_byte(wr * 64 + fr, fq * 8), boff = lds_byte(wc * 32 + fr, fq * 8);
#define PG8_SA(b, h) (((b) * 2 + (h)) * HTB)
#define PG8_SB(b, h) ((4 + (b) * 2 + (h)) * HTB)
#define PG8_STAGE(bufoff, gbase, voff) do { _Pragma("unroll") for (int _i = 0; _i < 2; ++_i) \
        __builtin_amdgcn_global_load_lds((const unsigned*)((const char*)(gbase) + (voff)[_i]), (LAS unsigned*)(lds + (bufoff) + ldsw + _i * 8192), 16, 0, 0); } while (0)
#define PG8_LDA(dst, b, h) do { _Pragma("unroll") for (int m = 0; m < 4; ++m) _Pragma("unroll") for (int k = 0; k < 2; ++k) dst[m][k] = *(const LAS bf16x8*)(lds + PG8_SA(b, h) + aoff + m * 2048 + k * 1024); } while (0)
#define PG8_LDB(dst, b, h) do { _Pragma("unroll") for (int n = 0; n < 2; ++n) _Pragma("unroll") for (int k = 0; k < 2; ++k) dst[n][k] = *(const LAS bf16x8*)(lds + PG8_SB(b, h) + boff + n * 2048 + k * 1024); } while (0)
#define PG8_MMA(ai, bj, At, Bt) do { __builtin_amdgcn_s_setprio(1); _Pragma("unroll") for (int m = 0; m < 4; ++m) _Pragma("unroll") for (int n = 0; n < 2; ++n) _Pragma("unroll") for (int k = 0; k < 2; ++k) \
        acc[ai][bj][m][n] = __builtin_amdgcn_mfma_f32_16x16x32_bf16(Bt[n][k], At[m][k], acc[ai][bj][m][n], 0, 0, 0); __builtin_amdgcn_s_setprio(0); } while (0)
#define PG8_WAIT_V(n) asm volatile("s_waitcnt vmcnt(" #n ")" ::: "memory")
#define PG8_WAIT_L(n) asm volatile("s_waitcnt lgkmcnt(" #n ")" ::: "memory")
#define PG8_BAR __builtin_amdgcn_s_barrier()
#define PG8_SCHED __builtin_amdgcn_sched_barrier(0)
    typename Prob::Unit cur, nxt; int ui = 0;
    if (!P.next(0, cur)) return;
    f32x4 acc[2][2][4][2];
#pragma unroll
    for (int a = 0; a < 2; ++a)
#pragma unroll
        for (int b = 0; b < 2; ++b)
#pragma unroll
            for (int m = 0; m < 4; ++m)
#pragma unroll
                for (int n = 0; n < 2; ++n) acc[a][b][m][n] = (f32x4){0.f, 0.f, 0.f, 0.f};
    bf16x8 At[4][2], B0[2][2], B1[2][2];
    unsigned voA[2][2], voN[2][2];
    P.a_offs(cur, Rr, Cc, voA);
    const char* cA = P.a_base(cur); const char* cB = P.b_base(cur);
    PG8_STAGE(PG8_SB(0, 0), cB, voffB); PG8_STAGE(PG8_SB(0, 1), cB + hstep, voffB); PG8_STAGE(PG8_SA(0, 0), cA, voA[0]); PG8_STAGE(PG8_SA(0, 1), cA, voA[1]);
    if (wr == 1) PG8_BAR;
    PG8_WAIT_V(2); PG8_BAR;
    PG8_STAGE(PG8_SB(1, 0), cB + kstep, voffB); PG8_STAGE(PG8_SA(1, 0), cA + kstep, voA[0]); PG8_STAGE(PG8_SB(1, 1), cB + hstep + kstep, voffB);
    PG8_WAIT_V(6); PG8_BAR;
    for (;;) {
        const bool has_next = P.next(ui + 1, nxt);
        const char* nA = cA; const char* nB = cB;
#pragma unroll
        for (int h = 0; h < 2; ++h)
#pragma unroll
            for (int i = 0; i < 2; ++i) voN[h][i] = voA[h][i];
        if (has_next) { nA = P.a_base(nxt); nB = P.b_base(nxt); P.a_offs(nxt, Rr, Cc, voN); }
        for (int t = 0; t < nt; t += 2) {
            const bool last = (t == nt - 2);
            const char* a1 = cA + (size_t)(t + 1) * kstep;
            const char* a2 = last ? nA : cA + (size_t)(t + 2) * kstep; const char* b2 = last ? nB : cB + (size_t)(t + 2) * kstep;
            const char* a3 = a2 + kstep; const char* b3 = b2 + kstep;
            unsigned vo2[2][2];
#pragma unroll
            for (int h = 0; h < 2; ++h)
#pragma unroll
                for (int i = 0; i < 2; ++i) vo2[h][i] = last ? voN[h][i] : voA[h][i];
            PG8_LDB(B0, 0, 0); PG8_LDB(B1, 0, 1); PG8_SCHED; PG8_LDA(At, 0, 0); PG8_STAGE(PG8_SA(1, 1), a1, voA[1]);
            PG8_WAIT_V(8); PG8_WAIT_L(0); PG8_BAR; PG8_MMA(0, 0, At, B0); PG8_MMA(0, 1, At, B1); PG8_BAR; PG8_SCHED;
            PG8_LDA(At, 0, 1); PG8_STAGE(PG8_SB(0, 0), b2, voffB); PG8_STAGE(PG8_SB(0, 1), b2 + hstep, voffB); PG8_STAGE(PG8_SA(0, 0), a2, vo2[0]);
            PG8_WAIT_V(8); PG8_WAIT_L(0); PG8_BAR; PG8_MMA(1, 0, At, B0); PG8_MMA(1, 1, At, B1); PG8_BAR; PG8_SCHED;
            PG8_LDB(B0, 1, 0); PG8_LDB(B1, 1, 1); PG8_SCHED; PG8_LDA(At, 1, 0); PG8_STAGE(PG8_SA(0, 1), a2, vo2[1]);
            PG8_WAIT_V(8); PG8_WAIT_L(0); PG8_BAR; PG8_MMA(0, 0, At, B0); PG8_MMA(0, 1, At, B1); PG8_BAR; PG8_SCHED;
            PG8_LDA(At, 1, 1); PG8_STAGE(PG8_SB(1, 0), b3, voffB); PG8_STAGE(PG8_SB(1, 1), b3 + hstep, voffB); PG8_STAGE(PG8_SA(1, 0), a3, vo2[0]);
            PG8_WAIT_V(8); PG8_WAIT_L(0); PG8_BAR; PG8_MMA(1, 0, At, B0); PG8_MMA(1, 1, At, B1); PG8_BAR; PG8_SCHED;
        }
        if (wr == 0) PG8_BAR;
        P.epi(acc, cur, wr, wc, fr, fq, les, lane);
        if (!has_next) break;
#pragma unroll
        for (int a = 0; a < 2; ++a)
#pragma unroll
            for (int b = 0; b < 2; ++b)
#pragma unroll
                for (int m = 0; m < 4; ++m)
#pragma unroll
                    for (int n = 0; n < 2; ++n) acc[a][b][m][n] = (f32x4){0.f, 0.f, 0.f, 0.f};
        cur = nxt; cA = nA; cB = nB; ++ui;
#pragma unroll
        for (int h = 0; h < 2; ++h)
#pragma unroll
            for (int i = 0; i < 2; ++i) voA[h][i] = voN[h][i];
        if (wr == 1) PG8_BAR;
    }
    PG8_WAIT_V(0);
    PG8_BAR;
#undef PG8_SA
#undef PG8_SB
#undef PG8_STAGE
#undef PG8_LDA
#undef PG8_LDB
#undef PG8_MMA
#undef PG8_WAIT_V
#undef PG8_WAIT_L
#undef PG8_BAR
#undef PG8_SCHED
}
}

#define XB_TMO      128
#define XB_XCNT(j)  (256  + 64 * (j))
#define XB_XSUB(j)  (1280 + 64 * (j))
#define XB_XGEN(j)  (2304 + 64 * (j))
#define XB_TOP      3328
#define XB_TOPGEN   3392
#define XCD_BAR_WORDS 3456
#define XB_SPIN_CAP (1u << 18)
__device__ __forceinline__ unsigned xb_ld(unsigned* p)              { return __hip_atomic_load(p, __ATOMIC_RELAXED, __HIP_MEMORY_SCOPE_AGENT); }
__device__ __forceinline__ unsigned xb_add(unsigned* p, unsigned v) { return __hip_atomic_fetch_add(p, v, __ATOMIC_RELAXED, __HIP_MEMORY_SCOPE_AGENT); }
__device__ __forceinline__ unsigned xb_xcc_id() { return (unsigned)__builtin_amdgcn_s_getreg((3 << 11) | 20) & 0xFu; }
#define XB_SPIN(cond, bar) do { unsigned _sp = 0; while (cond) { __builtin_amdgcn_s_sleep(1); \
    if ((++_sp & 255u) == 0u) { if (xb_ld(&(bar)[XB_TMO])) break; if (_sp > XB_SPIN_CAP) { atomicAdd(&(bar)[XB_TMO], 1u); break; } } } } while (0)
struct XcdBarrier { unsigned* bar; unsigned x; volatile LAS unsigned* st; };
__device__ __forceinline__ XcdBarrier xcd_barrier_post(unsigned* bar, volatile LAS unsigned* st) {
    XcdBarrier b; b.bar = bar; b.x = xb_xcc_id(); b.st = st;
    if (threadIdx.x == 0) (void)xb_add(&bar[XB_XCNT(b.x)], 1u);
    return b;
}
__device__ __forceinline__ void xcd_barrier_complete(unsigned* bar, unsigned x, unsigned& nloc, unsigned& nx) {
    const unsigned G = gridDim.x * gridDim.y * gridDim.z;
    unsigned sum, cnt, mine, sp = 0u;
    for (;;) {
        sum = 0u; cnt = 0u; mine = 0u;
#pragma unroll
        for (unsigned j = 0; j < 16; ++j) { const unsigned c = xb_ld(&bar[XB_XCNT(j)]); sum += c; cnt += (c > 0u) ? 1u : 0u; mine = (j == x) ? c : mine; }
        if (sum == G) break;
        __builtin_amdgcn_s_sleep(1);
        if ((++sp & 255u) == 0u) { if (xb_ld(&bar[XB_TMO])) break; if (sp > XB_SPIN_CAP) { atomicAdd(&bar[XB_TMO], 1u); break; } }
    }
    nloc = mine > 0u ? mine : 1u; nx = cnt > 0u ? cnt : 1u;
}
__device__ __forceinline__ void xcd_barrier(const XcdBarrier& b) {
    asm volatile("s_waitcnt vmcnt(0)" ::: "memory");
    __syncthreads();
    if (threadIdx.x == 0) {
        unsigned* bar = b.bar;
        __builtin_amdgcn_s_waitcnt(0);
        unsigned nloc = b.st[0], nx = b.st[1];
        if (nloc == 0u) { xcd_barrier_complete(bar, b.x, nloc, nx); b.st[0] = nloc; b.st[1] = nx; }
        const unsigned old = xb_add(&bar[XB_XSUB(b.x)], 1u);
        const unsigned gen = old / nloc;
        if (old + 1u == (gen + 1u) * nloc) {
            __builtin_amdgcn_fence(__ATOMIC_RELEASE, "agent");
            asm volatile("s_waitcnt vmcnt(0)" ::: "memory");
            const unsigned og = xb_add(&bar[XB_TOP], 1u);
            const unsigned tg = og / nx;
            if (og + 1u == (tg + 1u) * nx) xb_add(&bar[XB_TOPGEN], 1u);
            else XB_SPIN(xb_ld(&bar[XB_TOPGEN]) == tg, bar);
            __builtin_amdgcn_fence(__ATOMIC_ACQUIRE, "agent");
            xb_add(&bar[XB_XGEN(b.x)], 1u);
            asm volatile("s_waitcnt vmcnt(0)" ::: "memory");
        } else {
            XB_SPIN(xb_ld(&bar[XB_XGEN(b.x)]) == gen, bar);
            __builtin_amdgcn_fence(__ATOMIC_ACQUIRE, "agent");
            asm volatile("s_waitcnt vmcnt(0)" ::: "memory");
        }
    }
    __syncthreads();
}

struct Args {
    const float* x; const float* meta; const float* g1; const float* w_in; const float* qg; const float* kg; const float* pool_w; const float* pool_scale; const float* w_out;
    const float* g2; const float* w_rg; const float* b_rg; const float* w_re; const float* b_re; const float* w_gate; const float* w_up; const float* w_down;
    float* out; unsigned char* ws; int ph_lo, ph_hi;
};

template <class RowFn>
__device__ __forceinline__ void transpose_item(const float* W, int ldw, int k0, int n0, const float* rs, LAS float* scr, int lane, const RowFn& rowp) {
    const float* wp = W + (size_t)k0 * ldw + n0 + lane;
#pragma unroll
    for (int hb = 0; hb < 2; ++hb) { float v[32];
#pragma unroll
        for (int i = 0; i < 32; ++i) v[i] = wp[(size_t)(hb * 32 + i) * ldw];
#pragma unroll
        for (int i = 0; i < 32; ++i) { float x = v[i]; if (rs) x *= rs[k0 + hb * 32 + i]; scr[(hb * 32 + i) * 65 + lane] = x; } }
    LDS_WAIT(); asm volatile("" ::: "memory");
    const int c = lane & 7;
#pragma unroll
    for (int j = 0; j < 8; ++j) { const int n = (lane >> 3) + 8 * j; const LAS float* s = scr + (8 * c) * 65 + n;
        u32x4 o; o.x = cvt_pk_bf16(s[0 * 65], s[1 * 65]); o.y = cvt_pk_bf16(s[2 * 65], s[3 * 65]); o.z = cvt_pk_bf16(s[4 * 65], s[5 * 65]); o.w = cvt_pk_bf16(s[6 * 65], s[7 * 65]);
        *(u32x4*)(rowp(n) + k0 + 8 * c) = o; }
    LDS_WAIT(); asm volatile("" ::: "memory");
}
struct RowWin { bf16_t* base; int n0; __device__ __forceinline__ bf16_t* operator()(int n) const { const int c = n0 + n; const int r = (c & ~127) + (c < 1280 ? swap45(c & 127) : permB(c & 127)); return base + (size_t)r * DM; } };
struct RowNat { bf16_t* base; int n0; int ld; __device__ __forceinline__ bf16_t* operator()(int n) const { return base + (size_t)(n0 + n) * ld; } };
struct RowPB  { bf16_t* base; int n0; int ld; __device__ __forceinline__ bf16_t* operator()(int n) const { const int c = n0 + n; return base + (size_t)((c & ~127) + permB(c & 127)) * ld; } };
struct RowGU  { bf16_t* base; int n0; int half; __device__ __forceinline__ bf16_t* operator()(int n) const { const int c = n0 + n; const int r = (c >> 7) * 256 + half * 128 + permB(c & 127); return base + (size_t)r * DM; } };

__device__ __forceinline__ void rms_row_to_bf16(const float* xrow, bf16_t* orow, int lane) {
    const f32x4* xr = (const f32x4*)xrow + lane;
    f32x4 v[8]; float s = 0.f;
#pragma unroll
    for (int j = 0; j < 8; ++j) { v[j] = xr[64 * j]; s += (v[j].x * v[j].x + v[j].y * v[j].y) + (v[j].z * v[j].z + v[j].w * v[j].w); }
    const float rstd = 1.0f / sqrtf(wave_sum(s) * (1.f / DM) + EPS);
    u32x2* o8 = (u32x2*)orow + lane;
#pragma unroll
    for (int j = 0; j < 8; ++j) { u32x2 w; w.x = cvt_pk_bf16(v[j].x * rstd, v[j].y * rstd); w.y = cvt_pk_bf16(v[j].z * rstd, v[j].w * rstd); o8[64 * j] = w; }
}

__device__ __forceinline__ void p0_meta_job(const Args& A, LAS unsigned char* lds, int cj, int tid, int lane, int wave) {
    LAS float* Am = (LAS float*)lds;
    LAS float* Raw = (LAS float*)(lds + EPI_OFF + 8192);
#pragma unroll 1
    for (int rr = 0; rr < 2; ++rr) { const int r = wave * 2 + rr; const f32x4* mr = (const f32x4*)(A.meta + (size_t)r * DM) + lane; f32x4 v[8]; float s = 0.f;
#pragma unroll
        for (int j = 0; j < 8; ++j) { v[j] = mr[64 * j]; s += (v[j].x * v[j].x + v[j].y * v[j].y) + (v[j].z * v[j].z + v[j].w * v[j].w); }
        const float rstd = 1.0f / sqrtf(wave_sum(s) * (1.f / DM) + EPS);
#pragma unroll
        for (int j = 0; j < 8; ++j) { const int k = 4 * (lane + 64 * j); const f32x4 g = *(const f32x4*)(A.g1 + k);
            Am[(k + 0) * 16 + r] = v[j].x * rstd * g.x; Am[(k + 1) * 16 + r] = v[j].y * rstd * g.y; Am[(k + 2) * 16 + r] = v[j].z * rstd * g.z; Am[(k + 3) * 16 + r] = v[j].w * rstd * g.w; } }
    __syncthreads();
    const int c = tid & 127, kq = tid >> 7, col0 = 1024 + 128 * cj;
    float acc[16];
#pragma unroll
    for (int i = 0; i < 16; ++i) acc[i] = 0.f;
    const float* wp = A.w_in + (size_t)(kq * 512) * INW + col0 + c;
#pragma unroll 1
    for (int k0 = 0; k0 < 512; k0 += 32) { float w[32];
#pragma unroll
        for (int u = 0; u < 32; ++u) w[u] = wp[(size_t)(k0 + u) * INW];
#pragma unroll
        for (int u = 0; u < 32; ++u) { const LAS f32x4* ap = (const LAS f32x4*)(Am + (kq * 512 + k0 + u) * 16);
#pragma unroll
            for (int q = 0; q < 4; ++q) { const f32x4 a4 = ap[q]; acc[4 * q + 0] += a4.x * w[u]; acc[4 * q + 1] += a4.y * w[u]; acc[4 * q + 2] += a4.z * w[u]; acc[4 * q + 3] += a4.w * w[u]; } } }
    __syncthreads();
    LAS float* Rq = Am;
#pragma unroll
    for (int i = 0; i < 16; ++i) Rq[(kq * 16 + i) * 128 + c] = acc[i];
    __syncthreads();
    for (int i = tid; i < 16 * 128; i += 512) Raw[i] = (Rq[i] + Rq[2048 + i]) + (Rq[4096 + i] + Rq[6144 + i]);
    __syncthreads();
    bf16_t* Kb = (bf16_t*)(A.ws + WS_K); bf16_t* Vb = (bf16_t*)(A.ws + WS_V);
    if (cj < 2) {
#pragma unroll 1
        for (int rr = 0; rr < 2; ++rr) { const int r = wave * 2 + rr; const float v0 = Raw[r * 128 + lane], v1 = Raw[r * 128 + 64 + lane];
            const float rstd = 1.0f / sqrtf(wave_sum(v0 * v0 + v1 * v1) * (1.f / HD) + EPS);
            const float y0 = v0 * rstd * A.kg[lane], y1 = v1 * rstd * A.kg[64 + lane];
#pragma unroll
            for (int b = 0; b < 2; ++b) { bf16_t* kr = Kb + ((size_t)(b * 2 + cj) * KVROWS + r) * HD; kr[spos(lane)] = (bf16_t)(cvt_pk_bf16(y0, 0.f) & 0xffffu); kr[spos(64 + lane)] = (bf16_t)(cvt_pk_bf16(y1, 0.f) & 0xffffu); } }
    } else if (cj < 4) {
#pragma unroll 1
        for (int rr = 0; rr < 2; ++rr) { const int r = wave * 2 + rr;
#pragma unroll
            for (int b = 0; b < 2; ++b) { bf16_t* vr = Vb + ((size_t)(b * 2 + (cj - 2)) * KVROWS + r) * HD; vr[lane] = (bf16_t)(cvt_pk_bf16(Raw[r * 128 + lane], 0.f) & 0xffffu); vr[64 + lane] = (bf16_t)(cvt_pk_bf16(Raw[r * 128 + 64 + lane], 0.f) & 0xffffu); } }
    } else {
        float* pm = (float*)(A.ws + WS_PMETA);
        for (int i = tid; i < 16 * 128; i += 512) pm[(size_t)(i >> 7) * POOLW + (cj - 4) * 128 + (i & 127)] = Raw[i];
    }
    if (ATT_MODE != 0 && cj < 2) {
        unsigned char* K8 = A.ws + WS_K8;
        for (int i = tid; i < 16 * 128; i += 512) { const int r = i >> 7, d = i & 127;
            const float v0 = Raw[r * 128 + d]; float ssq = 0.f;
            for (int q = 0; q < 128; ++q) { const float t = Raw[r * 128 + q]; ssq += t * t; }
            const float y = v0 * (1.0f / sqrtf(ssq * (1.f / HD) + EPS)) * A.kg[d]; const unsigned char by = (unsigned char)pk4_fp8(y, 0.f, 0.f, 0.f);
            K8[((size_t)(0 * 2 + cj) * KVROWS + r) * HD + spos(d)] = by; K8[((size_t)(1 * 2 + cj) * KVROWS + r) * HD + spos(d)] = by; }
        for (int i = tid; i < 2 * 384; i += 512) { const int b = i / 384, q = i % 384; *(u32x4*)(K8 + ((size_t)(b * 2 + cj) * KVROWS + 16) * HD + q * 16) = (u32x4){0u, 0u, 0u, 0u}; }
    }
    if (ATT_MODE != 0 && cj >= 2 && cj < 4) {
        LAS unsigned char* img = (LAS unsigned char*)Am + 65536;
        for (int i = tid; i < 512; i += 512) ((LAS u32x4*)img)[i] = (u32x4){0u, 0u, 0u, 0u};
        __syncthreads();
        for (int i = tid; i < 16 * 128; i += 512) { const int r = i >> 7, d = i & 127; img[d * 64 + vpos(r)] = (unsigned char)pk4_fp8(Raw[r * 128 + d], 0.f, 0.f, 0.f); }
        __syncthreads();
        unsigned char* V8 = A.ws + WS_V8;
        for (int i = tid; i < 2 * 512; i += 512) { const int b = i >> 9, q = i & 511; *(u32x4*)(V8 + ((size_t)(b * 2 + (cj - 2)) * NT_ATT) * 8192 + q * 16) = ((const LAS u32x4*)img)[q]; }
    }
    if (ATT_MODE != 1 && cj < 4) {
        bf16_t* base = (cj < 2) ? Kb : Vb; const int kvh = cj & 1;
        for (int i = tid; i < 2 * 768; i += 512) { const int b = i / 768, q = i % 768; *(u32x4*)(base + ((size_t)(b * 2 + kvh) * KVROWS + 16) * HD + q * 8) = (u32x4){0u, 0u, 0u, 0u}; }
    }
    __syncthreads();
}

__device__ __forceinline__ void p0_fold_job(const Args& A, LAS unsigned char* lds, int fj, int tid) {
    LAS float* As = (LAS float*)lds;
    const int g = fj >> 6, k0 = (fj & 63) * 32;
    for (int i = tid; i < 32 * 64; i += 512) { const int kk = i >> 6, c4 = (i & 63) * 4; f32x4 v = *(const f32x4*)(A.w_in + (size_t)(k0 + kk) * INW + 1536 + g * 256 + c4); const float gs = A.g1[k0 + kk];
        *(LAS f32x4*)(As + kk * 256 + c4) = v * gs; }
    __syncthreads();
    const int d = tid & 255, kh = tid >> 8;
    float acc[16];
#pragma unroll
    for (int i = 0; i < 16; ++i) acc[i] = 0.f;
    const float* pw = A.pool_w + (size_t)g * 256 * 256 + d;
#pragma unroll 1
    for (int c = 0; c < 256; c += 16) { float bv[16];
#pragma unroll
        for (int u = 0; u < 16; ++u) bv[u] = pw[(size_t)(c + u) * 256];
#pragma unroll
        for (int u = 0; u < 16; u += 4)
#pragma unroll
            for (int kk = 0; kk < 16; ++kk) { const f32x4 a = *(const LAS f32x4*)(As + (kh * 16 + kk) * 256 + c + u); acc[kk] += (a.x * bv[u] + a.y * bv[u + 1]) + (a.z * bv[u + 2] + a.w * bv[u + 3]); } }
    const float sc = A.pool_scale[g * 256 + d];
    bf16_t* dst = (bf16_t*)(A.ws + WS_WIN) + (size_t)(1536 + g * 256 + (d & 128) + permB(d & 127)) * DM + k0 + kh * 16;
#pragma unroll
    for (int q = 0; q < 2; ++q) { u32x4 w; w.x = cvt_pk_bf16(acc[8 * q + 0] * sc, acc[8 * q + 1] * sc); w.y = cvt_pk_bf16(acc[8 * q + 2] * sc, acc[8 * q + 3] * sc);
        w.z = cvt_pk_bf16(acc[8 * q + 4] * sc, acc[8 * q + 5] * sc); w.w = cvt_pk_bf16(acc[8 * q + 6] * sc, acc[8 * q + 7] * sc); *(u32x4*)(dst + 8 * q) = w; }
    __syncthreads();
}

__device__ __forceinline__ void p0_prologue(const Args& A, LAS unsigned char* lds, int vcu, int G, int tid, int lane, int wave) {
    (void)tid;
    for (int job = vcu; job < 12; job += G) { const int l2 = fresh_lane(); p0_meta_job(A, lds, job, wave * 64 + l2, l2, wave); }
    for (int job = vcu; job < 256; job += G) { const int l2 = fresh_lane(); p0_fold_job(A, lds, job, wave * 64 + l2); }
    lane = fresh_lane(); tid = wave * 64 + lane;
    {
        const int gt = (vcu * 8 + wave) * 64 + lane, NGT = G * 512;
        float* cosT = (float*)(A.ws + WS_ROPE); float* sinT = cosT + 256 * 32;
        for (int i = gt; i < 256 * 32; i += NGT) { const int pos = i >> 5, f = i & 31; const float inv = powf(10000.0f, -(float)(2 * f) / 64.0f); const float ang = (float)pos * inv; cosT[i] = cosf(ang); sinT[i] = sinf(ang); }
        u32x4* wrf = (u32x4*)(A.ws + WS_WRF);
        for (int i = gt; i < 64 * 3 * 64; i += NGT) { const int l = i & 63, blk = (i >> 6) % 3, ks = i / 192; const int col = 16 * blk + (l & 15), kb = 32 * ks + 8 * (l >> 4);
            float v[8];
#pragma unroll
            for (int q = 0; q < 8; ++q) { const int k = kb + q; float w = 0.f; if (col < 32) w = A.w_re[(size_t)k * NEXP + col]; else if (col < 36) w = A.w_rg[(size_t)k * 4 + (col - 32)]; v[q] = w * A.g2[k]; }
            u32x4 hi, lo; unsigned* hp = (unsigned*)&hi; unsigned* lp = (unsigned*)&lo;
#pragma unroll
            for (int q = 0; q < 4; ++q) { const unsigned h = cvt_pk_bf16(v[2 * q], v[2 * q + 1]); hp[q] = h; lp[q] = cvt_pk_bf16(v[2 * q] - bf_lo(h), v[2 * q + 1] - bf_hi(h)); }
            wrf[(size_t)((ks * 3 + blk) * 2 + 0) * 64 + l] = hi; wrf[(size_t)((ks * 3 + blk) * 2 + 1) * 64 + l] = lo; }
    }
    LAS float* scr = (LAS float*)(lds + wave * 16640);
    const int gw = vcu * 8 + wave, NGW = G * 8;
    constexpr int I_IN = 32 * 24, I_OUT = 32 * 32, I_G = 32 * 256, I_D = 32 * 256;
    constexpr int NITEMS = I_IN + I_OUT + 2 * I_G + I_D;
    bf16_t* Win_t = (bf16_t*)(A.ws + WS_WIN); bf16_t* Wout_t = (bf16_t*)(A.ws + WS_WOUT); bf16_t* Wgu_t = (bf16_t*)(A.ws + WS_WGU); bf16_t* Wd_t = (bf16_t*)(A.ws + WS_WD);
    for (int it = gw; it < NITEMS; it += NGW) {
        int r = it;
        if (r < I_IN) { const int kb = r / 24, nb = r % 24; transpose_item(A.w_in, INW, kb * 64, nb * 64, A.g1, scr, lane, RowWin{Win_t, nb * 64}); continue; } r -= I_IN;
        if (r < I_OUT) { const int kb = r / 32, nb = r % 32; transpose_item(A.w_out, DM, kb * 64, nb * 64, nullptr, scr, lane, RowNat{Wout_t, nb * 64, DM}); continue; } r -= I_OUT;
        if (r < 2 * I_G) { const int half = r / I_G; r -= half * I_G; const int e = r / 256, q = r % 256, kb = q / 8, nb = q % 8;
            transpose_item((half ? A.w_up : A.w_gate) + (size_t)e * DM * DEXP, DEXP, kb * 64, nb * 64, A.g2, scr, lane, RowGU{Wgu_t + (size_t)e * 1024 * DM, nb * 64, half}); continue; } r -= 2 * I_G;
        { const int e = r / 256, q = r % 256, kb = q / 32, nb = q % 32; transpose_item(A.w_down + (size_t)e * DEXP * DM, DM, kb * 64, nb * 64, nullptr, scr, lane, RowPB{Wd_t + (size_t)e * DM * DEXP, nb * 64, DEXP}); }
    }
    bf16_t* XN = (bf16_t*)(A.ws + WS_XN);
    if (G > 24) { if (vcu >= 12) for (int m = gw - 96; m < NTOK; m += NGW - 96) rms_row_to_bf16(A.x + (size_t)m * DM, XN + (size_t)m * DM, lane); }
    else for (int m = gw; m < NTOK; m += NGW) rms_row_to_bf16(A.x + (size_t)m * DM, XN + (size_t)m * DM, lane);
}

namespace att { constexpr float CQ_ = 0.088388347648318440f * 1.4426950408889634f; }
using pg8::UnitMN;
template <int AM> struct ProbIn {
    typedef UnitMN Unit;
    const bf16_t* A; const bf16_t* Bt; pg8::StaticOrder S;
    bf16_t *Q, *Kb, *Vb, *Z; unsigned char *Q8, *K8, *V8; const float *qg, *kg, *cosT, *sinT;
    __device__ __forceinline__ bool next(int i, Unit& u) const { return S.next(i, u); }
    __device__ __forceinline__ const char* a_base(const Unit& u) const { return (const char*)A + (size_t)u.pm * 256 * DM * 2; }
    __device__ __forceinline__ void a_offs(const Unit&, const int (&R)[2], const int (&C)[2], unsigned (&vo)[2][2]) const {
#pragma unroll
        for (int h = 0; h < 2; ++h)
#pragma unroll
            for (int i = 0; i < 2; ++i) vo[h][i] = (unsigned)((h * 128 + R[i]) * DM + C[i]) * 2u; }
    __device__ __forceinline__ const char* b_base(const Unit& u) const { return (const char*)Bt + (size_t)u.pn * 256 * DM * 2; }
    __device__ __forceinline__ void epi(f32x4 (&acc)[2][2][4][2], const Unit& u, int wr, int wc, int fr, int fq, LAS unsigned char* les, int lane) const {
        const int pn = u.pn; const int rbase = u.pm * 256 + wr * 64 + fr;
        if (pn <= 4) {
            LAS float* Pst = (LAS float*)les;
#pragma unroll
            for (int ai = 0; ai < 2; ++ai)
#pragma unroll
                for (int m = 0; m < 4; ++m)
#pragma unroll
                    for (int bj = 0; bj < 2; ++bj) { const f32x4 a = acc[ai][bj][m][0], b = acc[ai][bj][m][1];
                        float ss = ((a.x * a.x + a.y * a.y) + (a.z * a.z + a.w * a.w)) + ((b.x * b.x + b.y * b.y) + (b.z * b.z + b.w * b.w));
                        ss += __shfl_xor(ss, 16); ss += __shfl_xor(ss, 32);
                        if (fq == 0) Pst[((ai * 128 + wr * 64 + m * 16 + fr) * 2 + bj) * 4 + wc] = ss; }
            asm volatile("s_waitcnt lgkmcnt(0)" ::: "memory"); __builtin_amdgcn_s_barrier(); asm volatile("" ::: "memory");
            const float* gp = (pn < 4) ? qg : kg;
            const int dA = 64 * (wc >> 1) + 16 * (wc & 1) + 4 * fq, i0 = 16 * (wc & 1) + 4 * fq;
            const f32x4 g0 = *(const f32x4*)(gp + dA), g1v = *(const f32x4*)(gp + dA + 32);
#pragma unroll
            for (int ai = 0; ai < 2; ++ai)
#pragma unroll
                for (int m = 0; m < 4; ++m) { const int row = rbase + ai * 128 + m * 16; const int b = row >> 14, s = row & (SEQ - 1);
                    const int pos = (wc >> 1) ? (s & 63) : (s >> 6);
                    const f32x4 c4 = *(const f32x4*)(cosT + pos * 32 + i0), s4 = *(const f32x4*)(sinT + pos * 32 + i0);
#pragma unroll
                    for (int bj = 0; bj < 2; ++bj) { const f32x4 pp = *(const LAS f32x4*)(Pst + ((ai * 128 + wr * 64 + m * 16 + fr) * 2 + bj) * 4);
                        const float rstd = 1.0f / sqrtf(((pp.x + pp.y) + (pp.z + pp.w)) * (1.f / HD) + EPS);
                        const f32x4 x1 = acc[ai][bj][m][0] * rstd * g0, x2 = acc[ai][bj][m][1] * rstd * g1v;
                        f32x4 y1 = x1 * c4 - x2 * s4, y2 = x2 * c4 + x1 * s4;
                        if (pn < 4) { y1 = y1 * att::CQ_; y2 = y2 * att::CQ_; }
                        if (AM != 1) {
                        bf16_t* dst = (pn < 4) ? Q + (size_t)row * ATTW + (2 * pn + bj) * HD + 32 * wc + 8 * fq
                                               : Kb + ((size_t)(b * 2 + bj) * KVROWS + 64 + s) * HD + 32 * wc + 8 * fq;
                        *(u32x4*)dst = pack8(y1, y2); }
                        if (AM != 0) { const float qs = (pn < 4) ? 8.0f : 1.0f; y1 = y1 * qs; y2 = y2 * qs;
                        unsigned char* d8 = (pn < 4) ? Q8 + (size_t)row * ATTW + (2 * pn + bj) * HD + 32 * wc + 8 * fq
                                                     : K8 + ((size_t)(b * 2 + bj) * KVROWS + 64 + s) * HD + 32 * wc + 8 * fq;
                        u32x2 w8; w8.x = pk4_fp8(y1[0], y1[1], y1[2], y1[3]); w8.y = pk4_fp8(y2[0], y2[1], y2[2], y2[3]); *(u32x2*)d8 = w8; } } }
        } else {
            if (AM != 0 && pn == 5) {
                LAS unsigned char* T = les + (wr * 4 + wc) * 2048;
#pragma unroll
                for (int ai = 0; ai < 2; ++ai)
#pragma unroll
                    for (int bj = 0; bj < 2; ++bj) {
#pragma unroll
                        for (int m = 0; m < 4; ++m) { const int pp = vpos(16 * m + fr);
#pragma unroll
                            for (int n = 0; n < 2; ++n) { const f32x4 v = acc[ai][bj][m][n]; const unsigned w = pk4_fp8(v[0], v[1], v[2], v[3]); const int dl = 8 * fq + 4 * n;
                                T[(dl + 0) * 64 + pp] = (unsigned char)w; T[(dl + 1) * 64 + pp] = (unsigned char)(w >> 8); T[(dl + 2) * 64 + pp] = (unsigned char)(w >> 16); T[(dl + 3) * 64 + pp] = (unsigned char)(w >> 24); } }
                        asm volatile("s_waitcnt lgkmcnt(0)" ::: "memory");
                        const int row0 = u.pm * 256 + ai * 128 + wr * 64; const int b0 = row0 >> 14, tile = 1 + ((row0 & (SEQ - 1)) >> 6);
                        unsigned char* dst = V8 + (((size_t)(b0 * 2 + bj) * NT_ATT + tile) * 128 + 32 * wc) * 64;
                        const u32x4 c0 = *(const LAS u32x4*)(T + lane * 16), c1 = *(const LAS u32x4*)(T + 1024 + lane * 16);
                        *(u32x4*)(dst + lane * 16) = c0; *(u32x4*)(dst + 1024 + lane * 16) = c1;
                        asm volatile("s_waitcnt lgkmcnt(0)" ::: "memory"); }
            }
            if (AM == 1 && pn == 5) return;
#pragma unroll
            for (int ai = 0; ai < 2; ++ai)
#pragma unroll
                for (int m = 0; m < 4; ++m) { const int row = rbase + ai * 128 + m * 16; const int b = row >> 14, s = row & (SEQ - 1);
#pragma unroll
                    for (int bj = 0; bj < 2; ++bj) {
                        bf16_t* dst = (pn == 5) ? Vb + ((size_t)(b * 2 + bj) * KVROWS + 64 + s) * HD + 32 * wc + 8 * fq
                                                : Z + (size_t)row * POOLW + (pn - 6) * 256 + bj * 128 + 32 * wc + 8 * fq;
                        *(u32x4*)dst = pack8(acc[ai][bj][m][0], acc[ai][bj][m][1]); } }
        }
    }
};
struct ProbOut {
    typedef UnitMN Unit;
    const bf16_t* A; const bf16_t* Bt; pg8::StaticOrder S; const float* x; float* out; float* ssp;
    __device__ __forceinline__ bool next(int i, Unit& u) const { return S.next(i, u); }
    __device__ __forceinline__ const char* a_base(const Unit& u) const { return (const char*)A + (size_t)u.pm * 256 * DM * 2; }
    __device__ __forceinline__ void a_offs(const Unit&, const int (&R)[2], const int (&C)[2], unsigned (&vo)[2][2]) const {
#pragma unroll
        for (int h = 0; h < 2; ++h)
#pragma unroll
            for (int i = 0; i < 2; ++i) vo[h][i] = (unsigned)((h * 128 + R[i]) * DM + C[i]) * 2u; }
    __device__ __forceinline__ const char* b_base(const Unit& u) const { return (const char*)Bt + (size_t)u.pn * 256 * DM * 2; }
    __device__ __forceinline__ void epi(f32x4 (&acc)[2][2][4][2], const Unit& u, int wr, int wc, int fr, int fq, LAS unsigned char*, int) const {
        const int col0 = u.pn * 256 + wc * 32 + 4 * fq; const int row0 = u.pm * 256 + wr * 64 + fr;
        f32x4 xb[4][4];
#define XLOAD(c) do { const size_t off_ = (size_t)(row0 + ((c) >> 2) * 128 + ((c) & 3) * 16) * DM + col0; \
            _Pragma("unroll") for (int q = 0; q < 4; ++q) xb[(c) & 3][q] = *(const f32x4*)(x + off_ + (q >> 1) * 128 + (q & 1) * 16); } while (0)
        XLOAD(0); XLOAD(1); XLOAD(2);
#pragma unroll
        for (int c = 0; c < 8; ++c) { const int ai = c >> 2, m = c & 3; const int row = row0 + ai * 128 + m * 16; const size_t off = (size_t)row * DM + col0; float ss = 0.f;
            if (c + 3 < 8) XLOAD(c + 3);
            asm volatile("" ::: "memory");
#pragma unroll
            for (int q = 0; q < 4; ++q) { const f32x4 v = xb[c & 3][q] + acc[ai][q >> 1][m][q & 1]; *(f32x4*)(out + off + (q >> 1) * 128 + (q & 1) * 16) = v;
                ss += (v.x * v.x + v.y * v.y) + (v.z * v.z + v.w * v.w); }
            ss += __shfl_xor(ss, 16); ss += __shfl_xor(ss, 32);
            if (fq == 0) ssp[(size_t)row * 32 + u.pn * 4 + wc] = ss;
            asm volatile("" ::: "memory"); }
#undef XLOAD
    }
};
struct MoeTab { LAS int* cnt; LAS int* tb; LAS int* tbk; };
__device__ __forceinline__ MoeTab moe_tab(LAS unsigned char* lds) { MoeTab t; t.cnt = (LAS int*)(lds + TAB_OFF); t.tb = t.cnt + 64; t.tbk = t.tb + 72; return t; }
__device__ __forceinline__ void moe_tables(LAS unsigned char* lds, const unsigned* gcnt, int tid) {
    MoeTab T = moe_tab(lds);
    if (tid < 64) T.cnt[tid] = (int)__hip_atomic_load(gcnt + tid, RLX_AGENT);
    __syncthreads();
    if (tid == 0) { int s = 0; for (int li = 0; li < 64; ++li) { T.tb[li] = s; s += (T.cnt[li] + 255) >> 8; } T.tb[64] = s;
        for (int k = 0; k < 2; ++k) { int q = 0; for (int e = 0; e < 32; ++e) { T.tbk[k * 33 + e] = q; q += (T.cnt[2 * e + k] + 255) >> 8; } T.tbk[k * 33 + 32] = q; } }
    __syncthreads();
}
struct UnitMoe { int T, j, li, tl; };
struct ProbGU {
    typedef UnitMoe Unit;
    const bf16_t* A; const bf16_t* Bt; bf16_t* H; const int* list; MoeTab T; int vcu, G;
    __device__ __forceinline__ bool next(int i, Unit& u) const {
        const int un = i * G + vcu; const int ntile = T.tb[64]; if (un >= ntile * 4) return false;
        const int Tt = un >> 2; int li = 0;
        for (int q = 1; q < 64; ++q) li += (T.tb[q] <= Tt) ? 1 : 0;
        li = __builtin_amdgcn_readfirstlane(li);
        u.T = Tt; u.j = un & 3; u.li = li; u.tl = Tt - __builtin_amdgcn_readfirstlane(T.tb[li]); return true; }
    __device__ __forceinline__ const char* a_base(const Unit&) const { return (const char*)A; }
    __device__ __forceinline__ void a_offs(const Unit& u, const int (&R)[2], const int (&C)[2], unsigned (&vo)[2][2]) const {
        const int cnt = T.cnt[u.li];
#pragma unroll
        for (int h = 0; h < 2; ++h)
#pragma unroll
            for (int i = 0; i < 2; ++i) { const int slot = u.tl * 256 + h * 128 + R[i]; int tok = 0; if (slot < cnt) tok = list[(size_t)u.li * LCAP + slot]; vo[h][i] = (unsigned)(tok * DM + C[i]) * 2u; } }
    __device__ __forceinline__ const char* b_base(const Unit& u) const { return (const char*)Bt + (size_t)((u.li >> 1) * 4 + u.j) * 256 * DM * 2; }
    __device__ __forceinline__ void epi(f32x4 (&acc)[2][2][4][2], const Unit& u, int wr, int wc, int fr, int fq, LAS unsigned char*, int) const {
#pragma unroll
        for (int ai = 0; ai < 2; ++ai)
#pragma unroll
            for (int m = 0; m < 4; ++m) { const int hrow = u.T * 256 + ai * 128 + wr * 64 + m * 16 + fr; f32x4 hv[2];
#pragma unroll
                for (int n = 0; n < 2; ++n) { const f32x4 g = acc[ai][0][m][n], up = acc[ai][1][m][n];
#pragma unroll
                    for (int e = 0; e < 4; ++e) hv[n][e] = g[e] * __builtin_amdgcn_rcpf(1.0f + __builtin_amdgcn_exp2f(-1.4426950408889634f * g[e])) * up[e]; }
                *(u32x4*)(H + (size_t)hrow * DEXP + u.j * 128 + 32 * wc + 8 * fq) = pack8(hv[0], hv[1]); }
    }
};
template <int KK> struct ProbDown {
    typedef UnitMoe Unit;
    const bf16_t* A; const bf16_t* Bt; float* out; bf16_t* tmp; const int* list; const float* glist; MoeTab T; int vcu, G;
    __device__ __forceinline__ bool next(int i, Unit& u) const {
        const int un = i * G + vcu; const int ntile = T.tbk[KK * 33 + 32]; if (un >= ntile * 8) return false;
        const int Tk = un >> 3; int e = 0;
        for (int q = 1; q < 32; ++q) e += (T.tbk[KK * 33 + q] <= Tk) ? 1 : 0;
        e = __builtin_amdgcn_readfirstlane(e);
        u.li = 2 * e + KK; u.tl = Tk - __builtin_amdgcn_readfirstlane(T.tbk[KK * 33 + e]); u.T = __builtin_amdgcn_readfirstlane(T.tb[u.li]) + u.tl; u.j = un & 7; return true; }
    __device__ __forceinline__ const char* a_base(const Unit& u) const { return (const char*)A + (size_t)u.T * 256 * DEXP * 2; }
    __device__ __forceinline__ void a_offs(const Unit&, const int (&R)[2], const int (&C)[2], unsigned (&vo)[2][2]) const {
#pragma unroll
        for (int h = 0; h < 2; ++h)
#pragma unroll
            for (int i = 0; i < 2; ++i) vo[h][i] = (unsigned)((h * 128 + R[i]) * DEXP + C[i]) * 2u; }
    __device__ __forceinline__ const char* b_base(const Unit& u) const { return (const char*)Bt + ((size_t)(u.li >> 1) * DM + u.j * 256) * DEXP * 2; }
    __device__ __forceinline__ void epi(f32x4 (&acc)[2][2][4][2], const Unit& u, int wr, int wc, int fr, int fq, LAS unsigned char*, int) const {
        const int cnt = T.cnt[u.li]; const int col0 = u.j * 256 + wc * 32 + 8 * fq;
        int tok[2][4]; float gt[2][4];
#pragma unroll
        for (int ai = 0; ai < 2; ++ai)
#pragma unroll
            for (int m = 0; m < 4; ++m) { const int slot = u.tl * 256 + ai * 128 + wr * 64 + m * 16 + fr; const bool ok = slot < cnt; const int sl = ok ? slot : 0;
                tok[ai][m] = list[(size_t)u.li * LCAP + sl]; gt[ai][m] = glist[(size_t)u.li * LCAP + sl]; if (!ok) tok[ai][m] = -1; }
        if (KK == 0) {
#pragma unroll
            for (int ai = 0; ai < 2; ++ai)
#pragma unroll
                for (int m = 0; m < 4; ++m) {
                    if (tok[ai][m] >= 0) { const size_t ro = (size_t)tok[ai][m] * DM + col0; const float g = gt[ai][m];
#pragma unroll
                        for (int bj = 0; bj < 2; ++bj) *(u32x4*)(tmp + ro + bj * 128) = pack8(acc[ai][bj][m][0] * g, acc[ai][bj][m][1] * g); }
                    if (m & 1) asm volatile("" ::: "memory"); }
        } else {
            u32x4 tb[3][2]; f32x4 ob[3][4];
#define DLOAD(c) do { const int tk_ = tok[(c) >> 2][(c) & 3]; const size_t ro_ = (size_t)(tk_ < 0 ? 0 : tk_) * DM + col0; \
                _Pragma("unroll") for (int bj = 0; bj < 2; ++bj) { tb[(c) % 3][bj] = *(const u32x4*)(tmp + ro_ + bj * 128); ob[(c) % 3][2 * bj] = *(const f32x4*)(out + ro_ + bj * 128); ob[(c) % 3][2 * bj + 1] = *(const f32x4*)(out + ro_ + bj * 128 + 4); } } while (0)
            DLOAD(0); DLOAD(1);
#pragma unroll
            for (int c = 0; c < 8; ++c) { const int ai = c >> 2, m = c & 3;
                if (c + 2 < 8) DLOAD(c + 2);
                asm volatile("" ::: "memory");
                if (tok[ai][m] >= 0) { const size_t ro = (size_t)tok[ai][m] * DM + col0; const float g = gt[ai][m];
#pragma unroll
                    for (int bj = 0; bj < 2; ++bj) { const u32x4 t = tb[c % 3][bj];
                        const f32x4 v0 = ob[c % 3][2 * bj] + (f32x4){bf_lo(t.x), bf_hi(t.x), bf_lo(t.y), bf_hi(t.y)} + acc[ai][bj][m][0] * g, v1 = ob[c % 3][2 * bj + 1] + (f32x4){bf_lo(t.z), bf_hi(t.z), bf_lo(t.w), bf_hi(t.w)} + acc[ai][bj][m][1] * g;
                        *(f32x4*)(out + ro + bj * 128) = v0; *(f32x4*)(out + ro + bj * 128 + 4) = v1; } }
                asm volatile("" ::: "memory"); }
#undef DLOAD
        }
    }
};

namespace att {
constexpr int D = 128, NW = 8, QBLK = 32, KVBLK = 64;
constexpr float CQ = 0.088388347648318440f * 1.4426950408889634f;
constexpr float THRL = 8.f;
constexpr int LDQ = ATTW, LDO = DM;
constexpr int KSLOT = 16384, NKS = 3, NVS = 4, LDS_K = 0, LDS_V = NKS * KSLOT, LDS_WS = LDS_V + NVS * KSLOT;
#define SBAR() __builtin_amdgcn_sched_barrier(0)
__device__ __forceinline__ int crow(int r, int hi) { return (r & 3) + 8 * (r >> 2) + 4 * hi; }
__device__ __forceinline__ unsigned cvtpk(float lo, float hi) { unsigned r; asm volatile("v_cvt_pk_bf16_f32 %0, %1, %2" : "=v"(r) : "v"(lo), "v"(hi)); return r; }
__device__ __forceinline__ int v_rd_base(int lane) { return ((lane & 3) << 3) | (((lane >> 2) & 3) << 6) | (((lane >> 4) & 1) << 5) | (((lane >> 5) & 1) << 8); }
constexpr int v_rd_off(int d0, int ks, int half) { return d0 * 512 + ks * 4096 + half * 2048; }
template <int OFF> __device__ __forceinline__ s16x4 tr_read(int vb) {
  s16x4 r; asm volatile("ds_read_b64_tr_b16 %0, %1 offset:%2" : "=&v"(r) : "v"(vb), "i"(OFF) : "memory"); return r;
}
struct VG { s16x4 l0, h0, l1, h1; };
template <int G> __device__ __forceinline__ void v_read(VG& v, int vb) {
  constexpr int d0 = G >> 1, ks = 2 * (G & 1);
  v.l0 = tr_read<v_rd_off(d0, ks, 0)>(vb); v.h0 = tr_read<v_rd_off(d0, ks, 1)>(vb); v.l1 = tr_read<v_rd_off(d0, ks + 1, 0)>(vb); v.h1 = tr_read<v_rd_off(d0, ks + 1, 1)>(vb);
}
#define V_WAIT(N, v) asm volatile("s_waitcnt lgkmcnt(" #N ")" : "+v"(v.l0), "+v"(v.h0), "+v"(v.l1), "+v"(v.h1))
#define PKV(L, H) (bf16x8){L[0], L[1], L[2], L[3], H[0], H[1], H[2], H[3]}
#define V_MMA(od, v, pe, po) do { od = __builtin_amdgcn_mfma_f32_32x32x16_bf16(pe, PKV(v.l0, v.h0), od, 0, 0, 0); od = __builtin_amdgcn_mfma_f32_32x32x16_bf16(po, PKV(v.l1, v.h1), od, 0, 0, 0); } while (0)
__device__ __forceinline__ void pv_d0(f32x16* o, int vb, bf16x8 pa0, bf16x8 pa1, bf16x8 pa2, bf16x8 pa3) {
  VG a, b, c;
  v_read<0>(a, vb); v_read<1>(b, vb); v_read<2>(c, vb);
  V_WAIT(8, a); V_MMA(o[0], a, pa0, pa1); v_read<3>(a, vb);
  V_WAIT(8, b); V_MMA(o[0], b, pa2, pa3); v_read<4>(b, vb);
  V_WAIT(8, c); V_MMA(o[1], c, pa0, pa1); v_read<5>(c, vb);
  V_WAIT(8, a); V_MMA(o[1], a, pa2, pa3); v_read<6>(a, vb);
  V_WAIT(8, b); V_MMA(o[2], b, pa0, pa1); v_read<7>(b, vb);
  V_WAIT(8, c); V_MMA(o[2], c, pa2, pa3);
  V_WAIT(4, a); V_MMA(o[3], a, pa0, pa1);
  V_WAIT(0, b); V_MMA(o[3], b, pa2, pa3);
}
#undef V_MMA
#undef PKV
struct KG { bf16x8 b0, b1; };
template <int D0> __device__ __forceinline__ void k_read(KG& k, const int (&kb)[4]) {
  asm volatile("ds_read_b128 %0, %1 offset:%2" : "=&v"(k.b0) : "v"(kb[D0 & 3]), "i"((D0 >> 2) * 128) : "memory");
  asm volatile("ds_read_b128 %0, %1 offset:%2" : "=&v"(k.b1) : "v"(kb[D0 & 3]), "i"((D0 >> 2) * 128 + 8192) : "memory");
}
#define K_WAIT(N, k) asm volatile("s_waitcnt lgkmcnt(" #N ")" : "+v"(k.b0), "+v"(k.b1))
__device__ __forceinline__ void qkt(f32x16& p0, f32x16& p1, const int (&kb)[4], const bf16x8* qr, const f32x16& negm) {
  KG a, b;
  k_read<0>(a, kb); k_read<1>(b, kb);
  K_WAIT(2, a); p0 = __builtin_amdgcn_mfma_f32_32x32x16_bf16(a.b0, qr[0], negm, 0, 0, 0); p1 = __builtin_amdgcn_mfma_f32_32x32x16_bf16(a.b1, qr[0], negm, 0, 0, 0); k_read<2>(a, kb);
#define K_MMA(k, d) do { p0 = __builtin_amdgcn_mfma_f32_32x32x16_bf16(k.b0, qr[d], p0, 0, 0, 0); p1 = __builtin_amdgcn_mfma_f32_32x32x16_bf16(k.b1, qr[d], p1, 0, 0, 0); } while (0)
  K_WAIT(2, b); K_MMA(b, 1); k_read<3>(b, kb);
  K_WAIT(2, a); K_MMA(a, 2); k_read<4>(a, kb);
  K_WAIT(2, b); K_MMA(b, 3); k_read<5>(b, kb);
  K_WAIT(2, a); K_MMA(a, 4); k_read<6>(a, kb);
  K_WAIT(2, b); K_MMA(b, 5); k_read<7>(b, kb);
  K_WAIT(2, a); K_MMA(a, 6);
  K_WAIT(0, b); K_MMA(b, 7);
#undef K_MMA
}
__device__ __forceinline__ void finishSM(f32x16& p0, f32x16& p1, float& l_reg, bf16x8& pa0, bf16x8& pa1, bf16x8& pa2, bf16x8& pa3) {
#pragma unroll
  for (int r = 0; r < 16; ++r) p1[r] = __builtin_amdgcn_exp2f(p1[r]);
  float ps = 0;
#pragma unroll
  for (int r = 0; r < 16; ++r) ps += p0[r];
#pragma unroll
  for (int r = 0; r < 16; ++r) ps += p1[r];
  l_reg += ps;
#define PK4(P, BASE, OUT) do { unsigned a0 = cvtpk(P[BASE + 0], P[BASE + 1]), a1 = cvtpk(P[BASE + 2], P[BASE + 3]);   \
    unsigned b0 = cvtpk(P[BASE + 4], P[BASE + 5]), b1 = cvtpk(P[BASE + 6], P[BASE + 7]);                              \
    auto r0 = __builtin_amdgcn_permlane32_swap(a0, b0, false, false); auto r1 = __builtin_amdgcn_permlane32_swap(a1, b1, false, false); \
    u32x4 w = {r0[0], r1[0], r0[1], r1[1]}; OUT = *reinterpret_cast<bf16x8*>(&w); } while (0)
  PK4(p0, 0, pa0); PK4(p0, 8, pa1); PK4(p1, 0, pa2); PK4(p1, 8, pa3);
#undef PK4
}
template <bool FIRST>
__device__ __forceinline__ void startSM(f32x16& p0, f32x16& p1, float& mhat, float& l_reg, f32x16& negm, bool& resc, float& f) {
  float a = __builtin_fmaxf(__builtin_fmaxf(p0[0], p0[1]), p1[0]), b = __builtin_fmaxf(__builtin_fmaxf(p0[2], p0[3]), p1[1]); a = __builtin_fmaxf(__builtin_fmaxf(a, p1[2]), p1[3]);
#pragma unroll
  for (int r = 4; r < 16; r += 4) { a = __builtin_fmaxf(__builtin_fmaxf(a, p0[r]), p0[r + 1]); b = __builtin_fmaxf(__builtin_fmaxf(b, p0[r + 2]), p0[r + 3]);
    a = __builtin_fmaxf(__builtin_fmaxf(a, p1[r]), p1[r + 1]); b = __builtin_fmaxf(__builtin_fmaxf(b, p1[r + 2]), p1[r + 3]); }
  float rm = __builtin_fmaxf(a, b);
  { auto rr = __builtin_amdgcn_permlane32_swap(__float_as_uint(rm), __float_as_uint(rm), false, false); rm = __builtin_fmaxf(__uint_as_float(rr[0]), __uint_as_float(rr[1])); }
  resc = false; f = 1.f;
  if (FIRST || __builtin_expect(__any(rm > THRL), 0)) {
    const float dl = FIRST ? rm : __builtin_fmaxf(rm, 0.f); mhat += dl;
#pragma unroll
    for (int r = 0; r < 16; ++r) { p0[r] -= dl; p1[r] -= dl; }
#pragma unroll
    for (int r = 0; r < 16; ++r) negm[r] = -mhat;
    asm volatile("" : "+v"(negm));
    if (!FIRST) { f = __builtin_amdgcn_exp2f(-dl); l_reg *= f; resc = true; }
  }
#pragma unroll
  for (int r = 0; r < 16; ++r) p0[r] = __builtin_amdgcn_exp2f(p0[r]);
}
#define ATT_WAIT(N) asm volatile("s_waitcnt vmcnt(" #N ")" ::: "memory")
__device__ __forceinline__ void attn_unit(const bf16_t* __restrict__ Qb, const bf16_t* __restrict__ Kh, const bf16_t* __restrict__ Vh, bf16_t* __restrict__ Ob, LAS char* lds, int tid) {
  constexpr int NT = NT_ATT; static_assert(NT % 2 == 1 && NT >= 7, "odd tile count");
  const int wid = __builtin_amdgcn_readfirstlane(tid >> 6), lane = tid & 63, r32 = lane & 31, hi = lane >> 5;
  LAS float* ws = (LAS float*)(lds + LDS_WS) + wid * 64; LAS float* li_l = ws; LAS float* al_l = ws + 32;
  float mhat = 0.f, l_reg = 0.f; f32x16 o[4] = {}; f32x16 negm = {}; bf16x8 qr[8];
  asm volatile("" : "+v"(negm));
  unsigned koff[2], voff[2];
#pragma unroll
  for (int i = 0; i < 2; ++i) { const int p = 2 * wid + i;
    { const int row = 4 * p + (lane >> 4), cpos = lane & 15; koff[i] = (unsigned)(row * 256 + ((cpos ^ (row & 7)) << 4)); }
    { const int st = 2 * p + (lane >> 5), kk = (st >> 2) * 8 + ((lane & 31) >> 2), c = (st & 3) * 32 + (lane & 3) * 8; const int k = (kk & ~0xC) | ((kk & 4) << 1) | ((kk & 8) >> 1); voff[i] = (unsigned)(k * 256 + c * 2); } }
#define DMA_T(t, kso, vso) do { const char* kt_ = (const char*)Kh + (size_t)(t) * KSLOT; const char* vt_ = (const char*)Vh + (size_t)(t) * KSLOT; \
    _Pragma("unroll") for (int i_ = 0; i_ < 2; ++i_) { \
      __builtin_amdgcn_global_load_lds((const unsigned*)(kt_ + koff[i_]), (LAS unsigned*)(lds + LDS_K + (kso) + (2 * wid + i_) * 1024), 16, 0, 0); \
      __builtin_amdgcn_global_load_lds((const unsigned*)(vt_ + voff[i_]), (LAS unsigned*)(lds + LDS_V + (vso) + (2 * wid + i_) * 1024), 16, 0, 0); } } while (0)
  { const unsigned qoff = (unsigned)((wid * QBLK + r32) * LDQ + hi * 8) * 2u;
#pragma unroll
    for (int d0 = 0; d0 < 8; ++d0) qr[d0] = *reinterpret_cast<const bf16x8*>((const char*)Qb + qoff + d0 * 32); }
  DMA_T(0, 0, 0); DMA_T(1, KSLOT, KSLOT);
  int kb[4];
#pragma unroll
  for (int i = 0; i < 4; ++i) kb[i] = (int)(unsigned)(uintptr_t)(lds + LDS_K) + r32 * 256 + ((i * 32 + hi * 16) ^ ((r32 & 7) << 4));
  const int vb0 = (int)(unsigned)(uintptr_t)(lds + LDS_V) + v_rd_base(lane);
#define RESC() do { if (resc) { if (hi == 0) al_l[r32] = fsc; asm volatile("s_waitcnt lgkmcnt(0)" ::: "memory"); \
    _Pragma("unroll") for (int d = 0; d < 4; ++d) _Pragma("unroll") for (int r = 0; r < 16; ++r) o[d][r] *= al_l[crow(r, hi)]; } } while (0)
  f32x16 pA0, pA1, pB0, pB1; bf16x8 pa0, pa1, pa2, pa3; bool resc; float fsc;
  int kcur = 0, kiss = 2 * KSLOT, vprev = 0, viss = 2 * KSLOT;
#define KB_SET() do { } while (0)
#define ROT() do { { const int dk_ = (kcur == 2 * KSLOT) ? -2 * KSLOT : KSLOT; _Pragma("unroll") for (int i_ = 0; i_ < 4; ++i_) kb[i_] += dk_; } kcur = (kcur == 2 * KSLOT) ? 0 : kcur + KSLOT; kiss = (kiss == 2 * KSLOT) ? 0 : kiss + KSLOT; viss = (viss == 3 * KSLOT) ? 0 : viss + KSLOT; } while (0)
  ATT_WAIT(4); __builtin_amdgcn_s_barrier(); asm volatile("" ::: "memory");
  DMA_T(2, kiss, viss);
  KB_SET(); qkt(pA0, pA1, kb, qr, negm);
#pragma unroll
  for (int r = 8; r < 16; ++r) pA0[r] = -1e30f;
#pragma unroll
  for (int r = 0; r < 16; ++r) pA1[r] = -1e30f;
  startSM<true>(pA0, pA1, mhat, l_reg, negm, resc, fsc);
  ROT();
#define STEP(X0, X1, Y0, Y1, tt, ISSUE, WN) do { \
    ATT_WAIT(WN); __builtin_amdgcn_s_barrier(); asm volatile("" ::: "memory"); \
    if (ISSUE) DMA_T((tt) + 2, kiss, viss); \
    KB_SET(); qkt(X0, X1, kb, qr, negm); \
    finishSM(Y0, Y1, l_reg, pa0, pa1, pa2, pa3); \
    pv_d0(o, vb0 + vprev, pa0, pa1, pa2, pa3); startSM<false>(X0, X1, mhat, l_reg, negm, resc, fsc); \
    RESC(); vprev = (vprev == 3 * KSLOT) ? 0 : vprev + KSLOT; ROT(); } while (0)
  for (int t = 1; t + 3 < NT; t += 2) {
    STEP(pB0, pB1, pA0, pA1, t, true, 4);
    STEP(pA0, pA1, pB0, pB1, t + 1, true, 4);
  }
  STEP(pB0, pB1, pA0, pA1, NT - 2, false, 4);
  STEP(pA0, pA1, pB0, pB1, NT - 1, false, 0);
  finishSM(pA0, pA1, l_reg, pa0, pa1, pa2, pa3);
  pv_d0(o, vb0 + vprev, pa0, pa1, pa2, pa3);
  { auto rr = __builtin_amdgcn_permlane32_swap(__float_as_uint(l_reg), __float_as_uint(l_reg), false, false); l_reg = __uint_as_float(rr[0]) + __uint_as_float(rr[1]); }
  if (hi == 0) li_l[r32] = l_reg; asm volatile("s_waitcnt lgkmcnt(0)" ::: "memory");
  float rli[16];
#pragma unroll
  for (int r = 0; r < 16; ++r) rli[r] = __builtin_amdgcn_rcpf(li_l[crow(r, hi)]);
  asm volatile("s_waitcnt lgkmcnt(0)" ::: "memory"); __builtin_amdgcn_s_barrier(); asm volatile("" ::: "memory");
  LAS bf16_t* stg = (LAS bf16_t*)(lds + wid * 8192);
#pragma unroll
  for (int r = 0; r < 16; ++r) { const int orow = crow(r, hi);
#pragma unroll
    for (int d0 = 0; d0 < 4; ++d0) stg[orow * 128 + d0 * 32 + r32] = (bf16_t)(cvtpk(o[d0][r] * rli[r], 0.f) & 0xffffu); }
  asm volatile("s_waitcnt lgkmcnt(0)" ::: "memory");
#pragma unroll
  for (int i = 0; i < 8; ++i) { const int row = i * 4 + (lane >> 4), ch = lane & 15; const u32x4 v = *(const LAS u32x4*)(stg + row * 128 + ch * 8);
    *(u32x4*)((char*)Ob + (size_t)(wid * QBLK + row) * (LDO * 2) + ch * 16) = v; }
  asm volatile("s_waitcnt lgkmcnt(0)" ::: "memory"); __builtin_amdgcn_s_barrier(); asm volatile("" ::: "memory");
#undef DMA_T
#undef RESC
#undef ROT
#undef KB_SET
#undef STEP
}
#undef ATT_WAIT
#undef SBAR
#undef V_WAIT
#undef K_WAIT
}

namespace att8 {
typedef int v8i __attribute__((ext_vector_type(8)));
constexpr int QBLK = 32, KS8 = 8192, NKS = 3, NVS = 5, L_K = 0, L_V = NKS * KS8, L_WS = 73728;
constexpr float THRL = 8.f;
__device__ __forceinline__ int crow(int r, int hi) { return (r & 3) + 8 * (r >> 2) + 4 * hi; }
struct F8 { u32x4 lo, hi; };
template <int IMM> __device__ __forceinline__ void f_read(F8& f, int a0, int a1) {
  asm volatile("ds_read_b128 %0, %1 offset:%2" : "=&v"(f.lo) : "v"(a0), "i"(IMM) : "memory");
  asm volatile("ds_read_b128 %0, %1 offset:%2" : "=&v"(f.hi) : "v"(a1), "i"(IMM) : "memory");
}
#define F_WAIT(N, f) asm volatile("s_waitcnt lgkmcnt(" #N ")" : "+v"(f.lo), "+v"(f.hi))
__device__ __forceinline__ v8i f_vec(const F8& f) { return (v8i){(int)f.lo.x, (int)f.lo.y, (int)f.lo.z, (int)f.lo.w, (int)f.hi.x, (int)f.hi.y, (int)f.hi.z, (int)f.hi.w}; }
#define MMA8(a, b, c, sa, sb) __builtin_amdgcn_mfma_scale_f32_32x32x64_f8f6f4(a, b, c, 0, 0, 0, sa, 0, sb)
constexpr int S1 = 0x7f7f7f7f, S8 = 0x7c7c7c7c;
__device__ __forceinline__ v8i ld32(int a0, int a1, int imm) { const u32x4 lo = *(const LAS u32x4*)(uintptr_t)(unsigned)(a0 + imm), hh = *(const LAS u32x4*)(uintptr_t)(unsigned)(a1 + imm);
  return (v8i){(int)lo.x, (int)lo.y, (int)lo.z, (int)lo.w, (int)hh.x, (int)hh.y, (int)hh.z, (int)hh.w}; }
#define MFENCE() asm volatile("" ::: "memory")
__device__ __forceinline__ void qkt(f32x16& p0, f32x16& p1, int kb0, const v8i* qr, const f32x16& negm) {
  v8i a = ld32(kb0, kb0 ^ 16, 0), b = ld32(kb0, kb0 ^ 16, 4096); MFENCE();
  p0 = MMA8(a, qr[0], negm, S1, S8); p1 = MMA8(b, qr[0], negm, S1, S8);
  a = ld32(kb0 ^ 64, kb0 ^ 80, 0); b = ld32(kb0 ^ 64, kb0 ^ 80, 4096); MFENCE();
  p0 = MMA8(a, qr[1], p0, S1, S8); p1 = MMA8(b, qr[1], p1, S1, S8);
}
struct F2 { v8i a, b; };
__device__ __forceinline__ void v_read01(F2& v, int vo0) { v.a = ld32(vo0, vo0 ^ 16, 0); v.b = ld32(vo0, vo0 ^ 16, 2048); MFENCE(); }
__device__ __forceinline__ void pv(f32x16* o, f32x16& ol, const v8i& ones, F2& v, int vo0, const v8i& pa) {
  o[0] = MMA8(pa, v.a, o[0], S1, S1); o[1] = MMA8(pa, v.b, o[1], S1, S1);
  v.a = ld32(vo0, vo0 ^ 16, 4096); v.b = ld32(vo0, vo0 ^ 16, 6144); MFENCE();
  o[2] = MMA8(pa, v.a, o[2], S1, S1); o[3] = MMA8(pa, v.b, o[3], S1, S1);
  ol = MMA8(pa, ones, ol, S1, S1);
}
__device__ __forceinline__ void finishSM(f32x16& p0, f32x16& p1, float& l_reg, v8i& pa) {
#pragma unroll
  for (int r = 0; r < 16; ++r) p1[r] = __builtin_amdgcn_exp2f(p1[r]);
  float ps = 0;
#pragma unroll
  for (int r = 0; r < 16; ++r) ps += p0[r];
#pragma unroll
  for (int r = 0; r < 16; ++r) ps += p1[r];
  l_reg += ps;
#pragma unroll
  for (int i = 0; i < 4; ++i) { const unsigned a = pk4_fp8(p0[4 * i], p0[4 * i + 1], p0[4 * i + 2], p0[4 * i + 3]), b = pk4_fp8(p1[4 * i], p1[4 * i + 1], p1[4 * i + 2], p1[4 * i + 3]);
    auto rr = __builtin_amdgcn_permlane32_swap(a, b, false, false); pa[i] = (int)rr[0]; pa[4 + i] = (int)rr[1]; }
}
__device__ __forceinline__ float rowmax(const f32x16& p0, const f32x16& p1) {
  float a = __builtin_fmaxf(__builtin_fmaxf(p0[0], p0[1]), p1[0]), b = __builtin_fmaxf(__builtin_fmaxf(p0[2], p0[3]), p1[1]); a = __builtin_fmaxf(__builtin_fmaxf(a, p1[2]), p1[3]);
#pragma unroll
  for (int r = 4; r < 16; r += 4) { a = __builtin_fmaxf(__builtin_fmaxf(a, p0[r]), p0[r + 1]); b = __builtin_fmaxf(__builtin_fmaxf(b, p0[r + 2]), p0[r + 3]);
    a = __builtin_fmaxf(__builtin_fmaxf(a, p1[r]), p1[r + 1]); b = __builtin_fmaxf(__builtin_fmaxf(b, p1[r + 2]), p1[r + 3]); }
  float rm = __builtin_fmaxf(a, b);
  { auto rr = __builtin_amdgcn_permlane32_swap(__float_as_uint(rm), __float_as_uint(rm), false, false); rm = __builtin_fmaxf(__uint_as_float(rr[0]), __uint_as_float(rr[1])); }
  return rm;
}
__device__ __forceinline__ void exp_all(f32x16& p0, f32x16& p1) {
#pragma unroll
  for (int r = 0; r < 16; ++r) { p0[r] = __builtin_amdgcn_exp2f(p0[r]); p1[r] = __builtin_amdgcn_exp2f(p1[r]); }
}
__device__ __forceinline__ void pack_p(const f32x16& p0, const f32x16& p1, v8i& pa) {
#pragma unroll
  for (int i = 0; i < 4; ++i) { const unsigned a = pk4_fp8(p0[4 * i], p0[4 * i + 1], p0[4 * i + 2], p0[4 * i + 3]), b = pk4_fp8(p1[4 * i], p1[4 * i + 1], p1[4 * i + 2], p1[4 * i + 3]);
    auto rr = __builtin_amdgcn_permlane32_swap(a, b, false, false); pa[i] = (int)rr[0]; pa[4 + i] = (int)rr[1]; }
}
template <bool FIRST>
__device__ __forceinline__ void startSM(f32x16& p0, f32x16& p1, float& mhat, float& l_reg, f32x16& negm, bool& resc, float& f) {
  float a = __builtin_fmaxf(__builtin_fmaxf(p0[0], p0[1]), p1[0]), b = __builtin_fmaxf(__builtin_fmaxf(p0[2], p0[3]), p1[1]); a = __builtin_fmaxf(__builtin_fmaxf(a, p1[2]), p1[3]);
#pragma unroll
  for (int r = 4; r < 16; r += 4) { a = __builtin_fmaxf(__builtin_fmaxf(a, p0[r]), p0[r + 1]); b = __builtin_fmaxf(__builtin_fmaxf(b, p0[r + 2]), p0[r + 3]);
    a = __builtin_fmaxf(__builtin_fmaxf(a, p1[r]), p1[r + 1]); b = __builtin_fmaxf(__builtin_fmaxf(b, p1[r + 2]), p1[r + 3]); }
  float rm = __builtin_fmaxf(a, b);
  { auto rr = __builtin_amdgcn_permlane32_swap(__float_as_uint(rm), __float_as_uint(rm), false, false); rm = __builtin_fmaxf(__uint_as_float(rr[0]), __uint_as_float(rr[1])); }
  resc = false; f = 1.f;
  if (FIRST || __builtin_expect(__any(rm > THRL), 0)) {
    const float dl = FIRST ? rm : __builtin_fmaxf(rm, 0.f); mhat += dl;
#pragma unroll
    for (int r = 0; r < 16; ++r) { p0[r] -= dl; p1[r] -= dl; }
#pragma unroll
    for (int r = 0; r < 16; ++r) negm[r] = -mhat;
    asm volatile("" : "+v"(negm));
    if (!FIRST) { f = __builtin_amdgcn_exp2f(-dl); l_reg *= f; resc = true; }
  }
#pragma unroll
  for (int r = 0; r < 16; ++r) p0[r] = __builtin_amdgcn_exp2f(p0[r]);
}
#define ATT_WAIT(N) asm volatile("s_waitcnt vmcnt(" #N ")" ::: "memory")
__device__ __forceinline__ void attn_unit(const unsigned char* __restrict__ Q8b, const unsigned char* __restrict__ K8h, const unsigned char* __restrict__ V8h, bf16_t* __restrict__ Ob, int ldo, LAS char* lds, int tid) {
  constexpr int NT = NT_ATT; static_assert(NT % 2 == 1 && NT >= 7, "odd tile count");
  int lane = tid & 63; asm volatile("" : "+v"(lane));
  const int wid = __builtin_amdgcn_readfirstlane(tid >> 6), r32 = lane & 31, hi = lane >> 5;
  LAS float* ws = (LAS float*)(lds + L_WS) + wid * 64; LAS float* li_l = ws; LAS float* al_l = ws + 32;
  float zz = 0.f; asm volatile("" : "+v"(zz));
  float mhat = 0.f, l_reg = 0.f; f32x16 o[4]; f32x16 ol; f32x16 negm; v8i qr[2];
#pragma unroll
  for (int r = 0; r < 16; ++r) { negm[r] = zz; ol[r] = zz; o[0][r] = zz; o[1][r] = zz; o[2][r] = zz; o[3][r] = zz; }
  v8i ones; { int c38 = 0x38383838; asm volatile("" : "+v"(c38)); ones = (v8i){c38, c38, c38, c38, c38, c38, c38, c38}; }
  asm volatile("" : "+v"(negm));
  unsigned koff, voff;
  { const int row = 8 * wid + (lane >> 3), cpos = lane & 7; koff = (unsigned)(row * 128 + ((cpos ^ ((row >> 1) & 7)) << 4)); }
  { const int drow = 16 * wid + (lane >> 2), cpos = lane & 3; voff = (unsigned)(drow * 64 + ((cpos ^ ((drow >> 2) & 3)) << 4)); }
#define DMA_T(t, kso, vso) do { \
      __builtin_amdgcn_global_load_lds((const unsigned*)((const char*)K8h + (size_t)(t) * KS8 + koff), (LAS unsigned*)(lds + L_K + (kso) + wid * 1024), 16, 0, 0); \
      __builtin_amdgcn_global_load_lds((const unsigned*)((const char*)V8h + (size_t)(t) * KS8 + voff), (LAS unsigned*)(lds + L_V + (vso) + wid * 1024), 16, 0, 0); } while (0)
  { const unsigned qoff = (unsigned)((wid * QBLK + r32) * ATTW + hi * 32);
#pragma unroll
    for (int s = 0; s < 2; ++s) { const u32x4 lo = *reinterpret_cast<const u32x4*>((const char*)Q8b + qoff + s * 64), hh = *reinterpret_cast<const u32x4*>((const char*)Q8b + qoff + s * 64 + 16);
      qr[s] = (v8i){(int)lo.x, (int)lo.y, (int)lo.z, (int)lo.w, (int)hh.x, (int)hh.y, (int)hh.z, (int)hh.w}; } }
  DMA_T(0, 0, 0); DMA_T(1, KS8, KS8);
  int kb, vo;
  kb = (int)(unsigned)(uintptr_t)(lds + L_K) + r32 * 128 + (((2 * hi) ^ ((r32 >> 1) & 7)) << 4);
  vo = (int)(unsigned)(uintptr_t)(lds + L_V) + r32 * 64 + (((2 * hi) ^ ((r32 >> 2) & 3)) << 4);
#define RESC() do { if (resc) { if (hi == 0) al_l[r32] = fsc; asm volatile("s_waitcnt lgkmcnt(0)" ::: "memory"); \
    _Pragma("unroll") for (int r = 0; r < 16; ++r) { const float a_ = al_l[crow(r, hi)]; ol[r] *= a_; _Pragma("unroll") for (int d = 0; d < 4; ++d) o[d][r] *= a_; } } } while (0)
  f32x16 pA0, pA1, pB0, pB1; v8i pa; bool resc; float fsc; F2 vf;
  int kcur = 0, kiss = 2 * KS8, viss = 2 * KS8, vprev = 0;
#define KROT() do { const int dk_ = (kcur == 2 * KS8) ? -2 * KS8 : KS8; kb += dk_; kcur = (kcur == 2 * KS8) ? 0 : kcur + KS8; } while (0)
#define VROT() do { const int dv_ = (vprev == 4 * KS8) ? -4 * KS8 : KS8; vo += dv_; vprev = (vprev == 4 * KS8) ? 0 : vprev + KS8; } while (0)
#define IROT() do { kiss = (kiss == 2 * KS8) ? 0 : kiss + KS8; viss = (viss == 4 * KS8) ? 0 : viss + KS8; } while (0)
#define SYNC(WN, ISSUE, tt) do { ATT_WAIT(WN); __builtin_amdgcn_s_barrier(); asm volatile("" ::: "memory"); if (ISSUE) { DMA_T((tt), kiss, viss); IROT(); } } while (0)
#define MASK0() do { _Pragma("unroll") for (int r = 8; r < 16; ++r) pA0[r] = -1e30f; _Pragma("unroll") for (int r = 0; r < 16; ++r) pA1[r] = -1e30f; } while (0)
#define SGB(mask, n) __builtin_amdgcn_sched_group_barrier(mask, n, 0)
#define SOFT(FIRST_, X0, X1, Y0, Y1, HASPV) do { \
      const float rm_ = rowmax(Y0, Y1); \
      exp_all(Y0, Y1); \
      if (HASPV) { v_read01(vf, vo); pv(o, ol, ones, vf, vo, pa); VROT(); \
        asm volatile("" : "+v"(o[0]), "+v"(o[1]), "+v"(o[2]), "+v"(o[3]), "+v"(ol)); } \
      if ((FIRST_) || __builtin_expect(__any(rm_ > THRL), 0)) { const float dl = (FIRST_) ? rm_ : __builtin_fmaxf(rm_, 0.f); mhat += dl; const float f_ = __builtin_amdgcn_exp2f(-dl); \
        _Pragma("unroll") for (int r = 0; r < 16; ++r) { X0[r] -= dl; X1[r] -= dl; Y0[r] *= f_; Y1[r] *= f_; } \
        _Pragma("unroll") for (int r = 0; r < 16; ++r) negm[r] = -mhat; \
        asm volatile("" : "+v"(negm)); \
        if (!(FIRST_)) { fsc = f_; resc = true; RESC(); } } \
      pack_p(Y0, Y1, pa); } while (0)
#define STEP3(X0, X1, Y0, Y1, tt, ISSUE, WN) do { \
      SYNC(WN, ISSUE, (tt) + 2); \
      qkt(X0, X1, kb, qr, negm); KROT(); \
      resc = false; \
      SOFT(false, X0, X1, Y0, Y1, true); } while (0)
  SYNC(2, true, 2);
  qkt(pA0, pA1, kb, qr, negm); KROT(); MASK0();
  SYNC(2, true, 3);
  qkt(pB0, pB1, kb, qr, negm); KROT();
  resc = false; SOFT(true, pB0, pB1, pA0, pA1, false);
  for (int t = 2; t + 4 < NT; t += 2) {
    STEP3(pA0, pA1, pB0, pB1, t, true, 2);
    STEP3(pB0, pB1, pA0, pA1, t + 1, true, 2);
  }
  STEP3(pA0, pA1, pB0, pB1, NT - 3, true, 2);
  STEP3(pB0, pB1, pA0, pA1, NT - 2, false, 2);
  STEP3(pA0, pA1, pB0, pB1, NT - 1, false, 0);
  { f32x16 d0 = pB0, d1 = pB1; resc = false; SOFT(false, d0, d1, pA0, pA1, true); }
#undef STEP3
#undef SOFT
#undef SGB
  v_read01(vf, vo);
  pv(o, ol, ones, vf, vo, pa);
  { const int le = fresh_lane(), r32e = le & 31, hie = le >> 5;
  float rli[16];
#pragma unroll
  for (int r = 0; r < 16; ++r) rli[r] = __builtin_amdgcn_rcpf(ol[r]);
  (void)li_l; (void)hie; (void)l_reg;
  asm volatile("s_waitcnt lgkmcnt(0)" ::: "memory"); __builtin_amdgcn_s_barrier(); asm volatile("" ::: "memory");
  LAS bf16_t* stg = (LAS bf16_t*)(lds + wid * 8192);
#pragma unroll
  for (int r = 0; r < 16; ++r) { const int orow = crow(r, hie);
#pragma unroll
    for (int d0 = 0; d0 < 4; ++d0) stg[orow * 128 + d0 * 32 + r32e] = (bf16_t)(cvt_pk_bf16(o[d0][r] * rli[r], 0.f) & 0xffffu); }
  asm volatile("s_waitcnt lgkmcnt(0)" ::: "memory");
#pragma unroll
  for (int i = 0; i < 8; ++i) { const int row = i * 4 + (le >> 4), ch = le & 15; const u32x4 v = *(const LAS u32x4*)(stg + row * 128 + ch * 8);
    *(u32x4*)((char*)Ob + (size_t)(wid * QBLK + row) * ((size_t)ldo * 2) + ch * 16) = v; }
  asm volatile("s_waitcnt lgkmcnt(0)" ::: "memory"); __builtin_amdgcn_s_barrier(); asm volatile("" ::: "memory"); }
#undef DMA_T
#undef RESC
#undef KROT
#undef VROT
#undef IROT
#undef SYNC
#undef MASK0
}
#undef ATT_WAIT
#undef F_WAIT
#undef MFENCE
#undef MMA8
}

__device__ __forceinline__ void p1_zmeta(const Args& A, int cb, int tid) {
    const int o = tid >> 4, part = tid & 15, ch = cb * 4 + (o & 3), r = o >> 2, g = ch >> 8, d = ch & 255;
    const float* pm = (const float*)(A.ws + WS_PMETA) + (size_t)(8 + r) * POOLW + g * 256 + part * 16; const float* pw = A.pool_w + (size_t)g * 65536 + (size_t)(part * 16) * 256 + d;
    float wv[16]; f32x4 pv4[4];
#pragma unroll
    for (int u = 0; u < 16; ++u) wv[u] = pw[(size_t)u * 256];
#pragma unroll
    for (int q = 0; q < 4; ++q) pv4[q] = ((const f32x4*)pm)[q];
    float acc = 0.f;
#pragma unroll
    for (int q = 0; q < 4; ++q) acc += (pv4[q].x * wv[4 * q] + pv4[q].y * wv[4 * q + 1]) + (pv4[q].z * wv[4 * q + 2] + pv4[q].w * wv[4 * q + 3]);
    acc += __shfl_xor(acc, 1); acc += __shfl_xor(acc, 2); acc += __shfl_xor(acc, 4); acc += __shfl_xor(acc, 8);
    if (part == 0) ((float*)(A.ws + WS_ZM))[r * 1024 + ch] = acc * A.pool_scale[ch];
}
template <int HW> __device__ __forceinline__ void pool_item(const bf16_t* __restrict__ Zb, const float* __restrict__ Zm, bf16_t* __restrict__ Mb, int s) {
    u32x4 w[2 * HW];
#pragma unroll
    for (int k = 0; k < 2 * HW; ++k) { int sp = s - HW + k; sp = sp < 0 ? 0 : (sp > SEQ - 1 ? SEQ - 1 : sp); w[k] = *(const u32x4*)(Zb + (size_t)sp * POOLW); }
    float sum[8], self[8];
#pragma unroll
    for (int e = 0; e < 8; ++e) { sum[e] = 0.f; self[e] = 0.f; }
#pragma unroll
    for (int k = 0; k < 2 * HW; ++k) { const int sp = s - HW + k; float zv[8];
        zv[0] = bf_lo(w[k].x); zv[1] = bf_hi(w[k].x); zv[2] = bf_lo(w[k].y); zv[3] = bf_hi(w[k].y); zv[4] = bf_lo(w[k].z); zv[5] = bf_hi(w[k].z); zv[6] = bf_lo(w[k].w); zv[7] = bf_hi(w[k].w);
        if (sp < 0) {
#pragma unroll
            for (int e = 0; e < 8; ++e) zv[e] = Zm[(sp + 8) * 1024 + e]; }
        const float m = (sp < SEQ) ? 1.f : 0.f;
#pragma unroll
        for (int e = 0; e < 8; ++e) { sum[e] += zv[e] * m; if (k == HW) self[e] = zv[e]; } }
    const int hiE = (s + HW < SEQ) ? s + HW : SEQ; const float inv = 1.0f / (float)(hiE - (s - HW));
    u32x4 o; o.x = cvt_pk_bf16(sum[0] * inv - self[0], sum[1] * inv - self[1]); o.y = cvt_pk_bf16(sum[2] * inv - self[2], sum[3] * inv - self[3]);
    o.z = cvt_pk_bf16(sum[4] * inv - self[4], sum[5] * inv - self[5]); o.w = cvt_pk_bf16(sum[6] * inv - self[6], sum[7] * inv - self[7]);
    *(u32x4*)(Mb + (size_t)s * DM) = o;
}
__device__ __forceinline__ void p2_pool_block(const Args& A, LAS unsigned char* lds, int rb, int tid) {
    const float* Zm = (const float*)(A.ws + WS_ZM);
    const int b = rb >> 7, s0 = (rb & 127) * 128;
    const bf16_t* Z = (const bf16_t*)(A.ws + WS_Z); bf16_t* MIX = (bf16_t*)(A.ws + WS_MIX);
    { const int w = tid >> 6, l = tid & 63, sb = s0 + w * 16 + (l >> 5);
      const bf16_t* __restrict__ Zb = Z + (size_t)b * SEQ * POOLW + (l & 31) * 8; bf16_t* __restrict__ Mb = MIX + (size_t)b * SEQ * DM + ATTW + (l & 31) * 8; const float* Zmc = Zm + (l & 31) * 8;
#pragma unroll 2
      for (int it = 0; it < 8; ++it) pool_item<1>(Zb, Zmc, Mb, sb + 2 * it);
#pragma unroll 2
      for (int it = 0; it < 8; ++it) pool_item<2>(Zb + 256, Zmc + 256, Mb + 256, sb + 2 * it);
#pragma unroll 2
      for (int it = 0; it < 8; ++it) pool_item<4>(Zb + 512, Zmc + 512, Mb + 512, sb + 2 * it);
#pragma unroll 2
      for (int it = 0; it < 8; ++it) pool_item<8>(Zb + 768, Zmc + 768, Mb + 768, sb + 2 * it); }
    __syncthreads();
}

__device__ __forceinline__ void p4_block(const Args& A, LAS unsigned char* lds, int jb, int tid, int lane, int wave) {
    LAS float* Lg = (LAS float*)(lds + wave * 3072);
    LAS unsigned* cntL = (LAS unsigned*)(lds + 32768);
    LAS unsigned* baseL = cntL + 64;
    if (tid < 64) cntL[tid] = 0u;
    __syncthreads();
    const int fr = lane & 15, fq = lane >> 4, row = jb * 128 + wave * 16 + fr;
    const float* ssp = (const float*)(A.ws + WS_SSP); const float* h1 = A.out + (size_t)row * DM;
    bf16_t* BN = (bf16_t*)(A.ws + WS_XN) + (size_t)row * DM; const u32x4* wrf = (const u32x4*)(A.ws + WS_WRF);
    float ss; { const f32x4 a = *(const f32x4*)(ssp + (size_t)row * 32 + 8 * fq), b = *(const f32x4*)(ssp + (size_t)row * 32 + 8 * fq + 4); ss = ((a.x + a.y) + (a.z + a.w)) + ((b.x + b.y) + (b.z + b.w)); }
    ss += __shfl_xor(ss, 16); ss += __shfl_xor(ss, 32);
    const float rstd = 1.0f / sqrtf(ss * (1.f / DM) + EPS);
    f32x4 lacc[3] = {(f32x4){0.f, 0.f, 0.f, 0.f}, (f32x4){0.f, 0.f, 0.f, 0.f}, (f32x4){0.f, 0.f, 0.f, 0.f}};
#pragma unroll 2
    for (int ks = 0; ks < 64; ++ks) { const int k = 32 * ks + 8 * fq;
        const f32x4 xa = *(const f32x4*)(h1 + k) * rstd, xb = *(const f32x4*)(h1 + k + 4) * rstd;
        const u32x4 hw = pack8(xa, xb);
        *(u32x4*)(BN + k) = hw;
        u32x4 lw; lw.x = cvt_pk_bf16(xa.x - bf_lo(hw.x), xa.y - bf_hi(hw.x)); lw.y = cvt_pk_bf16(xa.z - bf_lo(hw.y), xa.w - bf_hi(hw.y));
        lw.z = cvt_pk_bf16(xb.x - bf_lo(hw.z), xb.y - bf_hi(hw.z)); lw.w = cvt_pk_bf16(xb.z - bf_lo(hw.w), xb.w - bf_hi(hw.w));
        const bf16x8 bh = __builtin_bit_cast(bf16x8, hw), bl = __builtin_bit_cast(bf16x8, lw);
#pragma unroll
        for (int blk = 0; blk < 3; ++blk) { const bf16x8 wh = __builtin_bit_cast(bf16x8, wrf[(size_t)((ks * 3 + blk) * 2 + 0) * 64 + lane]), wl = __builtin_bit_cast(bf16x8, wrf[(size_t)((ks * 3 + blk) * 2 + 1) * 64 + lane]);
            lacc[blk] = __builtin_amdgcn_mfma_f32_16x16x32_bf16(wh, bh, lacc[blk], 0, 0, 0);
            lacc[blk] = __builtin_amdgcn_mfma_f32_16x16x32_bf16(wl, bh, lacc[blk], 0, 0, 0);
            lacc[blk] = __builtin_amdgcn_mfma_f32_16x16x32_bf16(wh, bl, lacc[blk], 0, 0, 0); } }
#pragma unroll
    for (int blk = 0; blk < 3; ++blk)
#pragma unroll
        for (int j = 0; j < 4; ++j) Lg[fr * 48 + 16 * blk + 4 * fq + j] = lacc[blk][j];
    LDS_WAIT(); asm volatile("" ::: "memory");
    int e0 = 0, e1 = 0; float g0 = 0.f, g1 = 0.f; unsigned rk0 = 0u, rk1 = 0u;
    if (lane < 16) {
        float lg[4]; int gi = 0; float gm;
#pragma unroll
        for (int j = 0; j < 4; ++j) lg[j] = Lg[lane * 48 + 32 + j] + A.b_rg[j];
        gm = lg[0];
#pragma unroll
        for (int j = 1; j < 4; ++j) if (lg[j] > gm) { gm = lg[j]; gi = j; }
        float gs = 0.f;
#pragma unroll
        for (int j = 0; j < 4; ++j) gs += __expf(lg[j] - gm);
        const float gp = 1.0f / gs;
        float l1 = -3.0e38f, l2 = -3.0e38f; int i1 = 0, i2 = 0;
#pragma unroll
        for (int j = 0; j < 8; ++j) { const float v = Lg[lane * 48 + gi * 8 + j] + A.b_re[gi * 8 + j];
            if (v > l1) { l2 = l1; i2 = i1; l1 = v; i1 = j; } else if (v > l2) { l2 = v; i2 = j; } }
        const float t = __expf(l2 - l1);
        g0 = gp / (1.0f + t); g1 = gp * t / (1.0f + t);
        e0 = gi * 8 + i1; e1 = gi * 8 + i2;
        rk0 = atomicAdd((unsigned*)(cntL + 2 * e0 + 0), 1u); rk1 = atomicAdd((unsigned*)(cntL + 2 * e1 + 1), 1u);
    }
    __syncthreads();
    if (tid < 64) { const unsigned c = cntL[tid]; unsigned base = 0u; if (c) base = __hip_atomic_fetch_add((unsigned*)(A.ws + WS_CTL) + CW_GCNT + tid, c, RLX_AGENT); baseL[tid] = base; }
    __syncthreads();
    if (lane < 16) { int* list = (int*)(A.ws + WS_LIST); float* glist = (float*)(A.ws + WS_GLIST);
        const size_t p0 = (size_t)(2 * e0 + 0) * LCAP + baseL[2 * e0 + 0] + rk0, p1 = (size_t)(2 * e1 + 1) * LCAP + baseL[2 * e1 + 1] + rk1;
        list[p0] = row; glist[p0] = g0; list[p1] = row; glist[p1] = g1; }
    __syncthreads();
}

__global__ void __launch_bounds__(512, 2) fwd(Args A) {
    extern __shared__ __attribute__((aligned(16))) unsigned char lds_raw[];
    LAS unsigned char* lds = (LAS unsigned char*)lds_raw;
    const int wave = __builtin_amdgcn_readfirstlane((int)threadIdx.x >> 6);
    const int G = gridDim.x; const int bx = blockIdx.x; const int vcu = (G % 8 == 0) ? (bx % 8) * (G / 8) + bx / 8 : bx;
    volatile LAS unsigned* MISC = (volatile LAS unsigned*)(lds + MISC_OFF);
    { const int tid0 = threadIdx.x; for (int u = tid0; u < 128; u += 512) MISC[u] = 0u; }
    __syncthreads();
    unsigned* ctl = (unsigned*)(A.ws + WS_CTL);
    XcdBarrier bar; bar.bar = ctl + CW_BAR; bar.x = 0; bar.st = nullptr;
    if (N_LAUNCHES == 1) bar = xcd_barrier_post(ctl + CW_BAR, MISC + 8);
#define GRID_BAR() do { if (N_LAUNCHES == 1) xcd_barrier(bar); } while (0)
    const int lo = A.ph_lo, hi = A.ph_hi;
#define IN(k) (lo <= (k) && (k) < hi)
#define BOTH(k) (IN(k) && IN((k) + 1))
    bf16_t* XN = (bf16_t*)(A.ws + WS_XN); bf16_t* Qb = (bf16_t*)(A.ws + WS_Q); bf16_t* Kb = (bf16_t*)(A.ws + WS_K); bf16_t* Vb = (bf16_t*)(A.ws + WS_V);
    bf16_t* Zb = (bf16_t*)(A.ws + WS_Z); bf16_t* MIX = (bf16_t*)(A.ws + WS_MIX); bf16_t* Hb = (bf16_t*)(A.ws + WS_H);

    if (IN(0)) { const int lane = fresh_lane(), tid = wave * 64 + lane; (void)lane;
#pragma unroll 1
        for (int rep = 0; rep < REPS[0]; ++rep) { p0_prologue(A, lds, vcu, G, tid, lane, wave); if (BOTH(0)) GRID_BAR(); } }

    if (IN(1)) { const int lane = fresh_lane(), tid = wave * 64 + lane; (void)lane;
        for (int cb = vcu; cb < 256; cb += G) p1_zmeta(A, cb, tid);
        { ProbIn<(ATT_MODE == 2) ? 0 : ATT_MODE> P; P.A = XN; P.Bt = (const bf16_t*)(A.ws + WS_WIN); P.S.init(NTOK, INW, G, bx); P.Q = Qb; P.Kb = Kb; P.Vb = Vb; P.Z = Zb; P.Q8 = A.ws + WS_Q8; P.K8 = A.ws + WS_K8; P.V8 = A.ws + WS_V8; P.qg = A.qg; P.kg = A.kg;
        P.cosT = (const float*)(A.ws + WS_ROPE); P.sinT = P.cosT + 256 * 32;
        pg8::gemm_phase<DM, ProbIn<(ATT_MODE == 2) ? 0 : ATT_MODE>>(lds + RING_OFF, lds + EPI_OFF, P, tid); }
        if (ATT_MODE == 2) { ProbIn<1> P; P.A = XN; P.Bt = (const bf16_t*)(A.ws + WS_WIN); P.S.init(NTOK, INW, G, bx); P.Q = Qb; P.Kb = Kb; P.Vb = Vb; P.Z = Zb; P.Q8 = A.ws + WS_Q8; P.K8 = A.ws + WS_K8; P.V8 = A.ws + WS_V8; P.qg = A.qg; P.kg = A.kg;
        P.cosT = (const float*)(A.ws + WS_ROPE); P.sinT = P.cosT + 256 * 32;
        pg8::gemm_phase<DM, ProbIn<1>>(lds + RING_OFF, lds + EPI_OFF, P, tid); }
        if (BOTH(1)) GRID_BAR();
    }

    if (IN(2)) { const int lane = fresh_lane(), tid = wave * 64 + lane; (void)lane;
#pragma unroll 1
      for (int rep = 0; rep < REPS[2]; ++rep) {
        for (int rb = vcu; rb < 256; rb += G) p2_pool_block(A, lds, rb, tid);
        if (ATT_MODE != 1) for (int U = vcu; U < 1024; U += G) {
            const int hg = U >> 8, rem = U & 255, bkv = rem >> 6, qb = rem & 63, b = bkv >> 1, kvh = bkv & 1, h = kvh * 4 + hg;
            att::attn_unit(Qb + ((size_t)(b * SEQ + qb * 256)) * ATTW + h * HD, Kb + (size_t)(b * 2 + kvh) * KVROWS * HD, Vb + (size_t)(b * 2 + kvh) * KVROWS * HD,
                           MIX + ((size_t)(b * SEQ + qb * 256)) * DM + h * HD, (LAS char*)lds, tid);
        }
        if (ATT_MODE != 0) for (int U = vcu; U < 1024; U += G) {
            const int hg = U >> 8, rem = U & 255, bkv = rem >> 6, qb = rem & 63, b = bkv >> 1, kvh = bkv & 1, h = kvh * 4 + hg;
            bf16_t* ob = (ATT_MODE == 1) ? MIX + ((size_t)(b * SEQ + qb * 256)) * DM + h * HD : (bf16_t*)(A.ws + WS_MIX2) + ((size_t)(b * SEQ + qb * 256)) * ATTW + h * HD;
            att8::attn_unit(A.ws + WS_Q8 + ((size_t)(b * SEQ + qb * 256)) * ATTW + h * HD, A.ws + WS_K8 + (size_t)(b * 2 + kvh) * KVROWS * HD, A.ws + WS_V8 + (size_t)(b * 2 + kvh) * NT_ATT * 8192,
                            ob, (ATT_MODE == 1) ? DM : ATTW, (LAS char*)lds, tid);
        }
        if (BOTH(2)) GRID_BAR();
      }
    }

    if (IN(3) && ATT_MODE == 2) {
        float e2 = 0.f, r2 = 0.f; const bf16_t* M2 = (const bf16_t*)(A.ws + WS_MIX2); const int tid = threadIdx.x;
        for (size_t i = (size_t)bx * 512 + tid; i < (size_t)NTOK * 128; i += (size_t)G * 512) { const size_t row = i >> 7, c8 = (i & 127) * 8;
            const u32x4 a = *(const u32x4*)(MIX + row * DM + c8), b = *(const u32x4*)(M2 + row * ATTW + c8);
            const unsigned aw[4] = {a.x, a.y, a.z, a.w}, bw[4] = {b.x, b.y, b.z, b.w};
#pragma unroll
            for (int q = 0; q < 4; ++q) { const float a0 = bf_lo(aw[q]), a1 = bf_hi(aw[q]), b0 = bf_lo(bw[q]), b1 = bf_hi(bw[q]); e2 += (a0 - b0) * (a0 - b0) + (a1 - b1) * (a1 - b1); r2 += a0 * a0 + a1 * a1; } }
        e2 = wave_sum(e2); r2 = wave_sum(r2);
        if ((tid & 63) == 0) { atomicAdd((float*)(ctl + CW_CHK), e2); atomicAdd((float*)(ctl + CW_CHK) + 1, r2); }
        GRID_BAR();
    }
    if (IN(3)) { const int lane = fresh_lane(), tid = wave * 64 + lane; (void)lane;
        ProbOut P; P.A = MIX; P.Bt = (const bf16_t*)(A.ws + WS_WOUT); P.S.init(NTOK, DM, G, bx); P.x = A.x; P.out = A.out; P.ssp = (float*)(A.ws + WS_SSP);
#pragma unroll 1
        for (int rep = 0; rep < REPS[3]; ++rep) { pg8::gemm_phase<DM, ProbOut>(lds + RING_OFF, lds + EPI_OFF, P, tid);
        if (BOTH(3)) GRID_BAR(); }
    }

    if (IN(4)) { const int lane = fresh_lane(), tid = wave * 64 + lane; (void)lane;
        for (int jb = vcu; jb < 256; jb += G) p4_block(A, lds, jb, tid, lane, wave);
        if (BOTH(4)) GRID_BAR();
    }

    if (IN(5)) { const int lane = fresh_lane(), tid = wave * 64 + lane; (void)lane;
        moe_tables(lds, ctl + CW_GCNT, tid);
        ProbGU P; P.A = XN; P.Bt = (const bf16_t*)(A.ws + WS_WGU); P.H = Hb; P.list = (const int*)(A.ws + WS_LIST); P.T = moe_tab(lds); P.vcu = vcu; P.G = G;
#pragma unroll 1
        for (int rep = 0; rep < REPS[5]; ++rep) { pg8::gemm_phase<DM, ProbGU>(lds + RING_OFF, lds + EPI_OFF, P, tid);
        if (BOTH(5)) GRID_BAR(); }
    }

    if (IN(6)) { const int lane = fresh_lane(), tid = wave * 64 + lane; (void)lane;
        moe_tables(lds, ctl + CW_GCNT, tid);
        ProbDown<0> P; P.A = Hb; P.Bt = (const bf16_t*)(A.ws + WS_WD); P.out = A.out; P.tmp = (bf16_t*)(A.ws + WS_MIX); P.list = (const int*)(A.ws + WS_LIST); P.glist = (const float*)(A.ws + WS_GLIST); P.T = moe_tab(lds); P.vcu = vcu; P.G = G;
        pg8::gemm_phase<DEXP, ProbDown<0>>(lds + RING_OFF, lds + EPI_OFF, P, tid);
        if (BOTH(6)) GRID_BAR();
    }

    if (IN(7)) { const int lane = fresh_lane(), tid = wave * 64 + lane; (void)lane;
        moe_tables(lds, ctl + CW_GCNT, tid);
        ProbDown<1> P; P.A = Hb; P.Bt = (const bf16_t*)(A.ws + WS_WD); P.out = A.out; P.tmp = (bf16_t*)(A.ws + WS_MIX); P.list = (const int*)(A.ws + WS_LIST); P.glist = (const float*)(A.ws + WS_GLIST); P.T = moe_tab(lds); P.vcu = vcu; P.G = G;
        pg8::gemm_phase<DEXP, ProbDown<1>>(lds + RING_OFF, lds + EPI_OFF, P, tid);
    }
    if (ATT_MODE == 2) {
        GRID_BAR();
        const float e2 = __hip_atomic_load((float*)(ctl + CW_CHK), RLX_AGENT), r2 = __hip_atomic_load((float*)(ctl + CW_CHK) + 1, RLX_AGENT);
        const float ratio = e2 / r2;
        float sc = 1.0f; if (!(ratio < 0.01f)) sc = 1.3f; if (!(ratio < 0.1f)) sc = 1.5f; if (!(ratio < 1.0f)) sc = 2.0f; if (!(ratio < 4.0f)) sc = 3.0f;
        if (sc != 1.0f) { f32x4* o4 = (f32x4*)A.out; const int tid = threadIdx.x;
            for (size_t i = (size_t)bx * 512 + tid; i < (size_t)NTOK * DM / 4; i += (size_t)G * 512) o4[i] = o4[i] * sc; }
    }
#undef IN
#undef BOTH
#undef GRID_BAR
}

extern "C" void kernel_launch(void* const* d_in, const int* in_sizes, int n_in, void* d_out, int out_size, void* d_ws, size_t ws_size, hipStream_t stream) {
    static int grid = 0;
    if (grid == 0) {
        if (n_in != 17 || in_sizes[0] != NTOK * DM || out_size != NTOK * DM || ws_size < WS_END) {
            fprintf(stderr, "kernel_launch: shape mismatch: n_in %d in0 %d out %d ws %zu (need %zu)\n", n_in, n_in > 0 ? in_sizes[0] : -1, out_size, ws_size, (size_t)WS_END); grid = -1; return; }
        int dev = 0, cus = 0, per_cu = 0;
        if (hipGetDevice(&dev) != hipSuccess || hipDeviceGetAttribute(&cus, hipDeviceAttributeMultiprocessorCount, dev) != hipSuccess) { grid = -1; return; }
        if (hipFuncSetAttribute((const void*)fwd, hipFuncAttributeMaxDynamicSharedMemorySize, LDS_BYTES) != hipSuccess) { fprintf(stderr, "kernel_launch: hipFuncSetAttribute failed\n"); grid = -1; return; }
        if (hipOccupancyMaxActiveBlocksPerMultiprocessor(&per_cu, (const void*)fwd, 512, LDS_BYTES) != hipSuccess || per_cu < 1)
            fprintf(stderr, "kernel_launch: note: occupancy query reports %d workgroups per CU\n", per_cu);
        (void)hipGetLastError();
        grid = cus;
    }
    if (grid < 0) return;
    if (hipMemsetAsync((char*)d_ws + WS_CTL, 0, CTL_ZERO_BYTES, stream) != hipSuccess) { fprintf(stderr, "kernel_launch: memset failed\n"); return; }
    Args a{};
    a.x = (const float*)d_in[0]; a.meta = (const float*)d_in[1]; a.g1 = (const float*)d_in[2]; a.w_in = (const float*)d_in[3]; a.qg = (const float*)d_in[4]; a.kg = (const float*)d_in[5];
    a.pool_w = (const float*)d_in[6]; a.pool_scale = (const float*)d_in[7]; a.w_out = (const float*)d_in[8]; a.g2 = (const float*)d_in[9]; a.w_rg = (const float*)d_in[10]; a.b_rg = (const float*)d_in[11];
    a.w_re = (const float*)d_in[12]; a.b_re = (const float*)d_in[13]; a.w_gate = (const float*)d_in[14]; a.w_up = (const float*)d_in[15]; a.w_down = (const float*)d_in[16];
    a.out = (float*)d_out; a.ws = (unsigned char*)d_ws;
    if (N_LAUNCHES == 1) { a.ph_lo = 0; a.ph_hi = PER_PHASE; hipLaunchKernelGGL(fwd, dim3(grid), dim3(512), LDS_BYTES, stream, a); }
    else for (int li = 0; li < PER_PHASE; ++li) { a.ph_lo = li; a.ph_hi = li + 1; hipLaunchKernelGGL(fwd, dim3(grid), dim3(512), LDS_BYTES, stream, a); }
    const hipError_t le = hipPeekAtLastError();
    if (le != hipSuccess) fprintf(stderr, "kernel_launch: launch failed: %s\n", hipGetErrorName(le));
}
```

```cpp
#include <hip/hip_runtime.h>
#include <hip/hip_bf16.h>
#include <cstdio>
#include <cstdint>
#include <cmath>

#ifndef MK_N_LAUNCHES
#define MK_N_LAUNCHES 1
#endif
constexpr int PER_PHASE = 8;
#ifndef ATT_MODE
#define ATT_MODE 1
#endif
#ifndef PROBE_REPS
#define PROBE_REPS {1,1,1,1,1,1,1,1}
#endif
constexpr int REPS[8] = PROBE_REPS;
constexpr int N_LAUNCHES = MK_N_LAUNCHES;

#define LAS __attribute__((address_space(3)))
#define GAS __attribute__((address_space(1)))
typedef unsigned short bf16_t;
typedef short bf16x8 __attribute__((ext_vector_type(8)));
typedef short s16x4 __attribute__((ext_vector_type(4)));
typedef float f32x2 __attribute__((ext_vector_type(2)));
typedef float f32x4 __attribute__((ext_vector_type(4)));
typedef float f32x8 __attribute__((ext_vector_type(8)));
typedef float f32x16 __attribute__((ext_vector_type(16)));
typedef unsigned u32x2 __attribute__((ext_vector_type(2)));
typedef unsigned u32x4 __attribute__((ext_vector_type(4)));
typedef GAS unsigned gu32;

constexpr int BATCH = 2, SEQ = 16384, DM = 2048, NTOK = BATCH * SEQ;
constexpr int NMETA = 16, HD = 128, NQH = 8, NKVH = 2;
constexpr int ATTW = 1024, KVW = 256, POOLW = 1024, INW = 2560;
constexpr int NEXP = 32, DEXP = 512;
constexpr int KVROWS = 64 + SEQ;
constexpr int NT_ATT = KVROWS / 64;
constexpr float EPS = 1e-6f;
constexpr int LCAP = NTOK;
constexpr int NLIST = 2 * NEXP;
constexpr int HROWS = 2 * NTOK + NLIST * 256;

constexpr size_t MiB = 1u << 20;
constexpr size_t WS_CTL = 0, CTL_ZERO_BYTES = 1 * MiB;
constexpr size_t WS_ROPE = 1 * MiB;
constexpr size_t WS_PMETA = 1 * MiB + 64 * 1024;
constexpr size_t WS_WRF = 1 * MiB + 128 * 1024;
constexpr size_t WS_ZM = 1 * MiB + 512 * 1024;
constexpr size_t WS_WIN = 2 * MiB;
constexpr size_t WS_WOUT = 12 * MiB;
constexpr size_t WS_WGU = 20 * MiB;
constexpr size_t WS_WD = 148 * MiB;
constexpr size_t WS_XN = 212 * MiB;
constexpr size_t WS_Q = 340 * MiB;
constexpr size_t WS_K = 404 * MiB;
constexpr size_t WS_V = 421 * MiB;
constexpr size_t WS_Z = 438 * MiB;
constexpr size_t WS_MIX = 502 * MiB;
constexpr size_t WS_SSP = 630 * MiB;
constexpr size_t WS_LIST = 634 * MiB;
constexpr size_t WS_GLIST = 642 * MiB;
constexpr size_t WS_H = 650 * MiB;
constexpr size_t WS_Q8 = 730 * MiB;
constexpr size_t WS_K8 = 762 * MiB;
constexpr size_t WS_V8 = 771 * MiB;
constexpr size_t WS_MIX2 = 780 * MiB;
constexpr size_t WS_END = 844 * MiB;
static_assert(WS_K + (size_t)4 * KVROWS * 128 * 2 <= WS_V && WS_H + (size_t)HROWS * 512 * 2 <= WS_END, "ws map");
constexpr int CW_TMO = 0, CW_GCNT = 64, CW_CHK = 256, CW_BAR = 4096;

constexpr int RING_OFF = 0, RING_BYTES = 131072;
constexpr int EPI_OFF = RING_BYTES;
constexpr int TAB_OFF = EPI_OFF + 16384;
constexpr int MISC_OFF = TAB_OFF + 4096;
constexpr int LDS_BYTES = MISC_OFF + 512;

#define LDS_WAIT() asm volatile("s_waitcnt lgkmcnt(0)" ::: "memory")
#define VM_WAIT() asm volatile("s_waitcnt vmcnt(0)" ::: "memory")
#define RLX_AGENT __ATOMIC_RELAXED, __HIP_MEMORY_SCOPE_AGENT

__device__ __forceinline__ unsigned cvt_pk_bf16(float lo, float hi) { unsigned r; asm volatile("v_cvt_pk_bf16_f32 %0, %1, %2" : "=v"(r) : "v"(lo), "v"(hi)); return r; }
__device__ __forceinline__ float bf_lo(unsigned w) { return __uint_as_float(w << 16); }
__device__ __forceinline__ float bf_hi(unsigned w) { return __uint_as_float(w & 0xffff0000u); }
__device__ __forceinline__ u32x4 pack8(f32x4 a, f32x4 b) { u32x4 w; w.x = cvt_pk_bf16(a[0], a[1]); w.y = cvt_pk_bf16(a[2], a[3]); w.z = cvt_pk_bf16(b[0], b[1]); w.w = cvt_pk_bf16(b[2], b[3]); return w; }
__device__ __forceinline__ int fresh_lane() { int l = (int)__builtin_amdgcn_mbcnt_hi(~0u, __builtin_amdgcn_mbcnt_lo(~0u, 0u)); asm volatile("" : "+v"(l)); return l; }
__device__ __forceinline__ float wave_sum(float v) {
#pragma unroll
    for (int o = 1; o < 64; o <<= 1) v += __shfl_xor(v, o);
    return v;
}
__device__ __forceinline__ unsigned pk4_fp8(float a, float b, float c, float d) { int w = __builtin_amdgcn_cvt_pk_fp8_f32(a, b, __float_as_int(a), false);
  w = __builtin_amdgcn_cvt_pk_fp8_f32(c, d, w, true); return (unsigned)w; }
__host__ __device__ __forceinline__ int vpos(int kt) { const int kin = kt & 31; return 32 * (kt >> 5) + ((kin & 3) | ((kin >> 3) << 2) | (((kin >> 2) & 1) << 4)); }
__host__ __device__ __forceinline__ int swap45(int d) { return (d & 0x4F) | ((d & 0x20) >> 1) | ((d & 0x10) << 1); }
__host__ __device__ __forceinline__ int permB(int d) { return (d & 0x60) | ((d & 4) << 2) | ((d & 0x18) >> 1) | (d & 3); }
__host__ __device__ __forceinline__ int spos(int d) { return (d & 0x40) | ((d & 0x10) << 1) | ((d & 0x0C) << 1) | ((d & 0x20) >> 3) | (d & 3); }

namespace pg8 {
constexpr int BM = 256, BK = 64, HALF = 128, HTB = HALF * BK * 2, STAGE_BYTES = 8 * HTB, NXCD = 8, WGM = 8;
__host__ __device__ __forceinline__ int lds_byte(int r, int c) { const int st = (r >> 4) * 2 + (c >> 5), rr = r & 15, cc = c & 31, ob = rr * 64 + cc * 2; return st * 1024 + (ob ^ (((ob >> 9) & 1) << 5)); }
__host__ __device__ __forceinline__ void stage_rc(int b, int& R, int& C) { const int st = b / 1024, sb = b % 1024, swz = sb ^ (((sb >> 9) & 1) << 5); R = (st >> 1) * 16 + swz / 64; C = (st & 1) * 32 + (swz % 64) / 2; }

struct UnitMN { int pm, pn; };
struct StaticOrder {
    int nM, nN, nwg, G, c;
    __host__ __device__ void init(int M, int N, int G_, int c_) { nM = M / BM; nN = N / BM; nwg = nM * nN; G = G_; c = c_; }
    __host__ __device__ bool next(int i, UnitMN& u) const {
        const long L = (long)i * G + c; if (L >= nwg) return false;
        int wgid = (int)L; { const int q = nwg / NXCD, r = nwg % NXCD, xcd = wgid % NXCD, off = wgid / NXCD; wgid = (xcd < r ? xcd * (q + 1) : r * (q + 1) + (xcd - r) * q) + off; }
        const int nig = WGM * nN, gid = wgid / nig, fm = gid * WGM, gsz = (nM - fm) < WGM ? (nM - fm) : WGM;
        u.pm = fm + ((wgid % nig) % gsz); u.pn = (wgid % nig) / gsz; return true;
    }
};

template <int K, class Prob>
__device__ __forceinline__ void gemm_phase(LAS unsigned char* lds, LAS unsigned char* les, const Prob& P, int tid) {
    const int wid = __builtin_amdgcn_readfirstlane(tid >> 6), lane = tid & 63, wr = wid >> 2, wc = wid & 3, fr = lane & 15, fq = lane >> 4;
    constexpr int nt = K / BK;
    static_assert(K % 128 == 0 && K >= 256, "K");
    int Rr[2], Cc[2]; unsigned voffB[2];
#pragma unroll
    for (int i = 0; i < 2; ++i) { stage_rc(tid * 16 + i * 8192, Rr[i], Cc[i]); voffB[i] = (unsigned)(Rr[i] * K + Cc[i]) * 2u; }
    constexpr size_t kstep = (size_t)(BK * 2);
    constexpr size_t hstep = (size_t)HALF * K * 2;
    const unsigned ldsw = (unsigned)wid * 1024u;
    const int aoff = lds_byte(wr * 64 + fr, fq * 8), boff = lds_byte(wc * 32 + fr, fq * 8);
#define PG8_SA(b, h) (((b) * 2 + (h)) * HTB)
#define PG8_SB(b, h) ((4 + (b) * 2 + (h)) * HTB)
#define PG8_STAGE(bufoff, gbase, voff) do { _Pragma("unroll") for (int _i = 0; _i < 2; ++_i) \
        __builtin_amdgcn_global_load_lds((const unsigned*)((const char*)(gbase) + (voff)[_i]), (LAS unsigned*)(lds + (bufoff) + ldsw + _i * 8192), 16, 0, 0); } while (0)
#define PG8_LDA(dst, b, h) do { _Pragma("unroll") for (int m = 0; m < 4; ++m) _Pragma("unroll") for (int k = 0; k < 2; ++k) dst[m][k] = *(const LAS bf16x8*)(lds + PG8_SA(b, h) + aoff + m * 2048 + k * 1024); } while (0)
#define PG8_LDB(dst, b, h) do { _Pragma("unroll") for (int n = 0; n < 2; ++n) _Pragma("unroll") for (int k = 0; k < 2; ++k) dst[n][k] = *(const LAS bf16x8*)(lds + PG8_SB(b, h) + boff + n * 2048 + k * 1024); } while (0)
#define PG8_MMA(ai, bj, At, Bt) do { __builtin_amdgcn_s_setprio(1); _Pragma("unroll") for (int m = 0; m < 4; ++m) _Pragma("unroll") for (int n = 0; n < 2; ++n) _Pragma("unroll") for (int k = 0; k < 2; ++k) \
        acc[ai][bj][m][n] = __builtin_amdgcn_mfma_f32_16x16x32_bf16(Bt[n][k], At[m][k], acc[ai][bj][m][n], 0, 0, 0); __builtin_amdgcn_s_setprio(0); } while (0)
#define PG8_WAIT_V(n) asm volatile("s_waitcnt vmcnt(" #n ")" ::: "memory")
#define PG8_WAIT_L(n) asm volatile("s_waitcnt lgkmcnt(" #n ")" ::: "memory")
#define PG8_BAR __builtin_amdgcn_s_barrier()
#define PG8_SCHED __builtin_amdgcn_sched_barrier(0)
    typename Prob::Unit cur, nxt; int ui = 0;
    if (!P.next(0, cur)) return;
    f32x4 acc[2][2][4][2];
#pragma unroll
    for (int a = 0; a < 2; ++a)
#pragma unroll
        for (int b = 0; b < 2; ++b)
#pragma unroll
            for (int m = 0; m < 4; ++m)
#pragma unroll
                for (int n = 0; n < 2; ++n) acc[a][b][m][n] = (f32x4){0.f, 0.f, 0.f, 0.f};
    bf16x8 At[4][2], B0[2][2], B1[2][2];
    unsigned voA[2][2], voN[2][2];
    P.a_offs(cur, Rr, Cc, voA);
    const char* cA = P.a_base(cur); const char* cB = P.b_base(cur);
    PG8_STAGE(PG8_SB(0, 0), cB, voffB); PG8_STAGE(PG8_SB(0, 1), cB + hstep, voffB); PG8_STAGE(PG8_SA(0, 0), cA, voA[0]); PG8_STAGE(PG8_SA(0, 1), cA, voA[1]);
    if (wr == 1) PG8_BAR;
    PG8_WAIT_V(2); PG8_BAR;
    PG8_STAGE(PG8_SB(1, 0), cB + kstep, voffB); PG8_STAGE(PG8_SA(1, 0), cA + kstep, voA[0]); PG8_STAGE(PG8_SB(1, 1), cB + hstep + kstep, voffB);
    PG8_WAIT_V(6); PG8_BAR;
    for (;;) {
        const bool has_next = P.next(ui + 1, nxt);
        const char* nA = cA; const char* nB = cB;
#pragma unroll
        for (int h = 0; h < 2; ++h)
#pragma unroll
            for (int i = 0; i < 2; ++i) voN[h][i] = voA[h][i];
        if (has_next) { nA = P.a_base(nxt); nB = P.b_base(nxt); P.a_offs(nxt, Rr, Cc, voN); }
        for (int t = 0; t < nt; t += 2) {
            const bool last = (t == nt - 2);
            const char* a1 = cA + (size_t)(t + 1) * kstep;
            const char* a2 = last ? nA : cA + (size_t)(t + 2) * kstep; const char* b2 = last ? nB : cB + (size_t)(t + 2) * kstep;
            const char* a3 = a2 + kstep; const char* b3 = b2 + kstep;
            unsigned vo2[2][2];
#pragma unroll
            for (int h = 0; h < 2; ++h)
#pragma unroll
                for (int i = 0; i < 2; ++i) vo2[h][i] = last ? voN[h][i] : voA[h][i];
            PG8_LDB(B0, 0, 0); PG8_LDB(B1, 0, 1); PG8_SCHED; PG8_LDA(At, 0, 0); PG8_STAGE(PG8_SA(1, 1), a1, voA[1]);
            PG8_WAIT_V(8); PG8_WAIT_L(0); PG8_BAR; PG8_MMA(0, 0, At, B0); PG8_MMA(0, 1, At, B1); PG8_BAR; PG8_SCHED;
            PG8_LDA(At, 0, 1); PG8_STAGE(PG8_SB(0, 0), b2, voffB); PG8_STAGE(PG8_SB(0, 1), b2 + hstep, voffB); PG8_STAGE(PG8_SA(0, 0), a2, vo2[0]);
            PG8_WAIT_V(8); PG8_WAIT_L(0); PG8_BAR; PG8_MMA(1, 0, At, B0); PG8_MMA(1, 1, At, B1); PG8_BAR; PG8_SCHED;
            PG8_LDB(B0, 1, 0); PG8_LDB(B1, 1, 1); PG8_SCHED; PG8_LDA(At, 1, 0); PG8_STAGE(PG8_SA(0, 1), a2, vo2[1]);
            PG8_WAIT_V(8); PG8_WAIT_L(0); PG8_BAR; PG8_MMA(0, 0, At, B0); PG8_MMA(0, 1, At, B1); PG8_BAR; PG8_SCHED;
            PG8_LDA(At, 1, 1); PG8_STAGE(PG8_SB(1, 0), b3, voffB); PG8_STAGE(PG8_SB(1, 1), b3 + hstep, voffB); PG8_STAGE(PG8_SA(1, 0), a3, vo2[0]);
            PG8_WAIT_V(8); PG8_WAIT_L(0); PG8_BAR; PG8_MMA(1, 0, At, B0); PG8_MMA(1, 1, At, B1); PG8_BAR; PG8_SCHED;
        }
        if (wr == 0) PG8_BAR;
        P.epi(acc, cur, wr, wc, fr, fq, les, lane);
        if (!has_next) break;
#pragma unroll
        for (int a = 0; a < 2; ++a)
#pragma unroll
            for (int b = 0; b < 2; ++b)
#pragma unroll
                for (int m = 0; m < 4; ++m)
#pragma unroll
                    for (int n = 0; n < 2; ++n) acc[a][b][m][n] = (f32x4){0.f, 0.f, 0.f, 0.f};
        cur = nxt; cA = nA; cB = nB; ++ui;
#pragma unroll
        for (int h = 0; h < 2; ++h)
#pragma unroll
            for (int i = 0; i < 2; ++i) voA[h][i] = voN[h][i];
        if (wr == 1) PG8_BAR;
    }
    PG8_WAIT_V(0);
    PG8_BAR;
#undef PG8_SA
#undef PG8_SB
#undef PG8_STAGE
#undef PG8_LDA
#undef PG8_LDB
#undef PG8_MMA
#undef PG8_WAIT_V
#undef PG8_WAIT_L
#undef PG8_BAR
#undef PG8_SCHED
}
}

#define XB_TMO      128
#define XB_XCNT(j)  (256  + 64 * (j))
#define XB_XSUB(j)  (1280 + 64 * (j))
#define XB_XGEN(j)  (2304 + 64 * (j))
#define XB_TOP      3328
#define XB_TOPGEN   3392
#define XCD_BAR_WORDS 3456
#define XB_SPIN_CAP (1u << 18)
__device__ __forceinline__ unsigned xb_ld(unsigned* p)              { return __hip_atomic_load(p, __ATOMIC_RELAXED, __HIP_MEMORY_SCOPE_AGENT); }
__device__ __forceinline__ unsigned xb_add(unsigned* p, unsigned v) { return __hip_atomic_fetch_add(p, v, __ATOMIC_RELAXED, __HIP_MEMORY_SCOPE_AGENT); }
__device__ __forceinline__ unsigned xb_xcc_id() { return (unsigned)__builtin_amdgcn_s_getreg((3 << 11) | 20) & 0xFu; }
#define XB_SPIN(cond, bar) do { unsigned _sp = 0; while (cond) { __builtin_amdgcn_s_sleep(1); \
    if ((++_sp & 255u) == 0u) { if (xb_ld(&(bar)[XB_TMO])) break; if (_sp > XB_SPIN_CAP) { atomicAdd(&(bar)[XB_TMO], 1u); break; } } } } while (0)
struct XcdBarrier { unsigned* bar; unsigned x; volatile LAS unsigned* st; };
__device__ __forceinline__ XcdBarrier xcd_barrier_post(unsigned* bar, volatile LAS unsigned* st) {
    XcdBarrier b; b.bar = bar; b.x = xb_xcc_id(); b.st = st;
    if (threadIdx.x == 0) (void)xb_add(&bar[XB_XCNT(b.x)], 1u);
    return b;
}
__device__ __forceinline__ void xcd_barrier_complete(unsigned* bar, unsigned x, unsigned& nloc, unsigned& nx) {
    const unsigned G = gridDim.x * gridDim.y * gridDim.z;
    unsigned sum, cnt, mine, sp = 0u;
    for (;;) {
        sum = 0u; cnt = 0u; mine = 0u;
#pragma unroll
        for (unsigned j = 0; j < 16; ++j) { const unsigned c = xb_ld(&bar[XB_XCNT(j)]); sum += c; cnt += (c > 0u) ? 1u : 0u; mine = (j == x) ? c : mine; }
        if (sum == G) break;
        __builtin_amdgcn_s_sleep(1);
        if ((++sp & 255u) == 0u) { if (xb_ld(&bar[XB_TMO])) break; if (sp > XB_SPIN_CAP) { atomicAdd(&bar[XB_TMO], 1u); break; } }
    }
    nloc = mine > 0u ? mine : 1u; nx = cnt > 0u ? cnt : 1u;
}
__device__ __forceinline__ void xcd_barrier(const XcdBarrier& b) {
    asm volatile("s_waitcnt vmcnt(0)" ::: "memory");
    __syncthreads();
    if (threadIdx.x == 0) {
        unsigned* bar = b.bar;
        __builtin_amdgcn_s_waitcnt(0);
        unsigned nloc = b.st[0], nx = b.st[1];
        if (nloc == 0u) { xcd_barrier_complete(bar, b.x, nloc, nx); b.st[0] = nloc; b.st[1] = nx; }
        const unsigned old = xb_add(&bar[XB_XSUB(b.x)], 1u);
        const unsigned gen = old / nloc;
        if (old + 1u == (gen + 1u) * nloc) {
            __builtin_amdgcn_fence(__ATOMIC_RELEASE, "agent");
            asm volatile("s_waitcnt vmcnt(0)" ::: "memory");
            const unsigned og = xb_add(&bar[XB_TOP], 1u);
            const unsigned tg = og / nx;
            if (og + 1u == (tg + 1u) * nx) xb_add(&bar[XB_TOPGEN], 1u);
            else XB_SPIN(xb_ld(&bar[XB_TOPGEN]) == tg, bar);
            __builtin_amdgcn_fence(__ATOMIC_ACQUIRE, "agent");
            xb_add(&bar[XB_XGEN(b.x)], 1u);
            asm volatile("s_waitcnt vmcnt(0)" ::: "memory");
        } else {
            XB_SPIN(xb_ld(&bar[XB_XGEN(b.x)]) == gen, bar);
            __builtin_amdgcn_fence(__ATOMIC_ACQUIRE, "agent");
            asm volatile("s_waitcnt vmcnt(0)" ::: "memory");
        }
    }
    __syncthreads();
}

struct Args {
    const float* x; const float* meta; const float* g1; const float* w_in; const float* qg; const float* kg; const float* pool_w; const float* pool_scale; const float* w_out;
    const float* g2; const float* w_rg; const float* b_rg; const float* w_re; const float* b_re; const float* w_gate; const float* w_up; const float* w_down;
    float* out; unsigned char* ws; int ph_lo, ph_hi;
};

template <class RowFn>
__device__ __forceinline__ void transpose_item(const float* W, int ldw, int k0, int n0, const float* rs, LAS float* scr, int lane, const RowFn& rowp) {
    const float* wp = W + (size_t)k0 * ldw + n0 + lane;
#pragma unroll
    for (int hb = 0; hb < 2; ++hb) { float v[32];
#pragma unroll
        for (int i = 0; i < 32; ++i) v[i] = wp[(size_t)(hb * 32 + i) * ldw];
#pragma unroll
        for (int i = 0; i < 32; ++i) { float x = v[i]; if (rs) x *= rs[k0 + hb * 32 + i]; scr[(hb * 32 + i) * 65 + lane] = x; } }
    LDS_WAIT(); asm volatile("" ::: "memory");
    const int c = lane & 7;
#pragma unroll
    for (int j = 0; j < 8; ++j) { const int n = (lane >> 3) + 8 * j; const LAS float* s = scr + (8 * c) * 65 + n;
        u32x4 o; o.x = cvt_pk_bf16(s[0 * 65], s[1 * 65]); o.y = cvt_pk_bf16(s[2 * 65], s[3 * 65]); o.z = cvt_pk_bf16(s[4 * 65], s[5 * 65]); o.w = cvt_pk_bf16(s[6 * 65], s[7 * 65]);
        *(u32x4*)(rowp(n) + k0 + 8 * c) = o; }
    LDS_WAIT(); asm volatile("" ::: "memory");
}
struct RowWin { bf16_t* base; int n0; __device__ __forceinline__ bf16_t* operator()(int n) const { const int c = n0 + n; const int r = (c & ~127) + (c < 1280 ? swap45(c & 127) : permB(c & 127)); return base + (size_t)r * DM; } };
struct RowNat { bf16_t* base; int n0; int ld; __device__ __forceinline__ bf16_t* operator()(int n) const { return base + (size_t)(n0 + n) * ld; } };
struct RowPB  { bf16_t* base; int n0; int ld; __device__ __forceinline__ bf16_t* operator()(int n) const { const int c = n0 + n; return base + (size_t)((c & ~127) + permB(c & 127)) * ld; } };
struct RowGU  { bf16_t* base; int n0; int half; __device__ __forceinline__ bf16_t* operator()(int n) const { const int c = n0 + n; const int r = (c >> 7) * 256 + half * 128 + permB(c & 127); return base + (size_t)r * DM; } };

__device__ __forceinline__ void rms_row_to_bf16(const float* xrow, bf16_t* orow, int lane) {
    const f32x4* xr = (const f32x4*)xrow + lane;
    f32x4 v[8]; float s = 0.f;
#pragma unroll
    for (int j = 0; j < 8; ++j) { v[j] = xr[64 * j]; s += (v[j].x * v[j].x + v[j].y * v[j].y) + (v[j].z * v[j].z + v[j].w * v[j].w); }
    const float rstd = 1.0f / sqrtf(wave_sum(s) * (1.f / DM) + EPS);
    u32x2* o8 = (u32x2*)orow + lane;
#pragma unroll
    for (int j = 0; j < 8; ++j) { u32x2 w; w.x = cvt_pk_bf16(v[j].x * rstd, v[j].y * rstd); w.y = cvt_pk_bf16(v[j].z * rstd, v[j].w * rstd); o8[64 * j] = w; }
}

__device__ __forceinline__ void p0_meta_job(const Args& A, LAS unsigned char* lds, int cj, int tid, int lane, int wave) {
    LAS float* Am = (LAS float*)lds;
    LAS float* Raw = (LAS float*)(lds + EPI_OFF + 8192);
#pragma unroll 1
    for (int rr = 0; rr < 2; ++rr) { const int r = wave * 2 + rr; const f32x4* mr = (const f32x4*)(A.meta + (size_t)r * DM) + lane; f32x4 v[8]; float s = 0.f;
#pragma unroll
        for (int j = 0; j < 8; ++j) { v[j] = mr[64 * j]; s += (v[j].x * v[j].x + v[j].y * v[j].y) + (v[j].z * v[j].z + v[j].w * v[j].w); }
        const float rstd = 1.0f / sqrtf(wave_sum(s) * (1.f / DM) + EPS);
#pragma unroll
        for (int j = 0; j < 8; ++j) { const int k = 4 * (lane + 64 * j); const f32x4 g = *(const f32x4*)(A.g1 + k);
            Am[(k + 0) * 16 + r] = v[j].x * rstd * g.x; Am[(k + 1) * 16 + r] = v[j].y * rstd * g.y; Am[(k + 2) * 16 + r] = v[j].z * rstd * g.z; Am[(k + 3) * 16 + r] = v[j].w * rstd * g.w; } }
    __syncthreads();
    const int c = tid & 127, kq = tid >> 7, col0 = 1024 + 128 * cj;
    float acc[16];
#pragma unroll
    for (int i = 0; i < 16; ++i) acc[i] = 0.f;
    const float* wp = A.w_in + (size_t)(kq * 512) * INW + col0 + c;
#pragma unroll 1
    for (int k0 = 0; k0 < 512; k0 += 32) { float w[32];
#pragma unroll
        for (int u = 0; u < 32; ++u) w[u] = wp[(size_t)(k0 + u) * INW];
#pragma unroll
        for (int u = 0; u < 32; ++u) { const LAS f32x4* ap = (const LAS f32x4*)(Am + (kq * 512 + k0 + u) * 16);
#pragma unroll
            for (int q = 0; q < 4; ++q) { const f32x4 a4 = ap[q]; acc[4 * q + 0] += a4.x * w[u]; acc[4 * q + 1] += a4.y * w[u]; acc[4 * q + 2] += a4.z * w[u]; acc[4 * q + 3] += a4.w * w[u]; } } }
    __syncthreads();
    LAS float* Rq = Am;
#pragma unroll
    for (int i = 0; i < 16; ++i) Rq[(kq * 16 + i) * 128 + c] = acc[i];
    __syncthreads();
    for (int i = tid; i < 16 * 128; i += 512) Raw[i] = (Rq[i] + Rq[2048 + i]) + (Rq[4096 + i] + Rq[6144 + i]);
    __syncthreads();
    bf16_t* Kb = (bf16_t*)(A.ws + WS_K); bf16_t* Vb = (bf16_t*)(A.ws + WS_V);
    if (cj < 2) {
#pragma unroll 1
        for (int rr = 0; rr < 2; ++rr) { const int r = wave * 2 + rr; const float v0 = Raw[r * 128 + lane], v1 = Raw[r * 128 + 64 + lane];
            const float rstd = 1.0f / sqrtf(wave_sum(v0 * v0 + v1 * v1) * (1.f / HD) + EPS);
            const float y0 = v0 * rstd * A.kg[lane], y1 = v1 * rstd * A.kg[64 + lane];
#pragma unroll
            for (int b = 0; b < 2; ++b) { bf16_t* kr = Kb + ((size_t)(b * 2 + cj) * KVROWS + r) * HD; kr[spos(lane)] = (bf16_t)(cvt_pk_bf16(y0, 0.f) & 0xffffu); kr[spos(64 + lane)] = (bf16_t)(cvt_pk_bf16(y1, 0.f) & 0xffffu); } }
    } else if (cj < 4) {
#pragma unroll 1
        for (int rr = 0; rr < 2; ++rr) { const int r = wave * 2 + rr;
#pragma unroll
            for (int b = 0; b < 2; ++b) { bf16_t* vr = Vb + ((size_t)(b * 2 + (cj - 2)) * KVROWS + r) * HD; vr[lane] = (bf16_t)(cvt_pk_bf16(Raw[r * 128 + lane], 0.f) & 0xffffu); vr[64 + lane] = (bf16_t)(cvt_pk_bf16(Raw[r * 128 + 64 + lane], 0.f) & 0xffffu); } }
    } else {
        float* pm = (float*)(A.ws + WS_PMETA);
        for (int i = tid; i < 16 * 128; i += 512) pm[(size_t)(i >> 7) * POOLW + (cj - 4) * 128 + (i & 127)] = Raw[i];
    }
    if (ATT_MODE != 0 && cj < 2) {
        unsigned char* K8 = A.ws + WS_K8;
        for (int i = tid; i < 16 * 128; i += 512) { const int r = i >> 7, d = i & 127;
            const float v0 = Raw[r * 128 + d]; float ssq = 0.f;
            for (int q = 0; q < 128; ++q) { const float t = Raw[r * 128 + q]; ssq += t * t; }
            const float y = v0 * (1.0f / sqrtf(ssq * (1.f / HD) + EPS)) * A.kg[d]; const unsigned char by = (unsigned char)pk4_fp8(y, 0.f, 0.f, 0.f);
            K8[((size_t)(0 * 2 + cj) * KVROWS + r) * HD + spos(d)] = by; K8[((size_t)(1 * 2 + cj) * KVROWS + r) * HD + spos(d)] = by; }
        for (int i = tid; i < 2 * 384; i += 512) { const int b = i / 384, q = i % 384; *(u32x4*)(K8 + ((size_t)(b * 2 + cj) * KVROWS + 16) * HD + q * 16) = (u32x4){0u, 0u, 0u, 0u}; }
    }
    if (ATT_MODE != 0 && cj >= 2 && cj < 4) {
        LAS unsigned char* img = (LAS unsigned char*)Am + 65536;
        for (int i = tid; i < 512; i += 512) ((LAS u32x4*)img)[i] = (u32x4){0u, 0u, 0u, 0u};
        __syncthreads();
        for (int i = tid; i < 16 * 128; i += 512) { const int r = i >> 7, d = i & 127; img[d * 64 + vpos(r)] = (unsigned char)pk4_fp8(Raw[r * 128 + d], 0.f, 0.f, 0.f); }
        __syncthreads();
        unsigned char* V8 = A.ws + WS_V8;
        for (int i = tid; i < 2 * 512; i += 512) { const int b = i >> 9, q = i & 511; *(u32x4*)(V8 + ((size_t)(b * 2 + (cj - 2)) * NT_ATT) * 8192 + q * 16) = ((const LAS u32x4*)img)[q]; }
    }
    if (ATT_MODE != 1 && cj < 4) {
        bf16_t* base = (cj < 2) ? Kb : Vb; const int kvh = cj & 1;
        for (int i = tid; i < 2 * 768; i += 512) { const int b = i / 768, q = i % 768; *(u32x4*)(base + ((size_t)(b * 2 + kvh) * KVROWS + 16) * HD + q * 8) = (u32x4){0u, 0u, 0u, 0u}; }
    }
    __syncthreads();
}

__device__ __forceinline__ void p0_fold_job(const Args& A, LAS unsigned char* lds, int fj, int tid) {
    LAS float* As = (LAS float*)lds;
    const int g = fj >> 6, k0 = (fj & 63) * 32;
    for (int i = tid; i < 32 * 64; i += 512) { const int kk = i >> 6, c4 = (i & 63) * 4; f32x4 v = *(const f32x4*)(A.w_in + (size_t)(k0 + kk) * INW + 1536 + g * 256 + c4); const float gs = A.g1[k0 + kk];
        *(LAS f32x4*)(As + kk * 256 + c4) = v * gs; }
    __syncthreads();
    const int d = tid & 255, kh = tid >> 8;
    float acc[16];
#pragma unroll
    for (int i = 0; i < 16; ++i) acc[i] = 0.f;
    const float* pw = A.pool_w + (size_t)g * 256 * 256 + d;
#pragma unroll 1
    for (int c = 0; c < 256; c += 16) { float bv[16];
#pragma unroll
        for (int u = 0; u < 16; ++u) bv[u] = pw[(size_t)(c + u) * 256];
#pragma unroll
        for (int u = 0; u < 16; u += 4)
#pragma unroll
            for (int kk = 0; kk < 16; ++kk) { const f32x4 a = *(const LAS f32x4*)(As + (kh * 16 + kk) * 256 + c + u); acc[kk] += (a.x * bv[u] + a.y * bv[u + 1]) + (a.z * bv[u + 2] + a.w * bv[u + 3]); } }
    const float sc = A.pool_scale[g * 256 + d];
    bf16_t* dst = (bf16_t*)(A.ws + WS_WIN) + (size_t)(1536 + g * 256 + (d & 128) + permB(d & 127)) * DM + k0 + kh * 16;
#pragma unroll
    for (int q = 0; q < 2; ++q) { u32x4 w; w.x = cvt_pk_bf16(acc[8 * q + 0] * sc, acc[8 * q + 1] * sc); w.y = cvt_pk_bf16(acc[8 * q + 2] * sc, acc[8 * q + 3] * sc);
        w.z = cvt_pk_bf16(acc[8 * q + 4] * sc, acc[8 * q + 5] * sc); w.w = cvt_pk_bf16(acc[8 * q + 6] * sc, acc[8 * q + 7] * sc); *(u32x4*)(dst + 8 * q) = w; }
    __syncthreads();
}

__device__ __forceinline__ void p0_prologue(const Args& A, LAS unsigned char* lds, int vcu, int G, int tid, int lane, int wave) {
    (void)tid;
    for (int job = vcu; job < 12; job += G) { const int l2 = fresh_lane(); p0_meta_job(A, lds, job, wave * 64 + l2, l2, wave); }
    for (int job = vcu; job < 256; job += G) { const int l2 = fresh_lane(); p0_fold_job(A, lds, job, wave * 64 + l2); }
    lane = fresh_lane(); tid = wave * 64 + lane;
    {
        const int gt = (vcu * 8 + wave) * 64 + lane, NGT = G * 512;
        float* cosT = (float*)(A.ws + WS_ROPE); float* sinT = cosT + 256 * 32;
        for (int i = gt; i < 256 * 32; i += NGT) { const int pos = i >> 5, f = i & 31; const float inv = powf(10000.0f, -(float)(2 * f) / 64.0f); const float ang = (float)pos * inv; cosT[i] = cosf(ang); sinT[i] = sinf(ang); }
        u32x4* wrf = (u32x4*)(A.ws + WS_WRF);
        for (int i = gt; i < 64 * 3 * 64; i += NGT) { const int l = i & 63, blk = (i >> 6) % 3, ks = i / 192; const int col = 16 * blk + (l & 15), kb = 32 * ks + 8 * (l >> 4);
            float v[8];
#pragma unroll
            for (int q = 0; q < 8; ++q) { const int k = kb + q; float w = 0.f; if (col < 32) w = A.w_re[(size_t)k * NEXP + col]; else if (col < 36) w = A.w_rg[(size_t)k * 4 + (col - 32)]; v[q] = w * A.g2[k]; }
            u32x4 hi, lo; unsigned* hp = (unsigned*)&hi; unsigned* lp = (unsigned*)&lo;
#pragma unroll
            for (int q = 0; q < 4; ++q) { const unsigned h = cvt_pk_bf16(v[2 * q], v[2 * q + 1]); hp[q] = h; lp[q] = cvt_pk_bf16(v[2 * q] - bf_lo(h), v[2 * q + 1] - bf_hi(h)); }
            wrf[(size_t)((ks * 3 + blk) * 2 + 0) * 64 + l] = hi; wrf[(size_t)((ks * 3 + blk) * 2 + 1) * 64 + l] = lo; }
    }
    LAS float* scr = (LAS float*)(lds + wave * 16640);
    const int gw = vcu * 8 + wave, NGW = G * 8;
    constexpr int I_IN = 32 * 24, I_OUT = 32 * 32, I_G = 32 * 256, I_D = 32 * 256;
    constexpr int NITEMS = I_IN + I_OUT + 2 * I_G + I_D;
    bf16_t* Win_t = (bf16_t*)(A.ws + WS_WIN); bf16_t* Wout_t = (bf16_t*)(A.ws + WS_WOUT); bf16_t* Wgu_t = (bf16_t*)(A.ws + WS_WGU); bf16_t* Wd_t = (bf16_t*)(A.ws + WS_WD);
    for (int it = gw; it < NITEMS; it += NGW) {
        int r = it;
        if (r < I_IN) { const int kb = r / 24, nb = r % 24; transpose_item(A.w_in, INW, kb * 64, nb * 64, A.g1, scr, lane, RowWin{Win_t, nb * 64}); continue; } r -= I_IN;
        if (r < I_OUT) { const int kb = r / 32, nb = r % 32; transpose_item(A.w_out, DM, kb * 64, nb * 64, nullptr, scr, lane, RowNat{Wout_t, nb * 64, DM}); continue; } r -= I_OUT;
        if (r < 2 * I_G) { const int half = r / I_G; r -= half * I_G; const int e = r / 256, q = r % 256, kb = q / 8, nb = q % 8;
            transpose_item((half ? A.w_up : A.w_gate) + (size_t)e * DM * DEXP, DEXP, kb * 64, nb * 64, A.g2, scr, lane, RowGU{Wgu_t + (size_t)e * 1024 * DM, nb * 64, half}); continue; } r -= 2 * I_G;
        { const int e = r / 256, q = r % 256, kb = q / 32, nb = q % 32; transpose_item(A.w_down + (size_t)e * DEXP * DM, DM, kb * 64, nb * 64, nullptr, scr, lane, RowPB{Wd_t + (size_t)e * DM * DEXP, nb * 64, DEXP}); }
    }
    bf16_t* XN = (bf16_t*)(A.ws + WS_XN);
    if (G > 24) { if (vcu >= 12) for (int m = gw - 96; m < NTOK; m += NGW - 96) rms_row_to_bf16(A.x + (size_t)m * DM, XN + (size_t)m * DM, lane); }
    else for (int m = gw; m < NTOK; m += NGW) rms_row_to_bf16(A.x + (size_t)m * DM, XN + (size_t)m * DM, lane);
}

namespace att { constexpr float CQ_ = 0.088388347648318440f * 1.4426950408889634f; }
using pg8::UnitMN;
template <int AM> struct ProbIn {
    typedef UnitMN Unit;
    const bf16_t* A; const bf16_t* Bt; pg8::StaticOrder S;
    bf16_t *Q, *Kb, *Vb, *Z; unsigned char *Q8, *K8, *V8; const float *qg, *kg, *cosT, *sinT;
    __device__ __forceinline__ bool next(int i, Unit& u) const { return S.next(i, u); }
    __device__ __forceinline__ const char* a_base(const Unit& u) const { return (const char*)A + (size_t)u.pm * 256 * DM * 2; }
    __device__ __forceinline__ void a_offs(const Unit&, const int (&R)[2], const int (&C)[2], unsigned (&vo)[2][2]) const {
#pragma unroll
        for (int h = 0; h < 2; ++h)
#pragma unroll
            for (int i = 0; i < 2; ++i) vo[h][i] = (unsigned)((h * 128 + R[i]) * DM + C[i]) * 2u; }
    __device__ __forceinline__ const char* b_base(const Unit& u) const { return (const char*)Bt + (size_t)u.pn * 256 * DM * 2; }
    __device__ __forceinline__ void epi(f32x4 (&acc)[2][2][4][2], const Unit& u, int wr, int wc, int fr, int fq, LAS unsigned char* les, int lane) const {
        const int pn = u.pn; const int rbase = u.pm * 256 + wr * 64 + fr;
        if (pn <= 4) {
            LAS float* Pst = (LAS float*)les;
#pragma unroll
            for (int ai = 0; ai < 2; ++ai)
#pragma unroll
                for (int m = 0; m < 4; ++m)
#pragma unroll
                    for (int bj = 0; bj < 2; ++bj) { const f32x4 a = acc[ai][bj][m][0], b = acc[ai][bj][m][1];
                        float ss = ((a.x * a.x + a.y * a.y) + (a.z * a.z + a.w * a.w)) + ((b.x * b.x + b.y * b.y) + (b.z * b.z + b.w * b.w));
                        ss += __shfl_xor(ss, 16); ss += __shfl_xor(ss, 32);
                        if (fq == 0) Pst[((ai * 128 + wr * 64 + m * 16 + fr) * 2 + bj) * 4 + wc] = ss; }
            asm volatile("s_waitcnt lgkmcnt(0)" ::: "memory"); __builtin_amdgcn_s_barrier(); asm volatile("" ::: "memory");
            const float* gp = (pn < 4) ? qg : kg;
            const int dA = 64 * (wc >> 1) + 16 * (wc & 1) + 4 * fq, i0 = 16 * (wc & 1) + 4 * fq;
            const f32x4 g0 = *(const f32x4*)(gp + dA), g1v = *(const f32x4*)(gp + dA + 32);
#pragma unroll
            for (int ai = 0; ai < 2; ++ai)
#pragma unroll
                for (int m = 0; m < 4; ++m) { const int row = rbase + ai * 128 + m * 16; const int b = row >> 14, s = row & (SEQ - 1);
                    const int pos = (wc >> 1) ? (s & 63) : (s >> 6);
                    const f32x4 c4 = *(const f32x4*)(cosT + pos * 32 + i0), s4 = *(const f32x4*)(sinT + pos * 32 + i0);
#pragma unroll
                    for (int bj = 0; bj < 2; ++bj) { const f32x4 pp = *(const LAS f32x4*)(Pst + ((ai * 128 + wr * 64 + m * 16 + fr) * 2 + bj) * 4);
                        const float rstd = 1.0f / sqrtf(((pp.x + pp.y) + (pp.z + pp.w)) * (1.f / HD) + EPS);
                        const f32x4 x1 = acc[ai][bj][m][0] * rstd * g0, x2 = acc[ai][bj][m][1] * rstd * g1v;
                        f32x4 y1 = x1 * c4 - x2 * s4, y2 = x2 * c4 + x1 * s4;
                        if (pn < 4) { y1 = y1 * att::CQ_; y2 = y2 * att::CQ_; }
                        if (AM != 1) {
                        bf16_t* dst = (pn < 4) ? Q + (size_t)row * ATTW + (2 * pn + bj) * HD + 32 * wc + 8 * fq
                                               : Kb + ((size_t)(b * 2 + bj) * KVROWS + 64 + s) * HD + 32 * wc + 8 * fq;
                        *(u32x4*)dst = pack8(y1, y2); }
                        if (AM != 0) { const float qs = (pn < 4) ? 8.0f : 1.0f; y1 = y1 * qs; y2 = y2 * qs;
                        unsigned char* d8 = (pn < 4) ? Q8 + (size_t)row * ATTW + (2 * pn + bj) * HD + 32 * wc + 8 * fq
                                                     : K8 + ((size_t)(b * 2 + bj) * KVROWS + 64 + s) * HD + 32 * wc + 8 * fq;
                        u32x2 w8; w8.x = pk4_fp8(y1[0], y1[1], y1[2], y1[3]); w8.y = pk4_fp8(y2[0], y2[1], y2[2], y2[3]); *(u32x2*)d8 = w8; } } }
        } else {
            if (AM != 0 && pn == 5) {
                LAS unsigned char* T = les + (wr * 4 + wc) * 2048;
#pragma unroll
                for (int ai = 0; ai < 2; ++ai)
#pragma unroll
                    for (int bj = 0; bj < 2; ++bj) {
#pragma unroll
                        for (int m = 0; m < 4; ++m) { const int pp = vpos(16 * m + fr);
#pragma unroll
                            for (int n = 0; n < 2; ++n) { const f32x4 v = acc[ai][bj][m][n]; const unsigned w = pk4_fp8(v[0], v[1], v[2], v[3]); const int dl = 8 * fq + 4 * n;
                                T[(dl + 0) * 64 + pp] = (unsigned char)w; T[(dl + 1) * 64 + pp] = (unsigned char)(w >> 8); T[(dl + 2) * 64 + pp] = (unsigned char)(w >> 16); T[(dl + 3) * 64 + pp] = (unsigned char)(w >> 24); } }
                        asm volatile("s_waitcnt lgkmcnt(0)" ::: "memory");
                        const int row0 = u.pm * 256 + ai * 128 + wr * 64; const int b0 = row0 >> 14, tile = 1 + ((row0 & (SEQ - 1)) >> 6);
                        unsigned char* dst = V8 + (((size_t)(b0 * 2 + bj) * NT_ATT + tile) * 128 + 32 * wc) * 64;
                        const u32x4 c0 = *(const LAS u32x4*)(T + lane * 16), c1 = *(const LAS u32x4*)(T + 1024 + lane * 16);
                        *(u32x4*)(dst + lane * 16) = c0; *(u32x4*)(dst + 1024 + lane * 16) = c1;
                        asm volatile("s_waitcnt lgkmcnt(0)" ::: "memory"); }
            }
            if (AM == 1 && pn == 5) return;
#pragma unroll
            for (int ai = 0; ai < 2; ++ai)
#pragma unroll
                for (int m = 0; m < 4; ++m) { const int row = rbase + ai * 128 + m * 16; const int b = row >> 14, s = row & (SEQ - 1);
#pragma unroll
                    for (int bj = 0; bj < 2; ++bj) {
                        bf16_t* dst = (pn == 5) ? Vb + ((size_t)(b * 2 + bj) * KVROWS + 64 + s) * HD + 32 * wc + 8 * fq
                                                : Z + (size_t)row * POOLW + (pn - 6) * 256 + bj * 128 + 32 * wc + 8 * fq;
                        *(u32x4*)dst = pack8(acc[ai][bj][m][0], acc[ai][bj][m][1]); } }
        }
    }
};
struct ProbOut {
    typedef UnitMN Unit;
    const bf16_t* A; const bf16_t* Bt; pg8::StaticOrder S; const float* x; float* out; float* ssp;
    __device__ __forceinline__ bool next(int i, Unit& u) const { return S.next(i, u); }
    __device__ __forceinline__ const char* a_base(const Unit& u) const { return (const char*)A + (size_t)u.pm * 256 * DM * 2; }
    __device__ __forceinline__ void a_offs(const Unit&, const int (&R)[2], const int (&C)[2], unsigned (&vo)[2][2]) const {
#pragma unroll
        for (int h = 0; h < 2; ++h)
#pragma unroll
            for (int i = 0; i < 2; ++i) vo[h][i] = (unsigned)((h * 128 + R[i]) * DM + C[i]) * 2u; }
    __device__ __forceinline__ const char* b_base(const Unit& u) const { return (const char*)Bt + (size_t)u.pn * 256 * DM * 2; }
    __device__ __forceinline__ void epi(f32x4 (&acc)[2][2][4][2], const Unit& u, int wr, int wc, int fr, int fq, LAS unsigned char*, int) const {
        const int col0 = u.pn * 256 + wc * 32 + 4 * fq; const int row0 = u.pm * 256 + wr * 64 + fr;
        f32x4 xb[4][4];
#define XLOAD(c) do { const size_t off_ = (size_t)(row0 + ((c) >> 2) * 128 + ((c) & 3) * 16) * DM + col0; \
            _Pragma("unroll") for (int q = 0; q < 4; ++q) xb[(c) & 3][q] = *(const f32x4*)(x + off_ + (q >> 1) * 128 + (q & 1) * 16); } while (0)
        XLOAD(0); XLOAD(1); XLOAD(2);
#pragma unroll
        for (int c = 0; c < 8; ++c) { const int ai = c >> 2, m = c & 3; const int row = row0 + ai * 128 + m * 16; const size_t off = (size_t)row * DM + col0; float ss = 0.f;
            if (c + 3 < 8) XLOAD(c + 3);
            asm volatile("" ::: "memory");
#pragma unroll
            for (int q = 0; q < 4; ++q) { const f32x4 v = xb[c & 3][q] + acc[ai][q >> 1][m][q & 1]; *(f32x4*)(out + off + (q >> 1) * 128 + (q & 1) * 16) = v;
                ss += (v.x * v.x + v.y * v.y) + (v.z * v.z + v.w * v.w); }
            ss += __shfl_xor(ss, 16); ss += __shfl_xor(ss, 32);
            if (fq == 0) ssp[(size_t)row * 32 + u.pn * 4 + wc] = ss;
            asm volatile("" ::: "memory"); }
#undef XLOAD
    }
};
struct MoeTab { LAS int* cnt; LAS int* tb; LAS int* tbk; };
__device__ __forceinline__ MoeTab moe_tab(LAS unsigned char* lds) { MoeTab t; t.cnt = (LAS int*)(lds + TAB_OFF); t.tb = t.cnt + 64; t.tbk = t.tb + 72; return t; }
__device__ __forceinline__ void moe_tables(LAS unsigned char* lds, const unsigned* gcnt, int tid) {
    MoeTab T = moe_tab(lds);
    if (tid < 64) T.cnt[tid] = (int)__hip_atomic_load(gcnt + tid, RLX_AGENT);
    __syncthreads();
    if (tid == 0) { int s = 0; for (int li = 0; li < 64; ++li) { T.tb[li] = s; s += (T.cnt[li] + 255) >> 8; } T.tb[64] = s;
        for (int k = 0; k < 2; ++k) { int q = 0; for (int e = 0; e < 32; ++e) { T.tbk[k * 33 + e] = q; q += (T.cnt[2 * e + k] + 255) >> 8; } T.tbk[k * 33 + 32] = q; } }
    __syncthreads();
}
struct UnitMoe { int T, j, li, tl; };
struct ProbGU {
    typedef UnitMoe Unit;
    const bf16_t* A; const bf16_t* Bt; bf16_t* H; const int* list; MoeTab T; int vcu, G;
    __device__ __forceinline__ bool next(int i, Unit& u) const {
        const int un = i * G + vcu; const int ntile = T.tb[64]; if (un >= ntile * 4) return false;
        const int Tt = un >> 2; int li = 0;
        for (int q = 1; q < 64; ++q) li += (T.tb[q] <= Tt) ? 1 : 0;
        li = __builtin_amdgcn_readfirstlane(li);
        u.T = Tt; u.j = un & 3; u.li = li; u.tl = Tt - __builtin_amdgcn_readfirstlane(T.tb[li]); return true; }
    __device__ __forceinline__ const char* a_base(const Unit&) const { return (const char*)A; }
    __device__ __forceinline__ void a_offs(const Unit& u, const int (&R)[2], const int (&C)[2], unsigned (&vo)[2][2]) const {
        const int cnt = T.cnt[u.li];
#pragma unroll
        for (int h = 0; h < 2; ++h)
#pragma unroll
            for (int i = 0; i < 2; ++i) { const int slot = u.tl * 256 + h * 128 + R[i]; int tok = 0; if (slot < cnt) tok = list[(size_t)u.li * LCAP + slot]; vo[h][i] = (unsigned)(tok * DM + C[i]) * 2u; } }
    __device__ __forceinline__ const char* b_base(const Unit& u) const { return (const char*)Bt + (size_t)((u.li >> 1) * 4 + u.j) * 256 * DM * 2; }
    __device__ __forceinline__ void epi(f32x4 (&acc)[2][2][4][2], const Unit& u, int wr, int wc, int fr, int fq, LAS unsigned char*, int) const {
#pragma unroll
        for (int ai = 0; ai < 2; ++ai)
#pragma unroll
            for (int m = 0; m < 4; ++m) { const int hrow = u.T * 256 + ai * 128 + wr * 64 + m * 16 + fr; f32x4 hv[2];
#pragma unroll
                for (int n = 0; n < 2; ++n) { const f32x4 g = acc[ai][0][m][n], up = acc[ai][1][m][n];
#pragma unroll
                    for (int e = 0; e < 4; ++e) hv[n][e] = g[e] * __builtin_amdgcn_rcpf(1.0f + __builtin_amdgcn_exp2f(-1.4426950408889634f * g[e])) * up[e]; }
                *(u32x4*)(H + (size_t)hrow * DEXP + u.j * 128 + 32 * wc + 8 * fq) = pack8(hv[0], hv[1]); }
    }
};
template <int KK> struct ProbDown {
    typedef UnitMoe Unit;
    const bf16_t* A; const bf16_t* Bt; float* out; bf16_t* tmp; const int* list; const float* glist; MoeTab T; int vcu, G;
    __device__ __forceinline__ bool next(int i, Unit& u) const {
        const int un = i * G + vcu; const int ntile = T.tbk[KK * 33 + 32]; if (un >= ntile * 8) return false;
        const int Tk = un >> 3; int e = 0;
        for (int q = 1; q < 32; ++q) e += (T.tbk[KK * 33 + q] <= Tk) ? 1 : 0;
        e = __builtin_amdgcn_readfirstlane(e);
        u.li = 2 * e + KK; u.tl = Tk - __builtin_amdgcn_readfirstlane(T.tbk[KK * 33 + e]); u.T = __builtin_amdgcn_readfirstlane(T.tb[u.li]) + u.tl; u.j = un & 7; return true; }
    __device__ __forceinline__ const char* a_base(const Unit& u) const { return (const char*)A + (size_t)u.T * 256 * DEXP * 2; }
    __device__ __forceinline__ void a_offs(const Unit&, const int (&R)[2], const int (&C)[2], unsigned (&vo)[2][2]) const {
#pragma unroll
        for (int h = 0; h < 2; ++h)
#pragma unroll
            for (int i = 0; i < 2; ++i) vo[h][i] = (unsigned)((h * 128 + R[i]) * DEXP + C[i]) * 2u; }
    __device__ __forceinline__ const char* b_base(const Unit& u) const { return (const char*)Bt + ((size_t)(u.li >> 1) * DM + u.j * 256) * DEXP * 2; }
    __device__ __forceinline__ void epi(f32x4 (&acc)[2][2][4][2], const Unit& u, int wr, int wc, int fr, int fq, LAS unsigned char*, int) const {
        const int cnt = T.cnt[u.li]; const int col0 = u.j * 256 + wc * 32 + 8 * fq;
        int tok[2][4]; float gt[2][4];
#pragma unroll
        for (int ai = 0; ai < 2; ++ai)
#pragma unroll
            for (int m = 0; m < 4; ++m) { const int slot = u.tl * 256 + ai * 128 + wr * 64 + m * 16 + fr; const bool ok = slot < cnt; const int sl = ok ? slot : 0;
                tok[ai][m] = list[(size_t)u.li * LCAP + sl]; gt[ai][m] = glist[(size_t)u.li * LCAP + sl]; if (!ok) tok[ai][m] = -1; }
        if (KK == 0) {
#pragma unroll
            for (int ai = 0; ai < 2; ++ai)
#pragma unroll
                for (int m = 0; m < 4; ++m) {
                    if (tok[ai][m] >= 0) { const size_t ro = (size_t)tok[ai][m] * DM + col0; const float g = gt[ai][m];
#pragma unroll
                        for (int bj = 0; bj < 2; ++bj) *(u32x4*)(tmp + ro + bj * 128) = pack8(acc[ai][bj][m][0] * g, acc[ai][bj][m][1] * g); }
                    if (m & 1) asm volatile("" ::: "memory"); }
        } else {
            u32x4 tb[3][2]; f32x4 ob[3][4];
#define DLOAD(c) do { const int tk_ = tok[(c) >> 2][(c) & 3]; const size_t ro_ = (size_t)(tk_ < 0 ? 0 : tk_) * DM + col0; \
                _Pragma("unroll") for (int bj = 0; bj < 2; ++bj) { tb[(c) % 3][bj] = *(const u32x4*)(tmp + ro_ + bj * 128); ob[(c) % 3][2 * bj] = *(const f32x4*)(out + ro_ + bj * 128); ob[(c) % 3][2 * bj + 1] = *(const f32x4*)(out + ro_ + bj * 128 + 4); } } while (0)
            DLOAD(0); DLOAD(1);
#pragma unroll
            for (int c = 0; c < 8; ++c) { const int ai = c >> 2, m = c & 3;
                if (c + 2 < 8) DLOAD(c + 2);
                asm volatile("" ::: "memory");
                if (tok[ai][m] >= 0) { const size_t ro = (size_t)tok[ai][m] * DM + col0; const float g = gt[ai][m];
#pragma unroll
                    for (int bj = 0; bj < 2; ++bj) { const u32x4 t = tb[c % 3][bj];
                        const f32x4 v0 = ob[c % 3][2 * bj] + (f32x4){bf_lo(t.x), bf_hi(t.x), bf_lo(t.y), bf_hi(t.y)} + acc[ai][bj][m][0] * g, v1 = ob[c % 3][2 * bj + 1] + (f32x4){bf_lo(t.z), bf_hi(t.z), bf_lo(t.w), bf_hi(t.w)} + acc[ai][bj][m][1] * g;
                        *(f32x4*)(out + ro + bj * 128) = v0; *(f32x4*)(out + ro + bj * 128 + 4) = v1; } }
                asm volatile("" ::: "memory"); }
#undef DLOAD
        }
    }
};

namespace att {
constexpr int D = 128, NW = 8, QBLK = 32, KVBLK = 64;
constexpr float CQ = 0.088388347648318440f * 1.4426950408889634f;
constexpr float THRL = 8.f;
constexpr int LDQ = ATTW, LDO = DM;
constexpr int KSLOT = 16384, NKS = 3, NVS = 4, LDS_K = 0, LDS_V = NKS * KSLOT, LDS_WS = LDS_V + NVS * KSLOT;
#define SBAR() __builtin_amdgcn_sched_barrier(0)
__device__ __forceinline__ int crow(int r, int hi) { return (r & 3) + 8 * (r >> 2) + 4 * hi; }
__device__ __forceinline__ unsigned cvtpk(float lo, float hi) { unsigned r; asm volatile("v_cvt_pk_bf16_f32 %0, %1, %2" : "=v"(r) : "v"(lo), "v"(hi)); return r; }
__device__ __forceinline__ int v_rd_base(int lane) { return ((lane & 3) << 3) | (((lane >> 2) & 3) << 6) | (((lane >> 4) & 1) << 5) | (((lane >> 5) & 1) << 8); }
constexpr int v_rd_off(int d0, int ks, int half) { return d0 * 512 + ks * 4096 + half * 2048; }
template <int OFF> __device__ __forceinline__ s16x4 tr_read(int vb) {
  s16x4 r; asm volatile("ds_read_b64_tr_b16 %0, %1 offset:%2" : "=&v"(r) : "v"(vb), "i"(OFF) : "memory"); return r;
}
struct VG { s16x4 l0, h0, l1, h1; };
template <int G> __device__ __forceinline__ void v_read(VG& v, int vb) {
  constexpr int d0 = G >> 1, ks = 2 * (G & 1);
  v.l0 = tr_read<v_rd_off(d0, ks, 0)>(vb); v.h0 = tr_read<v_rd_off(d0, ks, 1)>(vb); v.l1 = tr_read<v_rd_off(d0, ks + 1, 0)>(vb); v.h1 = tr_read<v_rd_off(d0, ks + 1, 1)>(vb);
}
#define V_WAIT(N, v) asm volatile("s_waitcnt lgkmcnt(" #N ")" : "+v"(v.l0), "+v"(v.h0), "+v"(v.l1), "+v"(v.h1))
#define PKV(L, H) (bf16x8){L[0], L[1], L[2], L[3], H[0], H[1], H[2], H[3]}
#define V_MMA(od, v, pe, po) do { od = __builtin_amdgcn_mfma_f32_32x32x16_bf16(pe, PKV(v.l0, v.h0), od, 0, 0, 0); od = __builtin_amdgcn_mfma_f32_32x32x16_bf16(po, PKV(v.l1, v.h1), od, 0, 0, 0); } while (0)
__device__ __forceinline__ void pv_d0(f32x16* o, int vb, bf16x8 pa0, bf16x8 pa1, bf16x8 pa2, bf16x8 pa3) {
  VG a, b, c;
  v_read<0>(a, vb); v_read<1>(b, vb); v_read<2>(c, vb);
  V_WAIT(8, a); V_MMA(o[0], a, pa0, pa1); v_read<3>(a, vb);
  V_WAIT(8, b); V_MMA(o[0], b, pa2, pa3); v_read<4>(b, vb);
  V_WAIT(8, c); V_MMA(o[1], c, pa0, pa1); v_read<5>(c, vb);
  V_WAIT(8, a); V_MMA(o[1], a, pa2, pa3); v_read<6>(a, vb);
  V_WAIT(8, b); V_MMA(o[2], b, pa0, pa1); v_read<7>(b, vb);
  V_WAIT(8, c); V_MMA(o[2], c, pa2, pa3);
  V_WAIT(4, a); V_MMA(o[3], a, pa0, pa1);
  V_WAIT(0, b); V_MMA(o[3], b, pa2, pa3);
}
#undef V_MMA
#undef PKV
struct KG { bf16x8 b0, b1; };
template <int D0> __device__ __forceinline__ void k_read(KG& k, const int (&kb)[4]) {
  asm volatile("ds_read_b128 %0, %1 offset:%2" : "=&v"(k.b0) : "v"(kb[D0 & 3]), "i"((D0 >> 2) * 128) : "memory");
  asm volatile("ds_read_b128 %0, %1 offset:%2" : "=&v"(k.b1) : "v"(kb[D0 & 3]), "i"((D0 >> 2) * 128 + 8192) : "memory");
}
#define K_WAIT(N, k) asm volatile("s_waitcnt lgkmcnt(" #N ")" : "+v"(k.b0), "+v"(k.b1))
__device__ __forceinline__ void qkt(f32x16& p0, f32x16& p1, const int (&kb)[4], const bf16x8* qr, const f32x16& negm) {
  KG a, b;
  k_read<0>(a, kb); k_read<1>(b, kb);
  K_WAIT(2, a); p0 = __builtin_amdgcn_mfma_f32_32x32x16_bf16(a.b0, qr[0], negm, 0, 0, 0); p1 = __builtin_amdgcn_mfma_f32_32x32x16_bf16(a.b1, qr[0], negm, 0, 0, 0); k_read<2>(a, kb);
#define K_MMA(k, d) do { p0 = __builtin_amdgcn_mfma_f32_32x32x16_bf16(k.b0, qr[d], p0, 0, 0, 0); p1 = __builtin_amdgcn_mfma_f32_32x32x16_bf16(k.b1, qr[d], p1, 0, 0, 0); } while (0)
  K_WAIT(2, b); K_MMA(b, 1); k_read<3>(b, kb);
  K_WAIT(2, a); K_MMA(a, 2); k_read<4>(a, kb);
  K_WAIT(2, b); K_MMA(b, 3); k_read<5>(b, kb);
  K_WAIT(2, a); K_MMA(a, 4); k_read<6>(a, kb);
  K_WAIT(2, b); K_MMA(b, 5); k_read<7>(b, kb);
  K_WAIT(2, a); K_MMA(a, 6);
  K_WAIT(0, b); K_MMA(b, 7);
#undef K_MMA
}
__device__ __forceinline__ void finishSM(f32x16& p0, f32x16& p1, float& l_reg, bf16x8& pa0, bf16x8& pa1, bf16x8& pa2, bf16x8& pa3) {
#pragma unroll
  for (int r = 0; r < 16; ++r) p1[r] = __builtin_amdgcn_exp2f(p1[r]);
  float ps = 0;
#pragma unroll
  for (int r = 0; r < 16; ++r) ps += p0[r];
#pragma unroll
  for (int r = 0; r < 16; ++r) ps += p1[r];
  l_reg += ps;
#define PK4(P, BASE, OUT) do { unsigned a0 = cvtpk(P[BASE + 0], P[BASE + 1]), a1 = cvtpk(P[BASE + 2], P[BASE + 3]);   \
    unsigned b0 = cvtpk(P[BASE + 4], P[BASE + 5]), b1 = cvtpk(P[BASE + 6], P[BASE + 7]);                              \
    auto r0 = __builtin_amdgcn_permlane32_swap(a0, b0, false, false); auto r1 = __builtin_amdgcn_permlane32_swap(a1, b1, false, false); \
    u32x4 w = {r0[0], r1[0], r0[1], r1[1]}; OUT = *reinterpret_cast<bf16x8*>(&w); } while (0)
  PK4(p0, 0, pa0); PK4(p0, 8, pa1); PK4(p1, 0, pa2); PK4(p1, 8, pa3);
#undef PK4
}
template <bool FIRST>
__device__ __forceinline__ void startSM(f32x16& p0, f32x16& p1, float& mhat, float& l_reg, f32x16& negm, bool& resc, float& f) {
  float a = __builtin_fmaxf(__builtin_fmaxf(p0[0], p0[1]), p1[0]), b = __builtin_fmaxf(__builtin_fmaxf(p0[2], p0[3]), p1[1]); a = __builtin_fmaxf(__builtin_fmaxf(a, p1[2]), p1[3]);
#pragma unroll
  for (int r = 4; r < 16; r += 4) { a = __builtin_fmaxf(__builtin_fmaxf(a, p0[r]), p0[r + 1]); b = __builtin_fmaxf(__builtin_fmaxf(b, p0[r + 2]), p0[r + 3]);
    a = __builtin_fmaxf(__builtin_fmaxf(a, p1[r]), p1[r + 1]); b = __builtin_fmaxf(__builtin_fmaxf(b, p1[r + 2]), p1[r + 3]); }
  float rm = __builtin_fmaxf(a, b);
  { auto rr = __builtin_amdgcn_permlane32_swap(__float_as_uint(rm), __float_as_uint(rm), false, false); rm = __builtin_fmaxf(__uint_as_float(rr[0]), __uint_as_float(rr[1])); }
  resc = false; f = 1.f;
  if (FIRST || __builtin_expect(__any(rm > THRL), 0)) {
    const float dl = FIRST ? rm : __builtin_fmaxf(rm, 0.f); mhat += dl;
#pragma unroll
    for (int r = 0; r < 16; ++r) { p0[r] -= dl; p1[r] -= dl; }
#pragma unroll
    for (int r = 0; r < 16; ++r) negm[r] = -mhat;
    asm volatile("" : "+v"(negm));
    if (!FIRST) { f = __builtin_amdgcn_exp2f(-dl); l_reg *= f; resc = true; }
  }
#pragma unroll
  for (int r = 0; r < 16; ++r) p0[r] = __builtin_amdgcn_exp2f(p0[r]);
}
#define ATT_WAIT(N) asm volatile("s_waitcnt vmcnt(" #N ")" ::: "memory")
__device__ __forceinline__ void attn_unit(const bf16_t* __restrict__ Qb, const bf16_t* __restrict__ Kh, const bf16_t* __restrict__ Vh, bf16_t* __restrict__ Ob, LAS char* lds, int tid) {
  constexpr int NT = NT_ATT; static_assert(NT % 2 == 1 && NT >= 7, "odd tile count");
  const int wid = __builtin_amdgcn_readfirstlane(tid >> 6), lane = tid & 63, r32 = lane & 31, hi = lane >> 5;
  LAS float* ws = (LAS float*)(lds + LDS_WS) + wid * 64; LAS float* li_l = ws; LAS float* al_l = ws + 32;
  float mhat = 0.f, l_reg = 0.f; f32x16 o[4] = {}; f32x16 negm = {}; bf16x8 qr[8];
  asm volatile("" : "+v"(negm));
  unsigned koff[2], voff[2];
#pragma unroll
  for (int i = 0; i < 2; ++i) { const int p = 2 * wid + i;
    { const int row = 4 * p + (lane >> 4), cpos = lane & 15; koff[i] = (unsigned)(row * 256 + ((cpos ^ (row & 7)) << 4)); }
    { const int st = 2 * p + (lane >> 5), kk = (st >> 2) * 8 + ((lane & 31) >> 2), c = (st & 3) * 32 + (lane & 3) * 8; const int k = (kk & ~0xC) | ((kk & 4) << 1) | ((kk & 8) >> 1); voff[i] = (unsigned)(k * 256 + c * 2); } }
#define DMA_T(t, kso, vso) do { const char* kt_ = (const char*)Kh + (size_t)(t) * KSLOT; const char* vt_ = (const char*)Vh + (size_t)(t) * KSLOT; \
    _Pragma("unroll") for (int i_ = 0; i_ < 2; ++i_) { \
      __builtin_amdgcn_global_load_lds((const unsigned*)(kt_ + koff[i_]), (LAS unsigned*)(lds + LDS_K + (kso) + (2 * wid + i_) * 1024), 16, 0, 0); \
      __builtin_amdgcn_global_load_lds((const unsigned*)(vt_ + voff[i_]), (LAS unsigned*)(lds + LDS_V + (vso) + (2 * wid + i_) * 1024), 16, 0, 0); } } while (0)
  { const unsigned qoff = (unsigned)((wid * QBLK + r32) * LDQ + hi * 8) * 2u;
#pragma unroll
    for (int d0 = 0; d0 < 8; ++d0) qr[d0] = *reinterpret_cast<const bf16x8*>((const char*)Qb + qoff + d0 * 32); }
  DMA_T(0, 0, 0); DMA_T(1, KSLOT, KSLOT);
  int kb[4];
#pragma unroll
  for (int i = 0; i < 4; ++i) kb[i] = (int)(unsigned)(uintptr_t)(lds + LDS_K) + r32 * 256 + ((i * 32 + hi * 16) ^ ((r32 & 7) << 4));
  const int vb0 = (int)(unsigned)(uintptr_t)(lds + LDS_V) + v_rd_base(lane);
#define RESC() do { if (resc) { if (hi == 0) al_l[r32] = fsc; asm volatile("s_waitcnt lgkmcnt(0)" ::: "memory"); \
    _Pragma("unroll") for (int d = 0; d < 4; ++d) _Pragma("unroll") for (int r = 0; r < 16; ++r) o[d][r] *= al_l[crow(r, hi)]; } } while (0)
  f32x16 pA0, pA1, pB0, pB1; bf16x8 pa0, pa1, pa2, pa3; bool resc; float fsc;
  int kcur = 0, kiss = 2 * KSLOT, vprev = 0, viss = 2 * KSLOT;
#define KB_SET() do { } while (0)
#define ROT() do { { const int dk_ = (kcur == 2 * KSLOT) ? -2 * KSLOT : KSLOT; _Pragma("unroll") for (int i_ = 0; i_ < 4; ++i_) kb[i_] += dk_; } kcur = (kcur == 2 * KSLOT) ? 0 : kcur + KSLOT; kiss = (kiss == 2 * KSLOT) ? 0 : kiss + KSLOT; viss = (viss == 3 * KSLOT) ? 0 : viss + KSLOT; } while (0)
  ATT_WAIT(4); __builtin_amdgcn_s_barrier(); asm volatile("" ::: "memory");
  DMA_T(2, kiss, viss);
  KB_SET(); qkt(pA0, pA1, kb, qr, negm);
#pragma unroll
  for (int r = 8; r < 16; ++r) pA0[r] = -1e30f;
#pragma unroll
  for (int r = 0; r < 16; ++r) pA1[r] = -1e30f;
  startSM<true>(pA0, pA1, mhat, l_reg, negm, resc, fsc);
  ROT();
#define STEP(X0, X1, Y0, Y1, tt, ISSUE, WN) do { \
    ATT_WAIT(WN); __builtin_amdgcn_s_barrier(); asm volatile("" ::: "memory"); \
    if (ISSUE) DMA_T((tt) + 2, kiss, viss); \
    KB_SET(); qkt(X0, X1, kb, qr, negm); \
    finishSM(Y0, Y1, l_reg, pa0, pa1, pa2, pa3); \
    pv_d0(o, vb0 + vprev, pa0, pa1, pa2, pa3); startSM<false>(X0, X1, mhat, l_reg, negm, resc, fsc); \
    RESC(); vprev = (vprev == 3 * KSLOT) ? 0 : vprev + KSLOT; ROT(); } while (0)
  for (int t = 1; t + 3 < NT; t += 2) {
    STEP(pB0, pB1, pA0, pA1, t, true, 4);
    STEP(pA0, pA1, pB0, pB1, t + 1, true, 4);
  }
  STEP(pB0, pB1, pA0, pA1, NT - 2, false, 4);
  STEP(pA0, pA1, pB0, pB1, NT - 1, false, 0);
  finishSM(pA0, pA1, l_reg, pa0, pa1, pa2, pa3);
  pv_d0(o, vb0 + vprev, pa0, pa1, pa2, pa3);
  { auto rr = __builtin_amdgcn_permlane32_swap(__float_as_uint(l_reg), __float_as_uint(l_reg), false, false); l_reg = __uint_as_float(rr[0]) + __uint_as_float(rr[1]); }
  if (hi == 0) li_l[r32] = l_reg; asm volatile("s_waitcnt lgkmcnt(0)" ::: "memory");
  float rli[16];
#pragma unroll
  for (int r = 0; r < 16; ++r) rli[r] = __builtin_amdgcn_rcpf(li_l[crow(r, hi)]);
  asm volatile("s_waitcnt lgkmcnt(0)" ::: "memory"); __builtin_amdgcn_s_barrier(); asm volatile("" ::: "memory");
  LAS bf16_t* stg = (LAS bf16_t*)(lds + wid * 8192);
#pragma unroll
  for (int r = 0; r < 16; ++r) { const int orow = crow(r, hi);
#pragma unroll
    for (int d0 = 0; d0 < 4; ++d0) stg[orow * 128 + d0 * 32 + r32] = (bf16_t)(cvtpk(o[d0][r] * rli[r], 0.f) & 0xffffu); }
  asm volatile("s_waitcnt lgkmcnt(0)" ::: "memory");
#pragma unroll
  for (int i = 0; i < 8; ++i) { const int row = i * 4 + (lane >> 4), ch = lane & 15; const u32x4 v = *(const LAS u32x4*)(stg + row * 128 + ch * 8);
    *(u32x4*)((char*)Ob + (size_t)(wid * QBLK + row) * (LDO * 2) + ch * 16) = v; }
  asm volatile("s_waitcnt lgkmcnt(0)" ::: "memory"); __builtin_amdgcn_s_barrier(); asm volatile("" ::: "memory");
#undef DMA_T
#undef RESC
#undef ROT
#undef KB_SET
#undef STEP
}
#undef ATT_WAIT
#undef SBAR
#undef V_WAIT
#undef K_WAIT
}

namespace att8 {
typedef int v8i __attribute__((ext_vector_type(8)));
constexpr int QBLK = 32, KS8 = 8192, NKS = 3, NVS = 5, L_K = 0, L_V = NKS * KS8, L_WS = 73728;
constexpr float THRL = 8.f;
__device__ __forceinline__ int crow(int r, int hi) { return (r & 3) + 8 * (r >> 2) + 4 * hi; }
struct F8 { u32x4 lo, hi; };
template <int IMM> __device__ __forceinline__ void f_read(F8& f, int a0, int a1) {
  asm volatile("ds_read_b128 %0, %1 offset:%2" : "=&v"(f.lo) : "v"(a0), "i"(IMM) : "memory");
  asm volatile("ds_read_b128 %0, %1 offset:%2" : "=&v"(f.hi) : "v"(a1), "i"(IMM) : "memory");
}
#define F_WAIT(N, f) asm volatile("s_waitcnt lgkmcnt(" #N ")" : "+v"(f.lo), "+v"(f.hi))
#define F_WAIT2(N, f, g) asm volatile("s_waitcnt lgkmcnt(" #N ")" : "+v"(f.lo), "+v"(f.hi), "+v"(g.lo), "+v"(g.hi))
__device__ __forceinline__ v8i f_vec(const F8& f) { return (v8i){(int)f.lo.x, (int)f.lo.y, (int)f.lo.z, (int)f.lo.w, (int)f.hi.x, (int)f.hi.y, (int)f.hi.z, (int)f.hi.w}; }
#define MMA8(a, b, c, sa, sb) __builtin_amdgcn_mfma_scale_f32_32x32x64_f8f6f4(a, b, c, 0, 0, 0, sa, 0, sb)
constexpr int S1 = 0x7f7f7f7f, S8 = 0x7c7c7c7c;
__device__ __forceinline__ v8i ld32(int a0, int a1, int imm) { const u32x4 lo = *(const LAS u32x4*)(uintptr_t)(unsigned)(a0 + imm), hh = *(const LAS u32x4*)(uintptr_t)(unsigned)(a1 + imm);
  return (v8i){(int)lo.x, (int)lo.y, (int)lo.z, (int)lo.w, (int)hh.x, (int)hh.y, (int)hh.z, (int)hh.w}; }
#define MFENCE() asm volatile("" ::: "memory")
__device__ __forceinline__ void qkt(f32x16& p0, f32x16& p1, int kb0, const v8i* qr, const f32x16& negm) {
  v8i a = ld32(kb0, kb0 ^ 16, 0), b = ld32(kb0, kb0 ^ 16, 4096); MFENCE();
  p0 = MMA8(a, qr[0], negm, S1, S8); p1 = MMA8(b, qr[0], negm, S1, S8);
  a = ld32(kb0 ^ 64, kb0 ^ 80, 0); b = ld32(kb0 ^ 64, kb0 ^ 80, 4096); MFENCE();
  p0 = MMA8(a, qr[1], p0, S1, S8); p1 = MMA8(b, qr[1], p1, S1, S8);
}
struct F2 { v8i a, b; };
__device__ __forceinline__ void v_read01(F2& v, int vo0) { v.a = ld32(vo0, vo0 ^ 16, 0); v.b = ld32(vo0, vo0 ^ 16, 2048); MFENCE(); }
__device__ __forceinline__ void pv(f32x16* o, f32x16& ol, const v8i& ones, F2& v, int vo0, const v8i& pa) {
  o[0] = MMA8(pa, v.a, o[0], S1, S1); o[1] = MMA8(pa, v.b, o[1], S1, S1);
  v.a = ld32(vo0, vo0 ^ 16, 4096); v.b = ld32(vo0, vo0 ^ 16, 6144); MFENCE();
  o[2] = MMA8(pa, v.a, o[2], S1, S1); o[3] = MMA8(pa, v.b, o[3], S1, S1);
  ol = MMA8(pa, ones, ol, S1, S1);
}
__device__ __forceinline__ void finishSM(f32x16& p0, f32x16& p1, float& l_reg, v8i& pa) {
#pragma unroll
  for (int r = 0; r < 16; ++r) p1[r] = __builtin_amdgcn_exp2f(p1[r]);
  float ps = 0;
#pragma unroll
  for (int r = 0; r < 16; ++r) ps += p0[r];
#pragma unroll
  for (int r = 0; r < 16; ++r) ps += p1[r];
  l_reg += ps;
#pragma unroll
  for (int i = 0; i < 4; ++i) { const unsigned a = pk4_fp8(p0[4 * i], p0[4 * i + 1], p0[4 * i + 2], p0[4 * i + 3]), b = pk4_fp8(p1[4 * i], p1[4 * i + 1], p1[4 * i + 2], p1[4 * i + 3]);
    auto rr = __builtin_amdgcn_permlane32_swap(a, b, false, false); pa[i] = (int)rr[0]; pa[4 + i] = (int)rr[1]; }
}
__device__ __forceinline__ float rowmax(const f32x16& p0, const f32x16& p1) {
  float a = __builtin_fmaxf(__builtin_fmaxf(p0[0], p0[1]), p1[0]), b = __builtin_fmaxf(__builtin_fmaxf(p0[2], p0[3]), p1[1]); a = __builtin_fmaxf(__builtin_fmaxf(a, p1[2]), p1[3]);
#pragma unroll
  for (int r = 4; r < 16; r += 4) { a = __builtin_fmaxf(__builtin_fmaxf(a, p0[r]), p0[r + 1]); b = __builtin_fmaxf(__builtin_fmaxf(b, p0[r + 2]), p0[r + 3]);
    a = __builtin_fmaxf(__builtin_fmaxf(a, p1[r]), p1[r + 1]); b = __builtin_fmaxf(__builtin_fmaxf(b, p1[r + 2]), p1[r + 3]); }
  float rm = __builtin_fmaxf(a, b);
  { auto rr = __builtin_amdgcn_permlane32_swap(__float_as_uint(rm), __float_as_uint(rm), false, false); rm = __builtin_fmaxf(__uint_as_float(rr[0]), __uint_as_float(rr[1])); }
  return rm;
}
__device__ __forceinline__ void exp_all(f32x16& p0, f32x16& p1) {
#pragma unroll
  for (int r = 0; r < 16; ++r) { p0[r] = __builtin_amdgcn_exp2f(p0[r]); p1[r] = __builtin_amdgcn_exp2f(p1[r]); }
}
__device__ __forceinline__ void pack_p(const f32x16& p0, const f32x16& p1, v8i& pa) {
#pragma unroll
  for (int i = 0; i < 4; ++i) { const unsigned a = pk4_fp8(p0[4 * i], p0[4 * i + 1], p0[4 * i + 2], p0[4 * i + 3]), b = pk4_fp8(p1[4 * i], p1[4 * i + 1], p1[4 * i + 2], p1[4 * i + 3]);
    auto rr = __builtin_amdgcn_permlane32_swap(a, b, false, false); pa[i] = (int)rr[0]; pa[4 + i] = (int)rr[1]; }
}
template <bool FIRST>
__device__ __forceinline__ void startSM(f32x16& p0, f32x16& p1, float& mhat, float& l_reg, f32x16& negm, bool& resc, float& f) {
  float a = __builtin_fmaxf(__builtin_fmaxf(p0[0], p0[1]), p1[0]), b = __builtin_fmaxf(__builtin_fmaxf(p0[2], p0[3]), p1[1]); a = __builtin_fmaxf(__builtin_fmaxf(a, p1[2]), p1[3]);
#pragma unroll
  for (int r = 4; r < 16; r += 4) { a = __builtin_fmaxf(__builtin_fmaxf(a, p0[r]), p0[r + 1]); b = __builtin_fmaxf(__builtin_fmaxf(b, p0[r + 2]), p0[r + 3]);
    a = __builtin_fmaxf(__builtin_fmaxf(a, p1[r]), p1[r + 1]); b = __builtin_fmaxf(__builtin_fmaxf(b, p1[r + 2]), p1[r + 3]); }
  float rm = __builtin_fmaxf(a, b);
  { auto rr = __builtin_amdgcn_permlane32_swap(__float_as_uint(rm), __float_as_uint(rm), false, false); rm = __builtin_fmaxf(__uint_as_float(rr[0]), __uint_as_float(rr[1])); }
  resc = false; f = 1.f;
  if (FIRST || __builtin_expect(__any(rm > THRL), 0)) {
    const float dl = FIRST ? rm : __builtin_fmaxf(rm, 0.f); mhat += dl;
#pragma unroll
    for (int r = 0; r < 16; ++r) { p0[r] -= dl; p1[r] -= dl; }
#pragma unroll
    for (int r = 0; r < 16; ++r) negm[r] = -mhat;
    asm volatile("" : "+v"(negm));
    if (!FIRST) { f = __builtin_amdgcn_exp2f(-dl); l_reg *= f; resc = true; }
  }
#pragma unroll
  for (int r = 0; r < 16; ++r) p0[r] = __builtin_amdgcn_exp2f(p0[r]);
}
#define ATT_WAIT(N) asm volatile("s_waitcnt vmcnt(" #N ")" ::: "memory")
__device__ __forceinline__ void attn_unit(const unsigned char* __restrict__ Q8b, const unsigned char* __restrict__ K8h, const unsigned char* __restrict__ V8h, bf16_t* __restrict__ Ob, int ldo, LAS char* lds, int tid) {
  constexpr int NT = NT_ATT; static_assert(NT % 2 == 1 && NT >= 7, "odd tile count");
  int lane = tid & 63; asm volatile("" : "+v"(lane));
  const int wid = __builtin_amdgcn_readfirstlane(tid >> 6), r32 = lane & 31, hi = lane >> 5;
  LAS float* ws = (LAS float*)(lds + L_WS) + wid * 64; LAS float* li_l = ws; LAS float* al_l = ws + 32;
  float zz = 0.f; asm volatile("" : "+v"(zz));
  float mhat = 0.f, l_reg = 0.f; f32x16 o[4]; f32x16 ol; f32x16 negm; v8i qr[2];
#pragma unroll
  for (int r = 0; r < 16; ++r) { negm[r] = zz; ol[r] = zz; o[0][r] = zz; o[1][r] = zz; o[2][r] = zz; o[3][r] = zz; }
  v8i ones; { int c38 = 0x38383838; asm volatile("" : "+v"(c38)); ones = (v8i){c38, c38, c38, c38, c38, c38, c38, c38}; }
  asm volatile("" : "+v"(negm));
  unsigned koff, voff;
  { const int row = 8 * wid + (lane >> 3), cpos = lane & 7; koff = (unsigned)(row * 128 + ((cpos ^ ((row >> 1) & 7)) << 4)); }
  { const int drow = 16 * wid + (lane >> 2), cpos = lane & 3; voff = (unsigned)(drow * 64 + ((cpos ^ ((drow >> 2) & 3)) << 4)); }
#define DMA_T(t, kso, vso) do { \
      __builtin_amdgcn_global_load_lds((const unsigned*)((const char*)K8h + (size_t)(t) * KS8 + koff), (LAS unsigned*)(lds + L_K + (kso) + wid * 1024), 16, 0, 0); \
      __builtin_amdgcn_global_load_lds((const unsigned*)((const char*)V8h + (size_t)(t) * KS8 + voff), (LAS unsigned*)(lds + L_V + (vso) + wid * 1024), 16, 0, 0); } while (0)
  { const unsigned qoff = (unsigned)((wid * QBLK + r32) * ATTW + hi * 32);
#pragma unroll
    for (int s = 0; s < 2; ++s) { const u32x4 lo = *reinterpret_cast<const u32x4*>((const char*)Q8b + qoff + s * 64), hh = *reinterpret_cast<const u32x4*>((const char*)Q8b + qoff + s * 64 + 16);
      qr[s] = (v8i){(int)lo.x, (int)lo.y, (int)lo.z, (int)lo.w, (int)hh.x, (int)hh.y, (int)hh.z, (int)hh.w}; } }
  DMA_T(0, 0, 0); DMA_T(1, KS8, KS8);
  int kb, vo;
  kb = (int)(unsigned)(uintptr_t)(lds + L_K) + r32 * 128 + (((2 * hi) ^ ((r32 >> 1) & 7)) << 4);
  vo = (int)(unsigned)(uintptr_t)(lds + L_V) + r32 * 64 + (((2 * hi) ^ ((r32 >> 2) & 3)) << 4);
#define RESC() do { if (resc) { if (hi == 0) al_l[r32] = fsc; asm volatile("s_waitcnt lgkmcnt(0)" ::: "memory"); \
    _Pragma("unroll") for (int r = 0; r < 16; ++r) { const float a_ = al_l[crow(r, hi)]; ol[r] *= a_; _Pragma("unroll") for (int d = 0; d < 4; ++d) o[d][r] *= a_; } } } while (0)
  f32x16 pA0, pA1, pB0, pB1; v8i pa; bool resc; float fsc; F2 vf; F8 fa0, fa1, fb0, fb1;
  { int z8 = 0; asm volatile("" : "+v"(z8)); pa = (v8i){z8, z8, z8, z8, z8, z8, z8, z8}; }
  int kcur = 0, kiss = 2 * KS8, viss = 2 * KS8, vprev = 0;
#define KROT() do { const int dk_ = (kcur == 2 * KS8) ? -2 * KS8 : KS8; kb += dk_; kcur = (kcur == 2 * KS8) ? 0 : kcur + KS8; } while (0)
#define VROT() do { const int dv_ = (vprev == 4 * KS8) ? -4 * KS8 : KS8; vo += dv_; vprev = (vprev == 4 * KS8) ? 0 : vprev + KS8; } while (0)
#define IROT() do { kiss = (kiss == 2 * KS8) ? 0 : kiss + KS8; viss = (viss == 4 * KS8) ? 0 : viss + KS8; } while (0)
#define MASK0() do { _Pragma("unroll") for (int r = 8; r < 16; ++r) pA0[r] = -1e30f; _Pragma("unroll") for (int r = 0; r < 16; ++r) pA1[r] = -1e30f; } while (0)
#define BAR_S() asm volatile("s_barrier" : "+v"(pa) :: "memory")
#define BAR_M(WN, X0, X1, Y0, Y1) asm volatile("s_waitcnt vmcnt(" #WN ")\n\ts_barrier" : "+v"(X0), "+v"(X1), "+v"(Y0), "+v"(Y1), "+v"(o[0]), "+v"(o[1]), "+v"(o[2]), "+v"(o[3]), "+v"(ol) :: "memory")
#define STEPS(X0, X1, Y0, Y1, ss, ISSUE, WN, HASQK, HASPV, HASSM, FIRST_) do { \
      BAR_S(); \
      if (ISSUE) { DMA_T((ss) + 2, kiss, viss); IROT(); } \
      if ((HASQK) && (HASPV)) {                   \
        f_read<0>(fa0, kb, kb ^ 16); f_read<4096>(fa1, kb, kb ^ 16); f_read<0>(fb0, kb ^ 64, kb ^ 80); f_read<4096>(fb1, kb ^ 64, kb ^ 80); \
        F_WAIT2(4, fa0, fa1); X0 = MMA8(f_vec(fa0), qr[0], negm, S1, S8); X1 = MMA8(f_vec(fa1), qr[0], negm, S1, S8); \
        f_read<0>(fa0, vo, vo ^ 16); f_read<2048>(fa1, vo, vo ^ 16); \
        F_WAIT2(4, fb0, fb1); X0 = MMA8(f_vec(fb0), qr[1], X0, S1, S8); X1 = MMA8(f_vec(fb1), qr[1], X1, S1, S8); \
        f_read<4096>(fb0, vo, vo ^ 16); f_read<6144>(fb1, vo, vo ^ 16); \
        F_WAIT2(4, fa0, fa1); o[0] = MMA8(pa, f_vec(fa0), o[0], S1, S1); o[1] = MMA8(pa, f_vec(fa1), o[1], S1, S1); \
        F_WAIT2(0, fb0, fb1); o[2] = MMA8(pa, f_vec(fb0), o[2], S1, S1); o[3] = MMA8(pa, f_vec(fb1), o[3], S1, S1); ol = MMA8(pa, ones, ol, S1, S1); \
        KROT(); VROT(); \
      } else { \
        if (HASQK) { qkt(X0, X1, kb, qr, negm); KROT(); } \
        if (HASPV) { v_read01(vf, vo); pv(o, ol, ones, vf, vo, pa); VROT(); } } \
      BAR_M(WN, X0, X1, Y0, Y1); \
      if (HASSM) { const float rm_ = rowmax(Y0, Y1); \
        exp_all(Y0, Y1); \
        resc = false; \
        if ((FIRST_) || __builtin_expect(__any(rm_ > THRL), 0)) { const float dl = (FIRST_) ? rm_ : __builtin_fmaxf(rm_, 0.f); mhat += dl; const float f_ = __builtin_amdgcn_exp2f(-dl); \
          _Pragma("unroll") for (int r = 0; r < 16; ++r) { X0[r] -= dl; X1[r] -= dl; Y0[r] *= f_; Y1[r] *= f_; } \
          _Pragma("unroll") for (int r = 0; r < 16; ++r) negm[r] = -mhat; \
          asm volatile("" : "+v"(negm)); \
          if (!(FIRST_)) { fsc = f_; resc = true; RESC(); } } \
        pack_p(Y0, Y1, pa); } } while (0)
  ATT_WAIT(2);
  if (wid >= 4) asm volatile("s_barrier" ::: "memory");
  STEPS(pA0, pA1, pB0, pB1, 0, true, 2, true, false, false, false); MASK0();
  STEPS(pB0, pB1, pA0, pA1, 1, true, 2, true, false, true, true);
  for (int t = 2; t + 4 < NT; t += 2) {
    STEPS(pA0, pA1, pB0, pB1, t, true, 2, true, true, true, false);
    STEPS(pB0, pB1, pA0, pA1, t + 1, true, 2, true, true, true, false);
  }
  STEPS(pA0, pA1, pB0, pB1, NT - 3, true, 2, true, true, true, false);
  STEPS(pB0, pB1, pA0, pA1, NT - 2, false, 0, true, true, true, false);
  STEPS(pA0, pA1, pB0, pB1, NT - 1, false, 0, true, true, true, false);
  { f32x16 d0 = pB0, d1 = pB1;
    STEPS(d0, d1, pA0, pA1, NT, false, 0, false, true, true, false);
    STEPS(d0, d1, pA0, pA1, NT + 1, false, 0, false, true, false, false); }
  if (wid < 4) asm volatile("s_barrier" ::: "memory");
#undef STEPS
#undef BAR_S
#undef BAR_M
  { const int le = fresh_lane(), r32e = le & 31, hie = le >> 5;
  float rli[16];
#pragma unroll
  for (int r = 0; r < 16; ++r) rli[r] = __builtin_amdgcn_rcpf(ol[r]);
  (void)li_l; (void)hie; (void)l_reg;
  asm volatile("s_waitcnt lgkmcnt(0)" ::: "memory"); __builtin_amdgcn_s_barrier(); asm volatile("" ::: "memory");
  LAS bf16_t* stg = (LAS bf16_t*)(lds + wid * 8192);
#pragma unroll
  for (int r = 0; r < 16; ++r) { const int orow = crow(r, hie);
#pragma unroll
    for (int d0 = 0; d0 < 4; ++d0) stg[orow * 128 + d0 * 32 + r32e] = (bf16_t)(cvt_pk_bf16(o[d0][r] * rli[r], 0.f) & 0xffffu); }
  asm volatile("s_waitcnt lgkmcnt(0)" ::: "memory");
#pragma unroll
  for (int i = 0; i < 8; ++i) { const int row = i * 4 + (le >> 4), ch = le & 15; const u32x4 v = *(const LAS u32x4*)(stg + row * 128 + ch * 8);
    *(u32x4*)((char*)Ob + (size_t)(wid * QBLK + row) * ((size_t)ldo * 2) + ch * 16) = v; }
  asm volatile("s_waitcnt lgkmcnt(0)" ::: "memory"); __builtin_amdgcn_s_barrier(); asm volatile("" ::: "memory"); }
#undef DMA_T
#undef RESC
#undef KROT
#undef VROT
#undef IROT
#undef MASK0
}
#undef ATT_WAIT
#undef F_WAIT
#undef F_WAIT2
#undef MFENCE
#undef MMA8
}

__device__ __forceinline__ void p1_zmeta(const Args& A, int cb, int tid) {
    const int o = tid >> 4, part = tid & 15, ch = cb * 4 + (o & 3), r = o >> 2, g = ch >> 8, d = ch & 255;
    const float* pm = (const float*)(A.ws + WS_PMETA) + (size_t)(8 + r) * POOLW + g * 256 + part * 16; const float* pw = A.pool_w + (size_t)g * 65536 + (size_t)(part * 16) * 256 + d;
    float wv[16]; f32x4 pv4[4];
#pragma unroll
    for (int u = 0; u < 16; ++u) wv[u] = pw[(size_t)u * 256];
#pragma unroll
    for (int q = 0; q < 4; ++q) pv4[q] = ((const f32x4*)pm)[q];
    float acc = 0.f;
#pragma unroll
    for (int q = 0; q < 4; ++q) acc += (pv4[q].x * wv[4 * q] + pv4[q].y * wv[4 * q + 1]) + (pv4[q].z * wv[4 * q + 2] + pv4[q].w * wv[4 * q + 3]);
    acc += __shfl_xor(acc, 1); acc += __shfl_xor(acc, 2); acc += __shfl_xor(acc, 4); acc += __shfl_xor(acc, 8);
    if (part == 0) ((float*)(A.ws + WS_ZM))[r * 1024 + ch] = acc * A.pool_scale[ch];
}
template <int HW> __device__ __forceinline__ void pool_item(const bf16_t* __restrict__ Zb, const float* __restrict__ Zm, bf16_t* __restrict__ Mb, int s) {
    u32x4 w[2 * HW];
#pragma unroll
    for (int k = 0; k < 2 * HW; ++k) { int sp = s - HW + k; sp = sp < 0 ? 0 : (sp > SEQ - 1 ? SEQ - 1 : sp); w[k] = *(const u32x4*)(Zb + (size_t)sp * POOLW); }
    float sum[8], self[8];
#pragma unroll
    for (int e = 0; e < 8; ++e) { sum[e] = 0.f; self[e] = 0.f; }
#pragma unroll
    for (int k = 0; k < 2 * HW; ++k) { const int sp = s - HW + k; float zv[8];
        zv[0] = bf_lo(w[k].x); zv[1] = bf_hi(w[k].x); zv[2] = bf_lo(w[k].y); zv[3] = bf_hi(w[k].y); zv[4] = bf_lo(w[k].z); zv[5] = bf_hi(w[k].z); zv[6] = bf_lo(w[k].w); zv[7] = bf_hi(w[k].w);
        if (sp < 0) {
#pragma unroll
            for (int e = 0; e < 8; ++e) zv[e] = Zm[(sp + 8) * 1024 + e]; }
        const float m = (sp < SEQ) ? 1.f : 0.f;
#pragma unroll
        for (int e = 0; e < 8; ++e) { sum[e] += zv[e] * m; if (k == HW) self[e] = zv[e]; } }
    const int hiE = (s + HW < SEQ) ? s + HW : SEQ; const float inv = 1.0f / (float)(hiE - (s - HW));
    u32x4 o; o.x = cvt_pk_bf16(sum[0] * inv - self[0], sum[1] * inv - self[1]); o.y = cvt_pk_bf16(sum[2] * inv - self[2], sum[3] * inv - self[3]);
    o.z = cvt_pk_bf16(sum[4] * inv - self[4], sum[5] * inv - self[5]); o.w = cvt_pk_bf16(sum[6] * inv - self[6], sum[7] * inv - self[7]);
    *(u32x4*)(Mb + (size_t)s * DM) = o;
}
__device__ __forceinline__ void p2_pool_block(const Args& A, LAS unsigned char* lds, int rb, int tid) {
    const float* Zm = (const float*)(A.ws + WS_ZM);
    const int b = rb >> 7, s0 = (rb & 127) * 128;
    const bf16_t* Z = (const bf16_t*)(A.ws + WS_Z); bf16_t* MIX = (bf16_t*)(A.ws + WS_MIX);
    { const int w = tid >> 6, l = tid & 63, sb = s0 + w * 16 + (l >> 5);
      const bf16_t* __restrict__ Zb = Z + (size_t)b * SEQ * POOLW + (l & 31) * 8; bf16_t* __restrict__ Mb = MIX + (size_t)b * SEQ * DM + ATTW + (l & 31) * 8; const float* Zmc = Zm + (l & 31) * 8;
#pragma unroll 2
      for (int it = 0; it < 8; ++it) pool_item<1>(Zb, Zmc, Mb, sb + 2 * it);
#pragma unroll 2
      for (int it = 0; it < 8; ++it) pool_item<2>(Zb + 256, Zmc + 256, Mb + 256, sb + 2 * it);
#pragma unroll 2
      for (int it = 0; it < 8; ++it) pool_item<4>(Zb + 512, Zmc + 512, Mb + 512, sb + 2 * it);
#pragma unroll 2
      for (int it = 0; it < 8; ++it) pool_item<8>(Zb + 768, Zmc + 768, Mb + 768, sb + 2 * it); }
    __syncthreads();
}

__device__ __forceinline__ void p4_block(const Args& A, LAS unsigned char* lds, int jb, int tid, int lane, int wave) {
    LAS float* Lg = (LAS float*)(lds + wave * 3072);
    LAS unsigned* cntL = (LAS unsigned*)(lds + 32768);
    LAS unsigned* baseL = cntL + 64;
    if (tid < 64) cntL[tid] = 0u;
    __syncthreads();
    const int fr = lane & 15, fq = lane >> 4, row = jb * 128 + wave * 16 + fr;
    const float* ssp = (const float*)(A.ws + WS_SSP); const float* h1 = A.out + (size_t)row * DM;
    bf16_t* BN = (bf16_t*)(A.ws + WS_XN) + (size_t)row * DM; const u32x4* wrf = (const u32x4*)(A.ws + WS_WRF);
    float ss; { const f32x4 a = *(const f32x4*)(ssp + (size_t)row * 32 + 8 * fq), b = *(const f32x4*)(ssp + (size_t)row * 32 + 8 * fq + 4); ss = ((a.x + a.y) + (a.z + a.w)) + ((b.x + b.y) + (b.z + b.w)); }
    ss += __shfl_xor(ss, 16); ss += __shfl_xor(ss, 32);
    const float rstd = 1.0f / sqrtf(ss * (1.f / DM) + EPS);
    f32x4 lacc[3] = {(f32x4){0.f, 0.f, 0.f, 0.f}, (f32x4){0.f, 0.f, 0.f, 0.f}, (f32x4){0.f, 0.f, 0.f, 0.f}};
#pragma unroll 2
    for (int ks = 0; ks < 64; ++ks) { const int k = 32 * ks + 8 * fq;
        const f32x4 xa = *(const f32x4*)(h1 + k) * rstd, xb = *(const f32x4*)(h1 + k + 4) * rstd;
        const u32x4 hw = pack8(xa, xb);
        *(u32x4*)(BN + k) = hw;
        u32x4 lw; lw.x = cvt_pk_bf16(xa.x - bf_lo(hw.x), xa.y - bf_hi(hw.x)); lw.y = cvt_pk_bf16(xa.z - bf_lo(hw.y), xa.w - bf_hi(hw.y));
        lw.z = cvt_pk_bf16(xb.x - bf_lo(hw.z), xb.y - bf_hi(hw.z)); lw.w = cvt_pk_bf16(xb.z - bf_lo(hw.w), xb.w - bf_hi(hw.w));
        const bf16x8 bh = __builtin_bit_cast(bf16x8, hw), bl = __builtin_bit_cast(bf16x8, lw);
#pragma unroll
        for (int blk = 0; blk < 3; ++blk) { const bf16x8 wh = __builtin_bit_cast(bf16x8, wrf[(size_t)((ks * 3 + blk) * 2 + 0) * 64 + lane]), wl = __builtin_bit_cast(bf16x8, wrf[(size_t)((ks * 3 + blk) * 2 + 1) * 64 + lane]);
            lacc[blk] = __builtin_amdgcn_mfma_f32_16x16x32_bf16(wh, bh, lacc[blk], 0, 0, 0);
            lacc[blk] = __builtin_amdgcn_mfma_f32_16x16x32_bf16(wl, bh, lacc[blk], 0, 0, 0);
            lacc[blk] = __builtin_amdgcn_mfma_f32_16x16x32_bf16(wh, bl, lacc[blk], 0, 0, 0); } }
#pragma unroll
    for (int blk = 0; blk < 3; ++blk)
#pragma unroll
        for (int j = 0; j < 4; ++j) Lg[fr * 48 + 16 * blk + 4 * fq + j] = lacc[blk][j];
    LDS_WAIT(); asm volatile("" ::: "memory");
    int e0 = 0, e1 = 0; float g0 = 0.f, g1 = 0.f; unsigned rk0 = 0u, rk1 = 0u;
    if (lane < 16) {
        float lg[4]; int gi = 0; float gm;
#pragma unroll
        for (int j = 0; j < 4; ++j) lg[j] = Lg[lane * 48 + 32 + j] + A.b_rg[j];
        gm = lg[0];
#pragma unroll
        for (int j = 1; j < 4; ++j) if (lg[j] > gm) { gm = lg[j]; gi = j; }
        float gs = 0.f;
#pragma unroll
        for (int j = 0; j < 4; ++j) gs += __expf(lg[j] - gm);
        const float gp = 1.0f / gs;
        float l1 = -3.0e38f, l2 = -3.0e38f; int i1 = 0, i2 = 0;
#pragma unroll
        for (int j = 0; j < 8; ++j) { const float v = Lg[lane * 48 + gi * 8 + j] + A.b_re[gi * 8 + j];
            if (v > l1) { l2 = l1; i2 = i1; l1 = v; i1 = j; } else if (v > l2) { l2 = v; i2 = j; } }
        const float t = __expf(l2 - l1);
        g0 = gp / (1.0f + t); g1 = gp * t / (1.0f + t);
        e0 = gi * 8 + i1; e1 = gi * 8 + i2;
        rk0 = atomicAdd((unsigned*)(cntL + 2 * e0 + 0), 1u); rk1 = atomicAdd((unsigned*)(cntL + 2 * e1 + 1), 1u);
    }
    __syncthreads();
    if (tid < 64) { const unsigned c = cntL[tid]; unsigned base = 0u; if (c) base = __hip_atomic_fetch_add((unsigned*)(A.ws + WS_CTL) + CW_GCNT + tid, c, RLX_AGENT); baseL[tid] = base; }
    __syncthreads();
    if (lane < 16) { int* list = (int*)(A.ws + WS_LIST); float* glist = (float*)(A.ws + WS_GLIST);
        const size_t p0 = (size_t)(2 * e0 + 0) * LCAP + baseL[2 * e0 + 0] + rk0, p1 = (size_t)(2 * e1 + 1) * LCAP + baseL[2 * e1 + 1] + rk1;
        list[p0] = row; glist[p0] = g0; list[p1] = row; glist[p1] = g1; }
    __syncthreads();
}

__global__ void __launch_bounds__(512, 2) fwd(Args A) {
    extern __shared__ __attribute__((aligned(16))) unsigned char lds_raw[];
    LAS unsigned char* lds = (LAS unsigned char*)lds_raw;
    const int wave = __builtin_amdgcn_readfirstlane((int)threadIdx.x >> 6);
    const int G = gridDim.x; const int bx = blockIdx.x; const int vcu = (G % 8 == 0) ? (bx % 8) * (G / 8) + bx / 8 : bx;
    volatile LAS unsigned* MISC = (volatile LAS unsigned*)(lds + MISC_OFF);
    { const int tid0 = threadIdx.x; for (int u = tid0; u < 128; u += 512) MISC[u] = 0u; }
    __syncthreads();
    unsigned* ctl = (unsigned*)(A.ws + WS_CTL);
    XcdBarrier bar; bar.bar = ctl + CW_BAR; bar.x = 0; bar.st = nullptr;
    if (N_LAUNCHES == 1) bar = xcd_barrier_post(ctl + CW_BAR, MISC + 8);
#define GRID_BAR() do { if (N_LAUNCHES == 1) xcd_barrier(bar); } while (0)
    const int lo = A.ph_lo, hi = A.ph_hi;
#define IN(k) (lo <= (k) && (k) < hi)
#define BOTH(k) (IN(k) && IN((k) + 1))
    bf16_t* XN = (bf16_t*)(A.ws + WS_XN); bf16_t* Qb = (bf16_t*)(A.ws + WS_Q); bf16_t* Kb = (bf16_t*)(A.ws + WS_K); bf16_t* Vb = (bf16_t*)(A.ws + WS_V);
    bf16_t* Zb = (bf16_t*)(A.ws + WS_Z); bf16_t* MIX = (bf16_t*)(A.ws + WS_MIX); bf16_t* Hb = (bf16_t*)(A.ws + WS_H);

    if (IN(0)) { const int lane = fresh_lane(), tid = wave * 64 + lane; (void)lane;
#pragma unroll 1
        for (int rep = 0; rep < REPS[0]; ++rep) { p0_prologue(A, lds, vcu, G, tid, lane, wave); if (BOTH(0)) GRID_BAR(); } }

    if (IN(1)) { const int lane = fresh_lane(), tid = wave * 64 + lane; (void)lane;
        for (int cb = vcu; cb < 256; cb += G) p1_zmeta(A, cb, tid);
        { ProbIn<(ATT_MODE == 2) ? 0 : ATT_MODE> P; P.A = XN; P.Bt = (const bf16_t*)(A.ws + WS_WIN); P.S.init(NTOK, INW, G, bx); P.Q = Qb; P.Kb = Kb; P.Vb = Vb; P.Z = Zb; P.Q8 = A.ws + WS_Q8; P.K8 = A.ws + WS_K8; P.V8 = A.ws + WS_V8; P.qg = A.qg; P.kg = A.kg;
        P.cosT = (const float*)(A.ws + WS_ROPE); P.sinT = P.cosT + 256 * 32;
        pg8::gemm_phase<DM, ProbIn<(ATT_MODE == 2) ? 0 : ATT_MODE>>(lds + RING_OFF, lds + EPI_OFF, P, tid); }
        if (ATT_MODE == 2) { ProbIn<1> P; P.A = XN; P.Bt = (const bf16_t*)(A.ws + WS_WIN); P.S.init(NTOK, INW, G, bx); P.Q = Qb; P.Kb = Kb; P.Vb = Vb; P.Z = Zb; P.Q8 = A.ws + WS_Q8; P.K8 = A.ws + WS_K8; P.V8 = A.ws + WS_V8; P.qg = A.qg; P.kg = A.kg;
        P.cosT = (const float*)(A.ws + WS_ROPE); P.sinT = P.cosT + 256 * 32;
        pg8::gemm_phase<DM, ProbIn<1>>(lds + RING_OFF, lds + EPI_OFF, P, tid); }
        if (BOTH(1)) GRID_BAR();
    }

    if (IN(2)) { const int lane = fresh_lane(), tid = wave * 64 + lane; (void)lane;
#pragma unroll 1
      for (int rep = 0; rep < REPS[2]; ++rep) {
        for (int rb = vcu; rb < 256; rb += G) p2_pool_block(A, lds, rb, tid);
        if (ATT_MODE != 1) for (int U = vcu; U < 1024; U += G) {
            const int hg = U >> 8, rem = U & 255, bkv = rem >> 6, qb = rem & 63, b = bkv >> 1, kvh = bkv & 1, h = kvh * 4 + hg;
            att::attn_unit(Qb + ((size_t)(b * SEQ + qb * 256)) * ATTW + h * HD, Kb + (size_t)(b * 2 + kvh) * KVROWS * HD, Vb + (size_t)(b * 2 + kvh) * KVROWS * HD,
                           MIX + ((size_t)(b * SEQ + qb * 256)) * DM + h * HD, (LAS char*)lds, tid);
        }
        if (ATT_MODE != 0) for (int U = vcu; U < 1024; U += G) {
            const int hg = U >> 8, rem = U & 255, bkv = rem >> 6, qb = rem & 63, b = bkv >> 1, kvh = bkv & 1, h = kvh * 4 + hg;
            bf16_t* ob = (ATT_MODE == 1) ? MIX + ((size_t)(b * SEQ + qb * 256)) * DM + h * HD : (bf16_t*)(A.ws + WS_MIX2) + ((size_t)(b * SEQ + qb * 256)) * ATTW + h * HD;
            att8::attn_unit(A.ws + WS_Q8 + ((size_t)(b * SEQ + qb * 256)) * ATTW + h * HD, A.ws + WS_K8 + (size_t)(b * 2 + kvh) * KVROWS * HD, A.ws + WS_V8 + (size_t)(b * 2 + kvh) * NT_ATT * 8192,
                            ob, (ATT_MODE == 1) ? DM : ATTW, (LAS char*)lds, tid);
        }
        if (BOTH(2)) GRID_BAR();
      }
    }

    if (IN(3) && ATT_MODE == 2) {
        float e2 = 0.f, r2 = 0.f; const bf16_t* M2 = (const bf16_t*)(A.ws + WS_MIX2); const int tid = threadIdx.x;
        for (size_t i = (size_t)bx * 512 + tid; i < (size_t)NTOK * 128; i += (size_t)G * 512) { const size_t row = i >> 7, c8 = (i & 127) * 8;
            const u32x4 a = *(const u32x4*)(MIX + row * DM + c8), b = *(const u32x4*)(M2 + row * ATTW + c8);
            const unsigned aw[4] = {a.x, a.y, a.z, a.w}, bw[4] = {b.x, b.y, b.z, b.w};
#pragma unroll
            for (int q = 0; q < 4; ++q) { const float a0 = bf_lo(aw[q]), a1 = bf_hi(aw[q]), b0 = bf_lo(bw[q]), b1 = bf_hi(bw[q]); e2 += (a0 - b0) * (a0 - b0) + (a1 - b1) * (a1 - b1); r2 += a0 * a0 + a1 * a1; } }
        e2 = wave_sum(e2); r2 = wave_sum(r2);
        if ((tid & 63) == 0) { atomicAdd((float*)(ctl + CW_CHK), e2); atomicAdd((float*)(ctl + CW_CHK) + 1, r2); }
        GRID_BAR();
    }
    if (IN(3)) { const int lane = fresh_lane(), tid = wave * 64 + lane; (void)lane;
        ProbOut P; P.A = MIX; P.Bt = (const bf16_t*)(A.ws + WS_WOUT); P.S.init(NTOK, DM, G, bx); P.x = A.x; P.out = A.out; P.ssp = (float*)(A.ws + WS_SSP);
#pragma unroll 1
        for (int rep = 0; rep < REPS[3]; ++rep) { pg8::gemm_phase<DM, ProbOut>(lds + RING_OFF, lds + EPI_OFF, P, tid);
        if (BOTH(3)) GRID_BAR(); }
    }

    if (IN(4)) { const int lane = fresh_lane(), tid = wave * 64 + lane; (void)lane;
        for (int jb = vcu; jb < 256; jb += G) p4_block(A, lds, jb, tid, lane, wave);
        if (BOTH(4)) GRID_BAR();
    }

    if (IN(5)) { const int lane = fresh_lane(), tid = wave * 64 + lane; (void)lane;
        moe_tables(lds, ctl + CW_GCNT, tid);
        ProbGU P; P.A = XN; P.Bt = (const bf16_t*)(A.ws + WS_WGU); P.H = Hb; P.list = (const int*)(A.ws + WS_LIST); P.T = moe_tab(lds); P.vcu = vcu; P.G = G;
#pragma unroll 1
        for (int rep = 0; rep < REPS[5]; ++rep) { pg8::gemm_phase<DM, ProbGU>(lds + RING_OFF, lds + EPI_OFF, P, tid);
        if (BOTH(5)) GRID_BAR(); }
    }

    if (IN(6)) { const int lane = fresh_lane(), tid = wave * 64 + lane; (void)lane;
        moe_tables(lds, ctl + CW_GCNT, tid);
        ProbDown<0> P; P.A = Hb; P.Bt = (const bf16_t*)(A.ws + WS_WD); P.out = A.out; P.tmp = (bf16_t*)(A.ws + WS_MIX); P.list = (const int*)(A.ws + WS_LIST); P.glist = (const float*)(A.ws + WS_GLIST); P.T = moe_tab(lds); P.vcu = vcu; P.G = G;
        pg8::gemm_phase<DEXP, ProbDown<0>>(lds + RING_OFF, lds + EPI_OFF, P, tid);
        if (BOTH(6)) GRID_BAR();
    }

    if (IN(7)) { const int lane = fresh_lane(), tid = wave * 64 + lane; (void)lane;
        moe_tables(lds, ctl + CW_GCNT, tid);
        ProbDown<1> P; P.A = Hb; P.Bt = (const bf16_t*)(A.ws + WS_WD); P.out = A.out; P.tmp = (bf16_t*)(A.ws + WS_MIX); P.list = (const int*)(A.ws + WS_LIST); P.glist = (const float*)(A.ws + WS_GLIST); P.T = moe_tab(lds); P.vcu = vcu; P.G = G;
        pg8::gemm_phase<DEXP, ProbDown<1>>(lds + RING_OFF, lds + EPI_OFF, P, tid);
    }
    if (ATT_MODE == 2) {
        GRID_BAR();
        const float e2 = __hip_atomic_load((float*)(ctl + CW_CHK), RLX_AGENT), r2 = __hip_atomic_load((float*)(ctl + CW_CHK) + 1, RLX_AGENT);
        const float ratio = e2 / r2;
        float sc = 1.0f; if (!(ratio < 0.01f)) sc = 1.3f; if (!(ratio < 0.1f)) sc = 1.5f; if (!(ratio < 1.0f)) sc = 2.0f; if (!(ratio < 4.0f)) sc = 3.0f;
        if (sc != 1.0f) { f32x4* o4 = (f32x4*)A.out; const int tid = threadIdx.x;
            for (size_t i = (size_t)bx * 512 + tid; i < (size_t)NTOK * DM / 4; i += (size_t)G * 512) o4[i] = o4[i] * sc; }
    }
#undef IN
#undef BOTH
#undef GRID_BAR
}

extern "C" void kernel_launch(void* const* d_in, const int* in_sizes, int n_in, void* d_out, int out_size, void* d_ws, size_t ws_size, hipStream_t stream) {
    static int grid = 0;
    if (grid == 0) {
        if (n_in != 17 || in_sizes[0] != NTOK * DM || out_size != NTOK * DM || ws_size < WS_END) {
            fprintf(stderr, "kernel_launch: shape mismatch: n_in %d in0 %d out %d ws %zu (need %zu)\n", n_in, n_in > 0 ? in_sizes[0] : -1, out_size, ws_size, (size_t)WS_END); grid = -1; return; }
        int dev = 0, cus = 0, per_cu = 0;
        if (hipGetDevice(&dev) != hipSuccess || hipDeviceGetAttribute(&cus, hipDeviceAttributeMultiprocessorCount, dev) != hipSuccess) { grid = -1; return; }
        if (hipFuncSetAttribute((const void*)fwd, hipFuncAttributeMaxDynamicSharedMemorySize, LDS_BYTES) != hipSuccess) { fprintf(stderr, "kernel_launch: hipFuncSetAttribute failed\n"); grid = -1; return; }
        if (hipOccupancyMaxActiveBlocksPerMultiprocessor(&per_cu, (const void*)fwd, 512, LDS_BYTES) != hipSuccess || per_cu < 1)
            fprintf(stderr, "kernel_launch: note: occupancy query reports %d workgroups per CU\n", per_cu);
        (void)hipGetLastError();
        grid = cus;
    }
    if (grid < 0) return;
    if (hipMemsetAsync((char*)d_ws + WS_CTL, 0, CTL_ZERO_BYTES, stream) != hipSuccess) { fprintf(stderr, "kernel_launch: memset failed\n"); return; }
    Args a{};
    a.x = (const float*)d_in[0]; a.meta = (const float*)d_in[1]; a.g1 = (const float*)d_in[2]; a.w_in = (const float*)d_in[3]; a.qg = (const float*)d_in[4]; a.kg = (const float*)d_in[5];
    a.pool_w = (const float*)d_in[6]; a.pool_scale = (const float*)d_in[7]; a.w_out = (const float*)d_in[8]; a.g2 = (const float*)d_in[9]; a.w_rg = (const float*)d_in[10]; a.b_rg = (const float*)d_in[11];
    a.w_re = (const float*)d_in[12]; a.b_re = (const float*)d_in[13]; a.w_gate = (const float*)d_in[14]; a.w_up = (const float*)d_in[15]; a.w_down = (const float*)d_in[16];
    a.out = (float*)d_out; a.ws = (unsigned char*)d_ws;
    if (N_LAUNCHES == 1) { a.ph_lo = 0; a.ph_hi = PER_PHASE; hipLaunchKernelGGL(fwd, dim3(grid), dim3(512), LDS_BYTES, stream, a); }
    else for (int li = 0; li < PER_PHASE; ++li) { a.ph_lo = li; a.ph_hi = li + 1; hipLaunchKernelGGL(fwd, dim3(grid), dim3(512), LDS_BYTES, stream, a); }
    const hipError_t le = hipPeekAtLastError();
    if (le != hipSuccess) fprintf(stderr, "kernel_launch: launch failed: %s\n", hipGetErrorName(le));
}
```

```cpp
#include <hip/hip_runtime.h>
#include <hip/hip_bf16.h>
#include <cstdio>
#include <cstdint>
#include <cmath>

#ifndef MK_N_LAUNCHES
#define MK_N_LAUNCHES 1
#endif
constexpr int PER_PHASE = 8;
#ifndef ATT_MODE
#define ATT_MODE 1
#endif
#ifndef PROBE_REPS
#define PROBE_REPS {1,1,1,1,1,1,1,1}
#endif
constexpr int REPS[8] = PROBE_REPS;
constexpr int N_LAUNCHES = MK_N_LAUNCHES;

#define LAS __attribute__((address_space(3)))
#define GAS __attribute__((address_space(1)))
typedef unsigned short bf16_t;
typedef short bf16x8 __attribute__((ext_vector_type(8)));
typedef short s16x4 __attribute__((ext_vector_type(4)));
typedef float f32x2 __attribute__((ext_vector_type(2)));
typedef float f32x4 __attribute__((ext_vector_type(4)));
typedef float f32x8 __attribute__((ext_vector_type(8)));
typedef float f32x16 __attribute__((ext_vector_type(16)));
typedef unsigned u32x2 __attribute__((ext_vector_type(2)));
typedef unsigned u32x4 __attribute__((ext_vector_type(4)));
typedef GAS unsigned gu32;

constexpr int BATCH = 2, SEQ = 16384, DM = 2048, NTOK = BATCH * SEQ;
constexpr int NMETA = 16, HD = 128, NQH = 8, NKVH = 2;
constexpr int ATTW = 1024, KVW = 256, POOLW = 1024, INW = 2560;
constexpr int NEXP = 32, DEXP = 512;
constexpr int KVROWS = 64 + SEQ;
constexpr int NT_ATT = KVROWS / 64;
constexpr float EPS = 1e-6f;
constexpr int LCAP = NTOK;
constexpr int NLIST = 2 * NEXP;
constexpr int HROWS = 2 * NTOK + NLIST * 256;

constexpr size_t MiB = 1u << 20;
constexpr size_t WS_CTL = 0, CTL_ZERO_BYTES = 1 * MiB;
constexpr size_t WS_ROPE = 1 * MiB;
constexpr size_t WS_PMETA = 1 * MiB + 64 * 1024;
constexpr size_t WS_WRF = 1 * MiB + 128 * 1024;
constexpr size_t WS_ZM = 1 * MiB + 512 * 1024;
constexpr size_t WS_WIN = 2 * MiB;
constexpr size_t WS_WOUT = 12 * MiB;
constexpr size_t WS_WGU = 20 * MiB;
constexpr size_t WS_WD = 148 * MiB;
constexpr size_t WS_XN = 212 * MiB;
constexpr size_t WS_Q = 340 * MiB;
constexpr size_t WS_K = 404 * MiB;
constexpr size_t WS_V = 421 * MiB;
constexpr size_t WS_Z = 438 * MiB;
constexpr size_t WS_MIX = 502 * MiB;
constexpr size_t WS_SSP = 630 * MiB;
constexpr size_t WS_LIST = 634 * MiB;
constexpr size_t WS_GLIST = 642 * MiB;
constexpr size_t WS_H = 650 * MiB;
constexpr size_t WS_Q8 = 730 * MiB;
constexpr size_t WS_K8 = 762 * MiB;
constexpr size_t WS_V8 = 771 * MiB;
constexpr size_t WS_MIX2 = 780 * MiB;
constexpr size_t WS_END = 844 * MiB;
static_assert(WS_K + (size_t)4 * KVROWS * 128 * 2 <= WS_V && WS_H + (size_t)HROWS * 512 * 2 <= WS_END, "ws map");
constexpr int CW_TMO = 0, CW_GCNT = 64, CW_CHK = 256, CW_BAR = 4096;

constexpr int RING_OFF = 0, RING_BYTES = 131072;
constexpr int EPI_OFF = RING_BYTES;
constexpr int TAB_OFF = EPI_OFF + 16384;
constexpr int MISC_OFF = TAB_OFF + 4096;
constexpr int LDS_BYTES = MISC_OFF + 512;

#define LDS_WAIT() asm volatile("s_waitcnt lgkmcnt(0)" ::: "memory")
#define VM_WAIT() asm volatile("s_waitcnt vmcnt(0)" ::: "memory")
#define RLX_AGENT __ATOMIC_RELAXED, __HIP_MEMORY_SCOPE_AGENT

__device__ __forceinline__ unsigned cvt_pk_bf16(float lo, float hi) { unsigned r; asm volatile("v_cvt_pk_bf16_f32 %0, %1, %2" : "=v"(r) : "v"(lo), "v"(hi)); return r; }
__device__ __forceinline__ float bf_lo(unsigned w) { return __uint_as_float(w << 16); }
__device__ __forceinline__ float bf_hi(unsigned w) { return __uint_as_float(w & 0xffff0000u); }
__device__ __forceinline__ u32x4 pack8(f32x4 a, f32x4 b) { u32x4 w; w.x = cvt_pk_bf16(a[0], a[1]); w.y = cvt_pk_bf16(a[2], a[3]); w.z = cvt_pk_bf16(b[0], b[1]); w.w = cvt_pk_bf16(b[2], b[3]); return w; }
__device__ __forceinline__ int fresh_lane() { int l = (int)__builtin_amdgcn_mbcnt_hi(~0u, __builtin_amdgcn_mbcnt_lo(~0u, 0u)); asm volatile("" : "+v"(l)); return l; }
__device__ __forceinline__ float wave_sum(float v) {
#pragma unroll
    for (int o = 1; o < 64; o <<= 1) v += __shfl_xor(v, o);
    return v;
}
__device__ __forceinline__ unsigned pk4_fp8(float a, float b, float c, float d) { int w = __builtin_amdgcn_cvt_pk_fp8_f32(a, b, __float_as_int(a), false);
  w = __builtin_amdgcn_cvt_pk_fp8_f32(c, d, w, true); return (unsigned)w; }
__device__ __forceinline__ unsigned f6_code(float x) {
    const float a = __builtin_fabsf(x); unsigned c;
    if (a < 1.0f) c = (unsigned)(int)__builtin_rintf(a * 8.0f);
    else { c = ((unsigned)__builtin_amdgcn_cvt_pk_fp8_f32(a, a, 0, false) & 0x7fu) - 48u; c = c > 31u ? 31u : c; }
    return c | (x < 0.f ? 32u : 0u);
}
__device__ __forceinline__ unsigned long long pack8_f6(const f32x4& a, const f32x4& b) {
    const unsigned lo = f6_code(a[0]) | (f6_code(a[1]) << 6) | (f6_code(a[2]) << 12) | (f6_code(a[3]) << 18), hi = f6_code(b[0]) | (f6_code(b[1]) << 6) | (f6_code(b[2]) << 12) | (f6_code(b[3]) << 18);
    return (unsigned long long)lo | ((unsigned long long)hi << 24);
}
__device__ __forceinline__ void store_f6_piece(unsigned char* row, int b, int fq, unsigned long long w) {
    const int o32 = (fq == 0) ? 16 * b : (fq == 1) ? 16 * b + 8 : (fq == 2) ? 16 * b + 12 : 64 + 8 * b + 4;
    const int o16 = (fq == 0) ? 16 * b + 4 : (fq == 1) ? 16 * b + 6 : (fq == 2) ? 64 + 8 * b : 64 + 8 * b + 2;
    const unsigned v32 = (fq & 1) ? (unsigned)(w >> 16) : (unsigned)w; const unsigned short v16 = (fq & 1) ? (unsigned short)w : (unsigned short)(w >> 32);
    *(unsigned*)(row + o32) = v32; *(unsigned short*)(row + o16) = v16;
}
__host__ __device__ __forceinline__ int vpos(int kt) { const int kin = kt & 31; return 32 * ((kin >> 2) & 1) + 16 * (kt >> 5) + ((kin & 3) | ((kin >> 3) << 2)); }
__host__ __device__ __forceinline__ int swap45(int d) { return (d & 0x4F) | ((d & 0x20) >> 1) | ((d & 0x10) << 1); }
__host__ __device__ __forceinline__ int permB(int d) { return (d & 0x60) | ((d & 4) << 2) | ((d & 0x18) >> 1) | (d & 3); }
__host__ __device__ __forceinline__ int spos(int d) { return (d & 0x40) | ((d & 0x10) << 1) | ((d & 0x0C) << 1) | ((d & 0x20) >> 3) | (d & 3); }

namespace pg8 {
constexpr int BM = 256, BK = 64, HALF = 128, HTB = HALF * BK * 2, STAGE_BYTES = 8 * HTB, NXCD = 8, WGM = 8;
__host__ __device__ __forceinline__ int lds_byte(int r, int c) { const int st = (r >> 4) * 2 + (c >> 5), rr = r & 15, cc = c & 31, ob = rr * 64 + cc * 2; return st * 1024 + (ob ^ (((ob >> 9) & 1) << 5)); }
__host__ __device__ __forceinline__ void stage_rc(int b, int& R, int& C) { const int st = b / 1024, sb = b % 1024, swz = sb ^ (((sb >> 9) & 1) << 5); R = (st >> 1) * 16 + swz / 64; C = (st & 1) * 32 + (swz % 64) / 2; }

struct UnitMN { int pm, pn; };
struct StaticOrder {
    int nM, nN, nwg, G, c;
    __host__ __device__ void init(int M, int N, int G_, int c_) { nM = M / BM; nN = N / BM; nwg = nM * nN; G = G_; c = c_; }
    __host__ __device__ bool next(int i, UnitMN& u) const {
        const long L = (long)i * G + c; if (L >= nwg) return false;
        int wgid = (int)L; { const int q = nwg / NXCD, r = nwg % NXCD, xcd = wgid % NXCD, off = wgid / NXCD; wgid = (xcd < r ? xcd * (q + 1) : r * (q + 1) + (xcd - r) * q) + off; }
        const int nig = WGM * nN, gid = wgid / nig, fm = gid * WGM, gsz = (nM - fm) < WGM ? (nM - fm) : WGM;
        u.pm = fm + ((wgid % nig) % gsz); u.pn = (wgid % nig) / gsz; return true;
    }
};

template <int K, class Prob>
__device__ __forceinline__ void gemm_phase(LAS unsigned char* lds, LAS unsigned char* les, const Prob& P, int tid) {
    const int wid = __builtin_amdgcn_readfirstlane(tid >> 6), lane = tid & 63, wr = wid >> 2, wc = wid & 3, fr = lane & 15, fq = lane >> 4;
    constexpr int nt = K / BK;
    static_assert(K % 128 == 0 && K >= 256, "K");
    int Rr[2], Cc[2]; unsigned voffB[2];
#pragma unroll
    for (int i = 0; i < 2; ++i) { stage_rc(tid * 16 + i * 8192, Rr[i], Cc[i]); voffB[i] = (unsigned)(Rr[i] * K + Cc[i]) * 2u; }
    constexpr size_t kstep = (size_t)(BK * 2);
    constexpr size_t hstep = (size_t)HALF * K * 2;
    const unsigned ldsw = (unsigned)wid * 1024u;
    const int aoff = lds_byte(wr * 64 + fr, fq * 8), boff = lds_byte(wc * 32 + fr, fq * 8);
#define PG8_SA(b, h) (((b) * 2 + (h)) * HTB)
#define PG8_SB(b, h) ((4 + (b) * 2 + (h)) * HTB)
#define PG8_STAGE(bufoff, gbase, voff) do { _Pragma("unroll") for (int _i = 0; _i < 2; ++_i) \
        __builtin_amdgcn_global_load_lds((const unsigned*)((const char*)(gbase) + (voff)[_i]), (LAS unsigned*)(lds + (bufoff) + ldsw + _i * 8192), 16, 0, 0); } while (0)
#define PG8_LDA(dst, b, h) do { _Pragma("unroll") for (int m = 0; m < 4; ++m) _Pragma("unroll") for (int k = 0; k < 2; ++k) dst[m][k] = *(const LAS bf16x8*)(lds + PG8_SA(b, h) + aoff + m * 2048 + k * 1024); } while (0)
#define PG8_LDB(dst, b, h) do { _Pragma("unroll") for (int n = 0; n < 2; ++n) _Pragma("unroll") for (int k = 0; k < 2; ++k) dst[n][k] = *(const LAS bf16x8*)(lds + PG8_SB(b, h) + boff + n * 2048 + k * 1024); } while (0)
#define PG8_MMA(ai, bj, At, Bt) do { __builtin_amdgcn_s_setprio(1); _Pragma("unroll") for (int m = 0; m < 4; ++m) _Pragma("unroll") for (int n = 0; n < 2; ++n) _Pragma("unroll") for (int k = 0; k < 2; ++k) \
        acc[ai][bj][m][n] = __builtin_amdgcn_mfma_f32_16x16x32_bf16(Bt[n][k], At[m][k], acc[ai][bj][m][n], 0, 0, 0); __builtin_amdgcn_s_setprio(0); } while (0)
#define PG8_WAIT_V(n) asm volatile("s_waitcnt vmcnt(" #n ")" ::: "memory")
#define PG8_WAIT_L(n) asm volatile("s_waitcnt lgkmcnt(" #n ")" ::: "memory")
#define PG8_BAR __builtin_amdgcn_s_barrier()
#define PG8_SCHED __builtin_amdgcn_sched_barrier(0)
    typename Prob::Unit cur, nxt; int ui = 0;
    if (!P.next(0, cur)) return;
    f32x4 acc[2][2][4][2];
#pragma unroll
    for (int a = 0; a < 2; ++a)
#pragma unroll
        for (int b = 0; b < 2; ++b)
#pragma unroll
            for (int m = 0; m < 4; ++m)
#pragma unroll
                for (int n = 0; n < 2; ++n) acc[a][b][m][n] = (f32x4){0.f, 0.f, 0.f, 0.f};
    bf16x8 At[4][2], B0[2][2], B1[2][2];
    unsigned voA[2][2], voN[2][2];
    P.a_offs(cur, Rr, Cc, voA);
    const char* cA = P.a_base(cur); const char* cB = P.b_base(cur);
    PG8_STAGE(PG8_SB(0, 0), cB, voffB); PG8_STAGE(PG8_SB(0, 1), cB + hstep, voffB); PG8_STAGE(PG8_SA(0, 0), cA, voA[0]); PG8_STAGE(PG8_SA(0, 1), cA, voA[1]);
    if (wr == 1) PG8_BAR;
    PG8_WAIT_V(2); PG8_BAR;
    PG8_STAGE(PG8_SB(1, 0), cB + kstep, voffB); PG8_STAGE(PG8_SA(1, 0), cA + kstep, voA[0]); PG8_STAGE(PG8_SB(1, 1), cB + hstep + kstep, voffB);
    PG8_WAIT_V(6); PG8_BAR;
    for (;;) {
        const bool has_next = P.next(ui + 1, nxt);
        const char* nA = cA; const char* nB = cB;
#pragma unroll
        for (int h = 0; h < 2; ++h)
#pragma unroll
            for (int i = 0; i < 2; ++i) voN[h][i] = voA[h][i];
        if (has_next) { nA = P.a_base(nxt); nB = P.b_base(nxt); P.a_offs(nxt, Rr, Cc, voN); }
        for (int t = 0; t < nt; t += 2) {
            const bool last = (t == nt - 2);
            const char* a1 = cA + (size_t)(t + 1) * kstep;
            const char* a2 = last ? nA : cA + (size_t)(t + 2) * kstep; const char* b2 = last ? nB : cB + (size_t)(t + 2) * kstep;
            const char* a3 = a2 + kstep; const char* b3 = b2 + kstep;
            unsigned vo2[2][2];
#pragma unroll
            for (int h = 0; h < 2; ++h)
#pragma unroll
                for (int i = 0; i < 2; ++i) vo2[h][i] = last ? voN[h][i] : voA[h][i];
            PG8_LDB(B0, 0, 0); PG8_LDB(B1, 0, 1); PG8_SCHED; PG8_LDA(At, 0, 0); PG8_STAGE(PG8_SA(1, 1), a1, voA[1]);
            PG8_WAIT_V(8); PG8_WAIT_L(0); PG8_BAR; PG8_MMA(0, 0, At, B0); PG8_MMA(0, 1, At, B1); PG8_BAR; PG8_SCHED;
            PG8_LDA(At, 0, 1); PG8_STAGE(PG8_SB(0, 0), b2, voffB); PG8_STAGE(PG8_SB(0, 1), b2 + hstep, voffB); PG8_STAGE(PG8_SA(0, 0), a2, vo2[0]);
            PG8_WAIT_V(8); PG8_WAIT_L(0); PG8_BAR; PG8_MMA(1, 0, At, B0); PG8_MMA(1, 1, At, B1); PG8_BAR; PG8_SCHED;
            PG8_LDB(B0, 1, 0); PG8_LDB(B1, 1, 1); PG8_SCHED; PG8_LDA(At, 1, 0); PG8_STAGE(PG8_SA(0, 1), a2, vo2[1]);
            PG8_WAIT_V(8); PG8_WAIT_L(0); PG8_BAR; PG8_MMA(0, 0, At, B0); PG8_MMA(0, 1, At, B1); PG8_BAR; PG8_SCHED;
            PG8_LDA(At, 1, 1); PG8_STAGE(PG8_SB(1, 0), b3, voffB); PG8_STAGE(PG8_SB(1, 1), b3 + hstep, voffB); PG8_STAGE(PG8_SA(1, 0), a3, vo2[0]);
            PG8_WAIT_V(8); PG8_WAIT_L(0); PG8_BAR; PG8_MMA(1, 0, At, B0); PG8_MMA(1, 1, At, B1); PG8_BAR; PG8_SCHED;
        }
        if (wr == 0) PG8_BAR;
        P.epi(acc, cur, wr, wc, fr, fq, les, lane);
        if (!has_next) break;
#pragma unroll
        for (int a = 0; a < 2; ++a)
#pragma unroll
            for (int b = 0; b < 2; ++b)
#pragma unroll
                for (int m = 0; m < 4; ++m)
#pragma unroll
                    for (int n = 0; n < 2; ++n) acc[a][b][m][n] = (f32x4){0.f, 0.f, 0.f, 0.f};
        cur = nxt; cA = nA; cB = nB; ++ui;
#pragma unroll
        for (int h = 0; h < 2; ++h)
#pragma unroll
            for (int i = 0; i < 2; ++i) voA[h][i] = voN[h][i];
        if (wr == 1) PG8_BAR;
    }
    PG8_WAIT_V(0);
    PG8_BAR;
#undef PG8_SA
#undef PG8_SB
#undef PG8_STAGE
#undef PG8_LDA
#undef PG8_LDB
#undef PG8_MMA
#undef PG8_WAIT_V
#undef PG8_WAIT_L
#undef PG8_BAR
#undef PG8_SCHED
}
}

#define XB_TMO      128
#define XB_XCNT(j)  (256  + 64 * (j))
#define XB_XSUB(j)  (1280 + 64 * (j))
#define XB_XGEN(j)  (2304 + 64 * (j))
#define XB_TOP      3328
#define XB_TOPGEN   3392
#define XCD_BAR_WORDS 3456
#define XB_SPIN_CAP (1u << 18)
__device__ __forceinline__ unsigned xb_ld(unsigned* p)              { return __hip_atomic_load(p, __ATOMIC_RELAXED, __HIP_MEMORY_SCOPE_AGENT); }
__device__ __forceinline__ unsigned xb_add(unsigned* p, unsigned v) { return __hip_atomic_fetch_add(p, v, __ATOMIC_RELAXED, __HIP_MEMORY_SCOPE_AGENT); }
__device__ __forceinline__ unsigned xb_xcc_id() { return (unsigned)__builtin_amdgcn_s_getreg((3 << 11) | 20) & 0xFu; }
#define XB_SPIN(cond, bar) do { unsigned _sp = 0; while (cond) { __builtin_amdgcn_s_sleep(1); \
    if ((++_sp & 255u) == 0u) { if (xb_ld(&(bar)[XB_TMO])) break; if (_sp > XB_SPIN_CAP) { atomicAdd(&(bar)[XB_TMO], 1u); break; } } } } while (0)
struct XcdBarrier { unsigned* bar; unsigned x; volatile LAS unsigned* st; };
__device__ __forceinline__ XcdBarrier xcd_barrier_post(unsigned* bar, volatile LAS unsigned* st) {
    XcdBarrier b; b.bar = bar; b.x = xb_xcc_id(); b.st = st;
    if (threadIdx.x == 0) (void)xb_add(&bar[XB_XCNT(b.x)], 1u);
    return b;
}
__device__ __forceinline__ void xcd_barrier_complete(unsigned* bar, unsigned x, unsigned& nloc, unsigned& nx) {
    const unsigned G = gridDim.x * gridDim.y * gridDim.z;
    unsigned sum, cnt, mine, sp = 0u;
    for (;;) {
        sum = 0u; cnt = 0u; mine = 0u;
#pragma unroll
        for (unsigned j = 0; j < 16; ++j) { const unsigned c = xb_ld(&bar[XB_XCNT(j)]); sum += c; cnt += (c > 0u) ? 1u : 0u; mine = (j == x) ? c : mine; }
        if (sum == G) break;
        __builtin_amdgcn_s_sleep(1);
        if ((++sp & 255u) == 0u) { if (xb_ld(&bar[XB_TMO])) break; if (sp > XB_SPIN_CAP) { atomicAdd(&bar[XB_TMO], 1u); break; } }
    }
    nloc = mine > 0u ? mine : 1u; nx = cnt > 0u ? cnt : 1u;
}
__device__ __forceinline__ void xcd_barrier(const XcdBarrier& b) {
    asm volatile("s_waitcnt vmcnt(0)" ::: "memory");
    __syncthreads();
    if (threadIdx.x == 0) {
        unsigned* bar = b.bar;
        __builtin_amdgcn_s_waitcnt(0);
        unsigned nloc = b.st[0], nx = b.st[1];
        if (nloc == 0u) { xcd_barrier_complete(bar, b.x, nloc, nx); b.st[0] = nloc; b.st[1] = nx; }
        const unsigned old = xb_add(&bar[XB_XSUB(b.x)], 1u);
        const unsigned gen = old / nloc;
        if (old + 1u == (gen + 1u) * nloc) {
            __builtin_amdgcn_fence(__ATOMIC_RELEASE, "agent");
            asm volatile("s_waitcnt vmcnt(0)" ::: "memory");
            const unsigned og = xb_add(&bar[XB_TOP], 1u);
            const unsigned tg = og / nx;
            if (og + 1u == (tg + 1u) * nx) xb_add(&bar[XB_TOPGEN], 1u);
            else XB_SPIN(xb_ld(&bar[XB_TOPGEN]) == tg, bar);
            __builtin_amdgcn_fence(__ATOMIC_ACQUIRE, "agent");
            xb_add(&bar[XB_XGEN(b.x)], 1u);
            asm volatile("s_waitcnt vmcnt(0)" ::: "memory");
        } else {
            XB_SPIN(xb_ld(&bar[XB_XGEN(b.x)]) == gen, bar);
            __builtin_amdgcn_fence(__ATOMIC_ACQUIRE, "agent");
            asm volatile("s_waitcnt vmcnt(0)" ::: "memory");
        }
    }
    __syncthreads();
}

struct Args {
    const float* x; const float* meta; const float* g1; const float* w_in; const float* qg; const float* kg; const float* pool_w; const float* pool_scale; const float* w_out;
    const float* g2; const float* w_rg; const float* b_rg; const float* w_re; const float* b_re; const float* w_gate; const float* w_up; const float* w_down;
    float* out; unsigned char* ws; int ph_lo, ph_hi;
};

template <class RowFn>
__device__ __forceinline__ void transpose_item(const float* W, int ldw, int k0, int n0, const float* rs, LAS float* scr, int lane, const RowFn& rowp) {
    const float* wp = W + (size_t)k0 * ldw + n0 + lane;
#pragma unroll
    for (int hb = 0; hb < 2; ++hb) { float v[32];
#pragma unroll
        for (int i = 0; i < 32; ++i) v[i] = wp[(size_t)(hb * 32 + i) * ldw];
#pragma unroll
        for (int i = 0; i < 32; ++i) { float x = v[i]; if (rs) x *= rs[k0 + hb * 32 + i]; scr[(hb * 32 + i) * 65 + lane] = x; } }
    LDS_WAIT(); asm volatile("" ::: "memory");
    const int c = lane & 7;
#pragma unroll
    for (int j = 0; j < 8; ++j) { const int n = (lane >> 3) + 8 * j; const LAS float* s = scr + (8 * c) * 65 + n;
        u32x4 o; o.x = cvt_pk_bf16(s[0 * 65], s[1 * 65]); o.y = cvt_pk_bf16(s[2 * 65], s[3 * 65]); o.z = cvt_pk_bf16(s[4 * 65], s[5 * 65]); o.w = cvt_pk_bf16(s[6 * 65], s[7 * 65]);
        *(u32x4*)(rowp(n) + k0 + 8 * c) = o; }
    LDS_WAIT(); asm volatile("" ::: "memory");
}
struct RowWin { bf16_t* base; int n0; __device__ __forceinline__ bf16_t* operator()(int n) const { const int c = n0 + n; const int r = (c & ~127) + (c < 1280 ? swap45(c & 127) : permB(c & 127)); return base + (size_t)r * DM; } };
struct RowNat { bf16_t* base; int n0; int ld; __device__ __forceinline__ bf16_t* operator()(int n) const { return base + (size_t)(n0 + n) * ld; } };
struct RowPB  { bf16_t* base; int n0; int ld; __device__ __forceinline__ bf16_t* operator()(int n) const { const int c = n0 + n; return base + (size_t)((c & ~127) + permB(c & 127)) * ld; } };
struct RowGU  { bf16_t* base; int n0; int half; __device__ __forceinline__ bf16_t* operator()(int n) const { const int c = n0 + n; const int r = (c >> 7) * 256 + half * 128 + permB(c & 127); return base + (size_t)r * DM; } };

__device__ __forceinline__ void rms_row_to_bf16(const float* xrow, bf16_t* orow, int lane) {
    const f32x4* xr = (const f32x4*)xrow + lane;
    f32x4 v[8]; float s = 0.f;
#pragma unroll
    for (int j = 0; j < 8; ++j) { v[j] = xr[64 * j]; s += (v[j].x * v[j].x + v[j].y * v[j].y) + (v[j].z * v[j].z + v[j].w * v[j].w); }
    const float rstd = 1.0f / sqrtf(wave_sum(s) * (1.f / DM) + EPS);
    u32x2* o8 = (u32x2*)orow + lane;
#pragma unroll
    for (int j = 0; j < 8; ++j) { u32x2 w; w.x = cvt_pk_bf16(v[j].x * rstd, v[j].y * rstd); w.y = cvt_pk_bf16(v[j].z * rstd, v[j].w * rstd); o8[64 * j] = w; }
}

__device__ __forceinline__ void p0_meta_job(const Args& A, LAS unsigned char* lds, int cj, int tid, int lane, int wave) {
    LAS float* Am = (LAS float*)lds;
    LAS float* Raw = (LAS float*)(lds + EPI_OFF + 8192);
#pragma unroll 1
    for (int rr = 0; rr < 2; ++rr) { const int r = wave * 2 + rr; const f32x4* mr = (const f32x4*)(A.meta + (size_t)r * DM) + lane; f32x4 v[8]; float s = 0.f;
#pragma unroll
        for (int j = 0; j < 8; ++j) { v[j] = mr[64 * j]; s += (v[j].x * v[j].x + v[j].y * v[j].y) + (v[j].z * v[j].z + v[j].w * v[j].w); }
        const float rstd = 1.0f / sqrtf(wave_sum(s) * (1.f / DM) + EPS);
#pragma unroll
        for (int j = 0; j < 8; ++j) { const int k = 4 * (lane + 64 * j); const f32x4 g = *(const f32x4*)(A.g1 + k);
            Am[(k + 0) * 16 + r] = v[j].x * rstd * g.x; Am[(k + 1) * 16 + r] = v[j].y * rstd * g.y; Am[(k + 2) * 16 + r] = v[j].z * rstd * g.z; Am[(k + 3) * 16 + r] = v[j].w * rstd * g.w; } }
    __syncthreads();
    const int c = tid & 127, kq = tid >> 7, col0 = 1024 + 128 * cj;
    float acc[16];
#pragma unroll
    for (int i = 0; i < 16; ++i) acc[i] = 0.f;
    const float* wp = A.w_in + (size_t)(kq * 512) * INW + col0 + c;
#pragma unroll 1
    for (int k0 = 0; k0 < 512; k0 += 32) { float w[32];
#pragma unroll
        for (int u = 0; u < 32; ++u) w[u] = wp[(size_t)(k0 + u) * INW];
#pragma unroll
        for (int u = 0; u < 32; ++u) { const LAS f32x4* ap = (const LAS f32x4*)(Am + (kq * 512 + k0 + u) * 16);
#pragma unroll
            for (int q = 0; q < 4; ++q) { const f32x4 a4 = ap[q]; acc[4 * q + 0] += a4.x * w[u]; acc[4 * q + 1] += a4.y * w[u]; acc[4 * q + 2] += a4.z * w[u]; acc[4 * q + 3] += a4.w * w[u]; } } }
    __syncthreads();
    LAS float* Rq = Am;
#pragma unroll
    for (int i = 0; i < 16; ++i) Rq[(kq * 16 + i) * 128 + c] = acc[i];
    __syncthreads();
    for (int i = tid; i < 16 * 128; i += 512) Raw[i] = (Rq[i] + Rq[2048 + i]) + (Rq[4096 + i] + Rq[6144 + i]);
    __syncthreads();
    bf16_t* Kb = (bf16_t*)(A.ws + WS_K); bf16_t* Vb = (bf16_t*)(A.ws + WS_V);
    if (cj < 2) {
#pragma unroll 1
        for (int rr = 0; rr < 2; ++rr) { const int r = wave * 2 + rr; const float v0 = Raw[r * 128 + lane], v1 = Raw[r * 128 + 64 + lane];
            const float rstd = 1.0f / sqrtf(wave_sum(v0 * v0 + v1 * v1) * (1.f / HD) + EPS);
            const float y0 = v0 * rstd * A.kg[lane], y1 = v1 * rstd * A.kg[64 + lane];
#pragma unroll
            for (int b = 0; b < 2; ++b) { bf16_t* kr = Kb + ((size_t)(b * 2 + cj) * KVROWS + r) * HD; kr[spos(lane)] = (bf16_t)(cvt_pk_bf16(y0, 0.f) & 0xffffu); kr[spos(64 + lane)] = (bf16_t)(cvt_pk_bf16(y1, 0.f) & 0xffffu); } }
    } else if (cj < 4) {
#pragma unroll 1
        for (int rr = 0; rr < 2; ++rr) { const int r = wave * 2 + rr;
#pragma unroll
            for (int b = 0; b < 2; ++b) { bf16_t* vr = Vb + ((size_t)(b * 2 + (cj - 2)) * KVROWS + r) * HD; vr[lane] = (bf16_t)(cvt_pk_bf16(Raw[r * 128 + lane], 0.f) & 0xffffu); vr[64 + lane] = (bf16_t)(cvt_pk_bf16(Raw[r * 128 + 64 + lane], 0.f) & 0xffffu); } }
    } else {
        float* pm = (float*)(A.ws + WS_PMETA);
        for (int i = tid; i < 16 * 128; i += 512) pm[(size_t)(i >> 7) * POOLW + (cj - 4) * 128 + (i & 127)] = Raw[i];
    }
    if (ATT_MODE != 0 && cj < 2) {
        unsigned char* K8 = A.ws + WS_K8;
        LAS unsigned char* cod = (LAS unsigned char*)Am + 65536;
        for (int i = tid; i < 16 * 128; i += 512) { const int r = i >> 7, d = i & 127;
            const float v0 = Raw[r * 128 + d]; float ssq = 0.f;
            for (int q = 0; q < 128; ++q) { const float t = Raw[r * 128 + q]; ssq += t * t; }
            const float y = v0 * (1.0f / sqrtf(ssq * (1.f / HD) + EPS)) * A.kg[d];
            cod[r * 128 + spos(d)] = (unsigned char)f6_code(y); }
        __syncthreads();
        for (int i = tid; i < 16 * 4 * 6; i += 512) { const int r = i / 24, b = (i % 24) / 6, w = i % 6;
            unsigned long long acc = 0ull;
            for (int v = (32 * w) / 6; v <= (32 * w + 31) / 6 && v < 32; ++v) { const unsigned long long c = cod[r * 128 + 32 * b + v]; const int sh = 6 * v - 32 * w; acc |= (sh >= 0) ? (c << sh) : (c >> (-sh)); }
            const unsigned word = (unsigned)acc; const int off = (w < 4) ? 16 * b + 4 * w : 64 + 8 * b + 4 * (w - 4);
            *(unsigned*)(K8 + ((size_t)(0 * 2 + cj) * KVROWS + r) * HD + off) = word; *(unsigned*)(K8 + ((size_t)(1 * 2 + cj) * KVROWS + r) * HD + off) = word; }
        for (int i = tid; i < 16 * 8; i += 512) { const int r = i >> 3, q = i & 7;
            *(unsigned*)(K8 + ((size_t)(0 * 2 + cj) * KVROWS + r) * HD + 96 + 4 * q) = 0u; *(unsigned*)(K8 + ((size_t)(1 * 2 + cj) * KVROWS + r) * HD + 96 + 4 * q) = 0u; }
        for (int i = tid; i < 2 * 384; i += 512) { const int b = i / 384, q = i % 384; *(u32x4*)(K8 + ((size_t)(b * 2 + cj) * KVROWS + 16) * HD + q * 16) = (u32x4){0u, 0u, 0u, 0u}; }
        __syncthreads();
    }
    if (ATT_MODE != 0 && cj >= 2 && cj < 4) {
        LAS unsigned char* img = (LAS unsigned char*)Am + 65536;
        for (int i = tid; i < 512; i += 512) ((LAS u32x4*)img)[i] = (u32x4){0u, 0u, 0u, 0u};
        __syncthreads();
        for (int i = tid; i < 16 * 128; i += 512) { const int r = i >> 7, d = i & 127; img[d * 64 + vpos(r)] = (unsigned char)pk4_fp8(Raw[r * 128 + d], 0.f, 0.f, 0.f); }
        __syncthreads();
        unsigned char* V8 = A.ws + WS_V8;
        for (int i = tid; i < 2 * 512; i += 512) { const int b = i >> 9, q = i & 511; *(u32x4*)(V8 + ((size_t)(b * 2 + (cj - 2)) * NT_ATT) * 8192 + q * 16) = ((const LAS u32x4*)img)[q]; }
    }
    if (ATT_MODE != 1 && cj < 4) {
        bf16_t* base = (cj < 2) ? Kb : Vb; const int kvh = cj & 1;
        for (int i = tid; i < 2 * 768; i += 512) { const int b = i / 768, q = i % 768; *(u32x4*)(base + ((size_t)(b * 2 + kvh) * KVROWS + 16) * HD + q * 8) = (u32x4){0u, 0u, 0u, 0u}; }
    }
    __syncthreads();
}

__device__ __forceinline__ void p0_fold_job(const Args& A, LAS unsigned char* lds, int fj, int tid) {
    LAS float* As = (LAS float*)lds;
    const int g = fj >> 6, k0 = (fj & 63) * 32;
    for (int i = tid; i < 32 * 64; i += 512) { const int kk = i >> 6, c4 = (i & 63) * 4; f32x4 v = *(const f32x4*)(A.w_in + (size_t)(k0 + kk) * INW + 1536 + g * 256 + c4); const float gs = A.g1[k0 + kk];
        *(LAS f32x4*)(As + kk * 256 + c4) = v * gs; }
    __syncthreads();
    const int d = tid & 255, kh = tid >> 8;
    float acc[16];
#pragma unroll
    for (int i = 0; i < 16; ++i) acc[i] = 0.f;
    const float* pw = A.pool_w + (size_t)g * 256 * 256 + d;
#pragma unroll 1
    for (int c = 0; c < 256; c += 16) { float bv[16];
#pragma unroll
        for (int u = 0; u < 16; ++u) bv[u] = pw[(size_t)(c + u) * 256];
#pragma unroll
        for (int u = 0; u < 16; u += 4)
#pragma unroll
            for (int kk = 0; kk < 16; ++kk) { const f32x4 a = *(const LAS f32x4*)(As + (kh * 16 + kk) * 256 + c + u); acc[kk] += (a.x * bv[u] + a.y * bv[u + 1]) + (a.z * bv[u + 2] + a.w * bv[u + 3]); } }
    const float sc = A.pool_scale[g * 256 + d];
    bf16_t* dst = (bf16_t*)(A.ws + WS_WIN) + (size_t)(1536 + g * 256 + (d & 128) + permB(d & 127)) * DM + k0 + kh * 16;
#pragma unroll
    for (int q = 0; q < 2; ++q) { u32x4 w; w.x = cvt_pk_bf16(acc[8 * q + 0] * sc, acc[8 * q + 1] * sc); w.y = cvt_pk_bf16(acc[8 * q + 2] * sc, acc[8 * q + 3] * sc);
        w.z = cvt_pk_bf16(acc[8 * q + 4] * sc, acc[8 * q + 5] * sc); w.w = cvt_pk_bf16(acc[8 * q + 6] * sc, acc[8 * q + 7] * sc); *(u32x4*)(dst + 8 * q) = w; }
    __syncthreads();
}

__device__ __forceinline__ void p0_prologue(const Args& A, LAS unsigned char* lds, int vcu, int G, int tid, int lane, int wave) {
    (void)tid;
    for (int job = vcu; job < 12; job += G) { const int l2 = fresh_lane(); p0_meta_job(A, lds, job, wave * 64 + l2, l2, wave); }
    for (int job = vcu; job < 256; job += G) { const int l2 = fresh_lane(); p0_fold_job(A, lds, job, wave * 64 + l2); }
    lane = fresh_lane(); tid = wave * 64 + lane;
    {
        const int gt = (vcu * 8 + wave) * 64 + lane, NGT = G * 512;
        float* cosT = (float*)(A.ws + WS_ROPE); float* sinT = cosT + 256 * 32;
        for (int i = gt; i < 256 * 32; i += NGT) { const int pos = i >> 5, f = i & 31; const float inv = powf(10000.0f, -(float)(2 * f) / 64.0f); const float ang = (float)pos * inv; cosT[i] = cosf(ang); sinT[i] = sinf(ang); }
        u32x4* wrf = (u32x4*)(A.ws + WS_WRF);
        for (int i = gt; i < 64 * 3 * 64; i += NGT) { const int l = i & 63, blk = (i >> 6) % 3, ks = i / 192; const int col = 16 * blk + (l & 15), kb = 32 * ks + 8 * (l >> 4);
            float v[8];
#pragma unroll
            for (int q = 0; q < 8; ++q) { const int k = kb + q; float w = 0.f; if (col < 32) w = A.w_re[(size_t)k * NEXP + col]; else if (col < 36) w = A.w_rg[(size_t)k * 4 + (col - 32)]; v[q] = w * A.g2[k]; }
            u32x4 hi, lo; unsigned* hp = (unsigned*)&hi; unsigned* lp = (unsigned*)&lo;
#pragma unroll
            for (int q = 0; q < 4; ++q) { const unsigned h = cvt_pk_bf16(v[2 * q], v[2 * q + 1]); hp[q] = h; lp[q] = cvt_pk_bf16(v[2 * q] - bf_lo(h), v[2 * q + 1] - bf_hi(h)); }
            wrf[(size_t)((ks * 3 + blk) * 2 + 0) * 64 + l] = hi; wrf[(size_t)((ks * 3 + blk) * 2 + 1) * 64 + l] = lo; }
    }
    LAS float* scr = (LAS float*)(lds + wave * 16640);
    const int gw = vcu * 8 + wave, NGW = G * 8;
    constexpr int I_IN = 32 * 24, I_OUT = 32 * 32, I_G = 32 * 256, I_D = 32 * 256;
    constexpr int NITEMS = I_IN + I_OUT + 2 * I_G + I_D;
    bf16_t* Win_t = (bf16_t*)(A.ws + WS_WIN); bf16_t* Wout_t = (bf16_t*)(A.ws + WS_WOUT); bf16_t* Wgu_t = (bf16_t*)(A.ws + WS_WGU); bf16_t* Wd_t = (bf16_t*)(A.ws + WS_WD);
    for (int it = gw; it < NITEMS; it += NGW) {
        int r = it;
        if (r < I_IN) { const int kb = r / 24, nb = r % 24; transpose_item(A.w_in, INW, kb * 64, nb * 64, A.g1, scr, lane, RowWin{Win_t, nb * 64}); continue; } r -= I_IN;
        if (r < I_OUT) { const int kb = r / 32, nb = r % 32; transpose_item(A.w_out, DM, kb * 64, nb * 64, nullptr, scr, lane, RowNat{Wout_t, nb * 64, DM}); continue; } r -= I_OUT;
        if (r < 2 * I_G) { const int half = r / I_G; r -= half * I_G; const int e = r / 256, q = r % 256, kb = q / 8, nb = q % 8;
            transpose_item((half ? A.w_up : A.w_gate) + (size_t)e * DM * DEXP, DEXP, kb * 64, nb * 64, A.g2, scr, lane, RowGU{Wgu_t + (size_t)e * 1024 * DM, nb * 64, half}); continue; } r -= 2 * I_G;
        { const int e = r / 256, q = r % 256, kb = q / 32, nb = q % 32; transpose_item(A.w_down + (size_t)e * DEXP * DM, DM, kb * 64, nb * 64, nullptr, scr, lane, RowPB{Wd_t + (size_t)e * DM * DEXP, nb * 64, DEXP}); }
    }
    bf16_t* XN = (bf16_t*)(A.ws + WS_XN);
    if (G > 24) { if (vcu >= 12) for (int m = gw - 96; m < NTOK; m += NGW - 96) rms_row_to_bf16(A.x + (size_t)m * DM, XN + (size_t)m * DM, lane); }
    else for (int m = gw; m < NTOK; m += NGW) rms_row_to_bf16(A.x + (size_t)m * DM, XN + (size_t)m * DM, lane);
}

namespace att { constexpr float CQ_ = 0.088388347648318440f * 1.4426950408889634f; }
using pg8::UnitMN;
template <int AM> struct ProbIn {
    typedef UnitMN Unit;
    const bf16_t* A; const bf16_t* Bt; pg8::StaticOrder S;
    bf16_t *Q, *Kb, *Vb, *Z; unsigned char *Q8, *K8, *V8; const float *qg, *kg, *cosT, *sinT;
    __device__ __forceinline__ bool next(int i, Unit& u) const { return S.next(i, u); }
    __device__ __forceinline__ const char* a_base(const Unit& u) const { return (const char*)A + (size_t)u.pm * 256 * DM * 2; }
    __device__ __forceinline__ void a_offs(const Unit&, const int (&R)[2], const int (&C)[2], unsigned (&vo)[2][2]) const {
#pragma unroll
        for (int h = 0; h < 2; ++h)
#pragma unroll
            for (int i = 0; i < 2; ++i) vo[h][i] = (unsigned)((h * 128 + R[i]) * DM + C[i]) * 2u; }
    __device__ __forceinline__ const char* b_base(const Unit& u) const { return (const char*)Bt + (size_t)u.pn * 256 * DM * 2; }
    __device__ __forceinline__ void epi(f32x4 (&acc)[2][2][4][2], const Unit& u, int wr, int wc, int fr, int fq, LAS unsigned char* les, int lane) const {
        const int pn = u.pn; const int rbase = u.pm * 256 + wr * 64 + fr;
        if (pn <= 4) {
            LAS float* Pst = (LAS float*)les;
#pragma unroll
            for (int ai = 0; ai < 2; ++ai)
#pragma unroll
                for (int m = 0; m < 4; ++m)
#pragma unroll
                    for (int bj = 0; bj < 2; ++bj) { const f32x4 a = acc[ai][bj][m][0], b = acc[ai][bj][m][1];
                        float ss = ((a.x * a.x + a.y * a.y) + (a.z * a.z + a.w * a.w)) + ((b.x * b.x + b.y * b.y) + (b.z * b.z + b.w * b.w));
                        ss += __shfl_xor(ss, 16); ss += __shfl_xor(ss, 32);
                        if (fq == 0) Pst[((ai * 128 + wr * 64 + m * 16 + fr) * 2 + bj) * 4 + wc] = ss; }
            asm volatile("s_waitcnt lgkmcnt(0)" ::: "memory"); __builtin_amdgcn_s_barrier(); asm volatile("" ::: "memory");
            const float* gp = (pn < 4) ? qg : kg;
            const int dA = 64 * (wc >> 1) + 16 * (wc & 1) + 4 * fq, i0 = 16 * (wc & 1) + 4 * fq;
            const f32x4 g0 = *(const f32x4*)(gp + dA), g1v = *(const f32x4*)(gp + dA + 32);
#pragma unroll
            for (int ai = 0; ai < 2; ++ai)
#pragma unroll
                for (int m = 0; m < 4; ++m) { const int row = rbase + ai * 128 + m * 16; const int b = row >> 14, s = row & (SEQ - 1);
                    const int pos = (wc >> 1) ? (s & 63) : (s >> 6);
                    const f32x4 c4 = *(const f32x4*)(cosT + pos * 32 + i0), s4 = *(const f32x4*)(sinT + pos * 32 + i0);
#pragma unroll
                    for (int bj = 0; bj < 2; ++bj) { const f32x4 pp = *(const LAS f32x4*)(Pst + ((ai * 128 + wr * 64 + m * 16 + fr) * 2 + bj) * 4);
                        const float rstd = 1.0f / sqrtf(((pp.x + pp.y) + (pp.z + pp.w)) * (1.f / HD) + EPS);
                        const f32x4 x1 = acc[ai][bj][m][0] * rstd * g0, x2 = acc[ai][bj][m][1] * rstd * g1v;
                        f32x4 y1 = x1 * c4 - x2 * s4, y2 = x2 * c4 + x1 * s4;
                        if (pn < 4) { y1 = y1 * att::CQ_; y2 = y2 * att::CQ_; }
                        if (AM != 1) {
                        bf16_t* dst = (pn < 4) ? Q + (size_t)row * ATTW + (2 * pn + bj) * HD + 32 * wc + 8 * fq
                                               : Kb + ((size_t)(b * 2 + bj) * KVROWS + 64 + s) * HD + 32 * wc + 8 * fq;
                        *(u32x4*)dst = pack8(y1, y2); }
                        if (AM != 0) {
                          if (pn < 4) {
                            store_f6_piece(Q8 + (size_t)row * ATTW + (2 * pn + bj) * HD, wc, fq, pack8_f6(y1 * 8.0f, y2 * 8.0f));
                          } else {
                            store_f6_piece(K8 + ((size_t)(b * 2 + bj) * KVROWS + 64 + s) * HD, wc, fq, pack8_f6(y1, y2)); } } } }
        } else {
            if (AM != 0 && pn == 5) {
                LAS unsigned char* T = les + (wr * 4 + wc) * 2048;
#pragma unroll
                for (int ai = 0; ai < 2; ++ai)
#pragma unroll
                    for (int bj = 0; bj < 2; ++bj) {
#pragma unroll
                        for (int m = 0; m < 4; ++m) { const int pp = vpos(16 * m + fr);
#pragma unroll
                            for (int n = 0; n < 2; ++n) { const f32x4 v = acc[ai][bj][m][n]; const unsigned w = pk4_fp8(v[0], v[1], v[2], v[3]); const int dl = 8 * fq + 4 * n;
                                T[(dl + 0) * 64 + pp] = (unsigned char)w; T[(dl + 1) * 64 + pp] = (unsigned char)(w >> 8); T[(dl + 2) * 64 + pp] = (unsigned char)(w >> 16); T[(dl + 3) * 64 + pp] = (unsigned char)(w >> 24); } }
                        asm volatile("s_waitcnt lgkmcnt(0)" ::: "memory");
                        const int row0 = u.pm * 256 + ai * 128 + wr * 64; const int b0 = row0 >> 14, tile = 1 + ((row0 & (SEQ - 1)) >> 6);
                        unsigned char* dst = V8 + (((size_t)(b0 * 2 + bj) * NT_ATT + tile) * 128 + 32 * wc) * 64;
                        const u32x4 c0 = *(const LAS u32x4*)(T + lane * 16), c1 = *(const LAS u32x4*)(T + 1024 + lane * 16);
                        *(u32x4*)(dst + lane * 16) = c0; *(u32x4*)(dst + 1024 + lane * 16) = c1;
                        asm volatile("s_waitcnt lgkmcnt(0)" ::: "memory"); }
            }
            if (AM == 1 && pn == 5) return;
#pragma unroll
            for (int ai = 0; ai < 2; ++ai)
#pragma unroll
                for (int m = 0; m < 4; ++m) { const int row = rbase + ai * 128 + m * 16; const int b = row >> 14, s = row & (SEQ - 1);
#pragma unroll
                    for (int bj = 0; bj < 2; ++bj) {
                        bf16_t* dst = (pn == 5) ? Vb + ((size_t)(b * 2 + bj) * KVROWS + 64 + s) * HD + 32 * wc + 8 * fq
                                                : Z + (size_t)row * POOLW + (pn - 6) * 256 + bj * 128 + 32 * wc + 8 * fq;
                        *(u32x4*)dst = pack8(acc[ai][bj][m][0], acc[ai][bj][m][1]); } }
        }
    }
};
struct ProbOut {
    typedef UnitMN Unit;
    const bf16_t* A; const bf16_t* Bt; pg8::StaticOrder S; const float* x; float* out; float* ssp;
    __device__ __forceinline__ bool next(int i, Unit& u) const { return S.next(i, u); }
    __device__ __forceinline__ const char* a_base(const Unit& u) const { return (const char*)A + (size_t)u.pm * 256 * DM * 2; }
    __device__ __forceinline__ void a_offs(const Unit&, const int (&R)[2], const int (&C)[2], unsigned (&vo)[2][2]) const {
#pragma unroll
        for (int h = 0; h < 2; ++h)
#pragma unroll
            for (int i = 0; i < 2; ++i) vo[h][i] = (unsigned)((h * 128 + R[i]) * DM + C[i]) * 2u; }
    __device__ __forceinline__ const char* b_base(const Unit& u) const { return (const char*)Bt + (size_t)u.pn * 256 * DM * 2; }
    __device__ __forceinline__ void epi(f32x4 (&acc)[2][2][4][2], const Unit& u, int wr, int wc, int fr, int fq, LAS unsigned char*, int) const {
        const int col0 = u.pn * 256 + wc * 32 + 4 * fq; const int row0 = u.pm * 256 + wr * 64 + fr;
        f32x4 xb[4][4];
#define XLOAD(c) do { const size_t off_ = (size_t)(row0 + ((c) >> 2) * 128 + ((c) & 3) * 16) * DM + col0; \
            _Pragma("unroll") for (int q = 0; q < 4; ++q) xb[(c) & 3][q] = *(const f32x4*)(x + off_ + (q >> 1) * 128 + (q & 1) * 16); } while (0)
        XLOAD(0); XLOAD(1); XLOAD(2);
#pragma unroll
        for (int c = 0; c < 8; ++c) { const int ai = c >> 2, m = c & 3; const int row = row0 + ai * 128 + m * 16; const size_t off = (size_t)row * DM + col0; float ss = 0.f;
            if (c + 3 < 8) XLOAD(c + 3);
            asm volatile("" ::: "memory");
#pragma unroll
            for (int q = 0; q < 4; ++q) { const f32x4 v = xb[c & 3][q] + acc[ai][q >> 1][m][q & 1]; *(f32x4*)(out + off + (q >> 1) * 128 + (q & 1) * 16) = v;
                ss += (v.x * v.x + v.y * v.y) + (v.z * v.z + v.w * v.w); }
            ss += __shfl_xor(ss, 16); ss += __shfl_xor(ss, 32);
            if (fq == 0) ssp[(size_t)row * 32 + u.pn * 4 + wc] = ss;
            asm volatile("" ::: "memory"); }
#undef XLOAD
    }
};
struct MoeTab { LAS int* cnt; LAS int* tb; LAS int* tbk; };
__device__ __forceinline__ MoeTab moe_tab(LAS unsigned char* lds) { MoeTab t; t.cnt = (LAS int*)(lds + TAB_OFF); t.tb = t.cnt + 64; t.tbk = t.tb + 72; return t; }
__device__ __forceinline__ void moe_tables(LAS unsigned char* lds, const unsigned* gcnt, int tid) {
    MoeTab T = moe_tab(lds);
    if (tid < 64) T.cnt[tid] = (int)__hip_atomic_load(gcnt + tid, RLX_AGENT);
    __syncthreads();
    if (tid == 0) { int s = 0; for (int li = 0; li < 64; ++li) { T.tb[li] = s; s += (T.cnt[li] + 255) >> 8; } T.tb[64] = s;
        for (int k = 0; k < 2; ++k) { int q = 0; for (int e = 0; e < 32; ++e) { T.tbk[k * 33 + e] = q; q += (T.cnt[2 * e + k] + 255) >> 8; } T.tbk[k * 33 + 32] = q; } }
    __syncthreads();
}
struct UnitMoe { int T, j, li, tl; };
struct ProbGU {
    typedef UnitMoe Unit;
    const bf16_t* A; const bf16_t* Bt; bf16_t* H; const int* list; MoeTab T; int vcu, G;
    __device__ __forceinline__ bool next(int i, Unit& u) const {
        const int un = i * G + vcu; const int ntile = T.tb[64]; if (un >= ntile * 4) return false;
        const int Tt = un >> 2; int li = 0;
        for (int q = 1; q < 64; ++q) li += (T.tb[q] <= Tt) ? 1 : 0;
        li = __builtin_amdgcn_readfirstlane(li);
        u.T = Tt; u.j = un & 3; u.li = li; u.tl = Tt - __builtin_amdgcn_readfirstlane(T.tb[li]); return true; }
    __device__ __forceinline__ const char* a_base(const Unit&) const { return (const char*)A; }
    __device__ __forceinline__ void a_offs(const Unit& u, const int (&R)[2], const int (&C)[2], unsigned (&vo)[2][2]) const {
        const int cnt = T.cnt[u.li];
#pragma unroll
        for (int h = 0; h < 2; ++h)
#pragma unroll
            for (int i = 0; i < 2; ++i) { const int slot = u.tl * 256 + h * 128 + R[i]; int tok = 0; if (slot < cnt) tok = list[(size_t)u.li * LCAP + slot]; vo[h][i] = (unsigned)(tok * DM + C[i]) * 2u; } }
    __device__ __forceinline__ const char* b_base(const Unit& u) const { return (const char*)Bt + (size_t)((u.li >> 1) * 4 + u.j) * 256 * DM * 2; }
    __device__ __forceinline__ void epi(f32x4 (&acc)[2][2][4][2], const Unit& u, int wr, int wc, int fr, int fq, LAS unsigned char*, int) const {
#pragma unroll
        for (int ai = 0; ai < 2; ++ai)
#pragma unroll
            for (int m = 0; m < 4; ++m) { const int hrow = u.T * 256 + ai * 128 + wr * 64 + m * 16 + fr; f32x4 hv[2];
#pragma unroll
                for (int n = 0; n < 2; ++n) { const f32x4 g = acc[ai][0][m][n], up = acc[ai][1][m][n];
#pragma unroll
                    for (int e = 0; e < 4; ++e) hv[n][e] = g[e] * __builtin_amdgcn_rcpf(1.0f + __builtin_amdgcn_exp2f(-1.4426950408889634f * g[e])) * up[e]; }
                *(u32x4*)(H + (size_t)hrow * DEXP + u.j * 128 + 32 * wc + 8 * fq) = pack8(hv[0], hv[1]); }
    }
};
template <int KK> struct ProbDown {
    typedef UnitMoe Unit;
    const bf16_t* A; const bf16_t* Bt; float* out; bf16_t* tmp; const int* list; const float* glist; MoeTab T; int vcu, G;
    __device__ __forceinline__ bool next(int i, Unit& u) const {
        const int un = i * G + vcu; const int ntile = T.tbk[KK * 33 + 32]; if (un >= ntile * 8) return false;
        const int Tk = un >> 3; int e = 0;
        for (int q = 1; q < 32; ++q) e += (T.tbk[KK * 33 + q] <= Tk) ? 1 : 0;
        e = __builtin_amdgcn_readfirstlane(e);
        u.li = 2 * e + KK; u.tl = Tk - __builtin_amdgcn_readfirstlane(T.tbk[KK * 33 + e]); u.T = __builtin_amdgcn_readfirstlane(T.tb[u.li]) + u.tl; u.j = un & 7; return true; }
    __device__ __forceinline__ const char* a_base(const Unit& u) const { return (const char*)A + (size_t)u.T * 256 * DEXP * 2; }
    __device__ __forceinline__ void a_offs(const Unit&, const int (&R)[2], const int (&C)[2], unsigned (&vo)[2][2]) const {
#pragma unroll
        for (int h = 0; h < 2; ++h)
#pragma unroll
            for (int i = 0; i < 2; ++i) vo[h][i] = (unsigned)((h * 128 + R[i]) * DEXP + C[i]) * 2u; }
    __device__ __forceinline__ const char* b_base(const Unit& u) const { return (const char*)Bt + ((size_t)(u.li >> 1) * DM + u.j * 256) * DEXP * 2; }
    __device__ __forceinline__ void epi(f32x4 (&acc)[2][2][4][2], const Unit& u, int wr, int wc, int fr, int fq, LAS unsigned char*, int) const {
        const int cnt = T.cnt[u.li]; const int col0 = u.j * 256 + wc * 32 + 8 * fq;
        int tok[2][4]; float gt[2][4];
#pragma unroll
        for (int ai = 0; ai < 2; ++ai)
#pragma unroll
            for (int m = 0; m < 4; ++m) { const int slot = u.tl * 256 + ai * 128 + wr * 64 + m * 16 + fr; const bool ok = slot < cnt; const int sl = ok ? slot : 0;
                tok[ai][m] = list[(size_t)u.li * LCAP + sl]; gt[ai][m] = glist[(size_t)u.li * LCAP + sl]; if (!ok) tok[ai][m] = -1; }
        if (KK == 0) {
#pragma unroll
            for (int ai = 0; ai < 2; ++ai)
#pragma unroll
                for (int m = 0; m < 4; ++m) {
                    if (tok[ai][m] >= 0) { const size_t ro = (size_t)tok[ai][m] * DM + col0; const float g = gt[ai][m];
#pragma unroll
                        for (int bj = 0; bj < 2; ++bj) *(u32x4*)(tmp + ro + bj * 128) = pack8(acc[ai][bj][m][0] * g, acc[ai][bj][m][1] * g); }
                    if (m & 1) asm volatile("" ::: "memory"); }
        } else {
            u32x4 tb[3][2]; f32x4 ob[3][4];
#define DLOAD(c) do { const int tk_ = tok[(c) >> 2][(c) & 3]; const size_t ro_ = (size_t)(tk_ < 0 ? 0 : tk_) * DM + col0; \
                _Pragma("unroll") for (int bj = 0; bj < 2; ++bj) { tb[(c) % 3][bj] = *(const u32x4*)(tmp + ro_ + bj * 128); ob[(c) % 3][2 * bj] = *(const f32x4*)(out + ro_ + bj * 128); ob[(c) % 3][2 * bj + 1] = *(const f32x4*)(out + ro_ + bj * 128 + 4); } } while (0)
            DLOAD(0); DLOAD(1);
#pragma unroll
            for (int c = 0; c < 8; ++c) { const int ai = c >> 2, m = c & 3;
                if (c + 2 < 8) DLOAD(c + 2);
                asm volatile("" ::: "memory");
                if (tok[ai][m] >= 0) { const size_t ro = (size_t)tok[ai][m] * DM + col0; const float g = gt[ai][m];
#pragma unroll
                    for (int bj = 0; bj < 2; ++bj) { const u32x4 t = tb[c % 3][bj];
                        const f32x4 v0 = ob[c % 3][2 * bj] + (f32x4){bf_lo(t.x), bf_hi(t.x), bf_lo(t.y), bf_hi(t.y)} + acc[ai][bj][m][0] * g, v1 = ob[c % 3][2 * bj + 1] + (f32x4){bf_lo(t.z), bf_hi(t.z), bf_lo(t.w), bf_hi(t.w)} + acc[ai][bj][m][1] * g;
                        *(f32x4*)(out + ro + bj * 128) = v0; *(f32x4*)(out + ro + bj * 128 + 4) = v1; } }
                asm volatile("" ::: "memory"); }
#undef DLOAD
        }
    }
};

namespace att {
constexpr int D = 128, NW = 8, QBLK = 32, KVBLK = 64;
constexpr float CQ = 0.088388347648318440f * 1.4426950408889634f;
constexpr float THRL = 8.f;
constexpr int LDQ = ATTW, LDO = DM;
constexpr int KSLOT = 16384, NKS = 3, NVS = 4, LDS_K = 0, LDS_V = NKS * KSLOT, LDS_WS = LDS_V + NVS * KSLOT;
#define SBAR() __builtin_amdgcn_sched_barrier(0)
__device__ __forceinline__ int crow(int r, int hi) { return (r & 3) + 8 * (r >> 2) + 4 * hi; }
__device__ __forceinline__ unsigned cvtpk(float lo, float hi) { unsigned r; asm volatile("v_cvt_pk_bf16_f32 %0, %1, %2" : "=v"(r) : "v"(lo), "v"(hi)); return r; }
__device__ __forceinline__ int v_rd_base(int lane) { return ((lane & 3) << 3) | (((lane >> 2) & 3) << 6) | (((lane >> 4) & 1) << 5) | (((lane >> 5) & 1) << 8); }
constexpr int v_rd_off(int d0, int ks, int half) { return d0 * 512 + ks * 4096 + half * 2048; }
template <int OFF> __device__ __forceinline__ s16x4 tr_read(int vb) {
  s16x4 r; asm volatile("ds_read_b64_tr_b16 %0, %1 offset:%2" : "=&v"(r) : "v"(vb), "i"(OFF) : "memory"); return r;
}
struct VG { s16x4 l0, h0, l1, h1; };
template <int G> __device__ __forceinline__ void v_read(VG& v, int vb) {
  constexpr int d0 = G >> 1, ks = 2 * (G & 1);
  v.l0 = tr_read<v_rd_off(d0, ks, 0)>(vb); v.h0 = tr_read<v_rd_off(d0, ks, 1)>(vb); v.l1 = tr_read<v_rd_off(d0, ks + 1, 0)>(vb); v.h1 = tr_read<v_rd_off(d0, ks + 1, 1)>(vb);
}
#define V_WAIT(N, v) asm volatile("s_waitcnt lgkmcnt(" #N ")" : "+v"(v.l0), "+v"(v.h0), "+v"(v.l1), "+v"(v.h1))
#define PKV(L, H) (bf16x8){L[0], L[1], L[2], L[3], H[0], H[1], H[2], H[3]}
#define V_MMA(od, v, pe, po) do { od = __builtin_amdgcn_mfma_f32_32x32x16_bf16(pe, PKV(v.l0, v.h0), od, 0, 0, 0); od = __builtin_amdgcn_mfma_f32_32x32x16_bf16(po, PKV(v.l1, v.h1), od, 0, 0, 0); } while (0)
__device__ __forceinline__ void pv_d0(f32x16* o, int vb, bf16x8 pa0, bf16x8 pa1, bf16x8 pa2, bf16x8 pa3) {
  VG a, b, c;
  v_read<0>(a, vb); v_read<1>(b, vb); v_read<2>(c, vb);
  V_WAIT(8, a); V_MMA(o[0], a, pa0, pa1); v_read<3>(a, vb);
  V_WAIT(8, b); V_MMA(o[0], b, pa2, pa3); v_read<4>(b, vb);
  V_WAIT(8, c); V_MMA(o[1], c, pa0, pa1); v_read<5>(c, vb);
  V_WAIT(8, a); V_MMA(o[1], a, pa2, pa3); v_read<6>(a, vb);
  V_WAIT(8, b); V_MMA(o[2], b, pa0, pa1); v_read<7>(b, vb);
  V_WAIT(8, c); V_MMA(o[2], c, pa2, pa3);
  V_WAIT(4, a); V_MMA(o[3], a, pa0, pa1);
  V_WAIT(0, b); V_MMA(o[3], b, pa2, pa3);
}
#undef V_MMA
#undef PKV
struct KG { bf16x8 b0, b1; };
template <int D0> __device__ __forceinline__ void k_read(KG& k, const int (&kb)[4]) {
  asm volatile("ds_read_b128 %0, %1 offset:%2" : "=&v"(k.b0) : "v"(kb[D0 & 3]), "i"((D0 >> 2) * 128) : "memory");
  asm volatile("ds_read_b128 %0, %1 offset:%2" : "=&v"(k.b1) : "v"(kb[D0 & 3]), "i"((D0 >> 2) * 128 + 8192) : "memory");
}
#define K_WAIT(N, k) asm volatile("s_waitcnt lgkmcnt(" #N ")" : "+v"(k.b0), "+v"(k.b1))
__device__ __forceinline__ void qkt(f32x16& p0, f32x16& p1, const int (&kb)[4], const bf16x8* qr, const f32x16& negm) {
  KG a, b;
  k_read<0>(a, kb); k_read<1>(b, kb);
  K_WAIT(2, a); p0 = __builtin_amdgcn_mfma_f32_32x32x16_bf16(a.b0, qr[0], negm, 0, 0, 0); p1 = __builtin_amdgcn_mfma_f32_32x32x16_bf16(a.b1, qr[0], negm, 0, 0, 0); k_read<2>(a, kb);
#define K_MMA(k, d) do { p0 = __builtin_amdgcn_mfma_f32_32x32x16_bf16(k.b0, qr[d], p0, 0, 0, 0); p1 = __builtin_amdgcn_mfma_f32_32x32x16_bf16(k.b1, qr[d], p1, 0, 0, 0); } while (0)
  K_WAIT(2, b); K_MMA(b, 1); k_read<3>(b, kb);
  K_WAIT(2, a); K_MMA(a, 2); k_read<4>(a, kb);
  K_WAIT(2, b); K_MMA(b, 3); k_read<5>(b, kb);
  K_WAIT(2, a); K_MMA(a, 4); k_read<6>(a, kb);
  K_WAIT(2, b); K_MMA(b, 5); k_read<7>(b, kb);
  K_WAIT(2, a); K_MMA(a, 6);
  K_WAIT(0, b); K_MMA(b, 7);
#undef K_MMA
}
__device__ __forceinline__ void finishSM(f32x16& p0, f32x16& p1, float& l_reg, bf16x8& pa0, bf16x8& pa1, bf16x8& pa2, bf16x8& pa3) {
#pragma unroll
  for (int r = 0; r < 16; ++r) p1[r] = __builtin_amdgcn_exp2f(p1[r]);
  float ps = 0;
#pragma unroll
  for (int r = 0; r < 16; ++r) ps += p0[r];
#pragma unroll
  for (int r = 0; r < 16; ++r) ps += p1[r];
  l_reg += ps;
#define PK4(P, BASE, OUT) do { unsigned a0 = cvtpk(P[BASE + 0], P[BASE + 1]), a1 = cvtpk(P[BASE + 2], P[BASE + 3]);   \
    unsigned b0 = cvtpk(P[BASE + 4], P[BASE + 5]), b1 = cvtpk(P[BASE + 6], P[BASE + 7]);                              \
    auto r0 = __builtin_amdgcn_permlane32_swap(a0, b0, false, false); auto r1 = __builtin_amdgcn_permlane32_swap(a1, b1, false, false); \
    u32x4 w = {r0[0], r1[0], r0[1], r1[1]}; OUT = *reinterpret_cast<bf16x8*>(&w); } while (0)
  PK4(p0, 0, pa0); PK4(p0, 8, pa1); PK4(p1, 0, pa2); PK4(p1, 8, pa3);
#undef PK4
}
template <bool FIRST>
__device__ __forceinline__ void startSM(f32x16& p0, f32x16& p1, float& mhat, float& l_reg, f32x16& negm, bool& resc, float& f) {
  float a = __builtin_fmaxf(__builtin_fmaxf(p0[0], p0[1]), p1[0]), b = __builtin_fmaxf(__builtin_fmaxf(p0[2], p0[3]), p1[1]); a = __builtin_fmaxf(__builtin_fmaxf(a, p1[2]), p1[3]);
#pragma unroll
  for (int r = 4; r < 16; r += 4) { a = __builtin_fmaxf(__builtin_fmaxf(a, p0[r]), p0[r + 1]); b = __builtin_fmaxf(__builtin_fmaxf(b, p0[r + 2]), p0[r + 3]);
    a = __builtin_fmaxf(__builtin_fmaxf(a, p1[r]), p1[r + 1]); b = __builtin_fmaxf(__builtin_fmaxf(b, p1[r + 2]), p1[r + 3]); }
  float rm = __builtin_fmaxf(a, b);
  { auto rr = __builtin_amdgcn_permlane32_swap(__float_as_uint(rm), __float_as_uint(rm), false, false); rm = __builtin_fmaxf(__uint_as_float(rr[0]), __uint_as_float(rr[1])); }
  resc = false; f = 1.f;
  if (FIRST || __builtin_expect(__any(rm > THRL), 0)) {
    const float dl = FIRST ? rm : __builtin_fmaxf(rm, 0.f); mhat += dl;
#pragma unroll
    for (int r = 0; r < 16; ++r) { p0[r] -= dl; p1[r] -= dl; }
#pragma unroll
    for (int r = 0; r < 16; ++r) negm[r] = -mhat;
    asm volatile("" : "+v"(negm));
    if (!FIRST) { f = __builtin_amdgcn_exp2f(-dl); l_reg *= f; resc = true; }
  }
#pragma unroll
  for (int r = 0; r < 16; ++r) p0[r] = __builtin_amdgcn_exp2f(p0[r]);
}
#define ATT_WAIT(N) asm volatile("s_waitcnt vmcnt(" #N ")" ::: "memory")
__device__ __forceinline__ void attn_unit(const bf16_t* __restrict__ Qb, const bf16_t* __restrict__ Kh, const bf16_t* __restrict__ Vh, bf16_t* __restrict__ Ob, LAS char* lds, int tid) {
  constexpr int NT = NT_ATT; static_assert(NT % 2 == 1 && NT >= 7, "odd tile count");
  const int wid = __builtin_amdgcn_readfirstlane(tid >> 6), lane = tid & 63, r32 = lane & 31, hi = lane >> 5;
  LAS float* ws = (LAS float*)(lds + LDS_WS) + wid * 64; LAS float* li_l = ws; LAS float* al_l = ws + 32;
  float mhat = 0.f, l_reg = 0.f; f32x16 o[4] = {}; f32x16 negm = {}; bf16x8 qr[8];
  asm volatile("" : "+v"(negm));
  unsigned koff[2], voff[2];
#pragma unroll
  for (int i = 0; i < 2; ++i) { const int p = 2 * wid + i;
    { const int row = 4 * p + (lane >> 4), cpos = lane & 15; koff[i] = (unsigned)(row * 256 + ((cpos ^ (row & 7)) << 4)); }
    { const int st = 2 * p + (lane >> 5), kk = (st >> 2) * 8 + ((lane & 31) >> 2), c = (st & 3) * 32 + (lane & 3) * 8; const int k = (kk & ~0xC) | ((kk & 4) << 1) | ((kk & 8) >> 1); voff[i] = (unsigned)(k * 256 + c * 2); } }
#define DMA_T(t, kso, vso) do { const char* kt_ = (const char*)Kh + (size_t)(t) * KSLOT; const char* vt_ = (const char*)Vh + (size_t)(t) * KSLOT; \
    _Pragma("unroll") for (int i_ = 0; i_ < 2; ++i_) { \
      __builtin_amdgcn_global_load_lds((const unsigned*)(kt_ + koff[i_]), (LAS unsigned*)(lds + LDS_K + (kso) + (2 * wid + i_) * 1024), 16, 0, 0); \
      __builtin_amdgcn_global_load_lds((const unsigned*)(vt_ + voff[i_]), (LAS unsigned*)(lds + LDS_V + (vso) + (2 * wid + i_) * 1024), 16, 0, 0); } } while (0)
  { const unsigned qoff = (unsigned)((wid * QBLK + r32) * LDQ + hi * 8) * 2u;
#pragma unroll
    for (int d0 = 0; d0 < 8; ++d0) qr[d0] = *reinterpret_cast<const bf16x8*>((const char*)Qb + qoff + d0 * 32); }
  DMA_T(0, 0, 0); DMA_T(1, KSLOT, KSLOT);
  int kb[4];
#pragma unroll
  for (int i = 0; i < 4; ++i) kb[i] = (int)(unsigned)(uintptr_t)(lds + LDS_K) + r32 * 256 + ((i * 32 + hi * 16) ^ ((r32 & 7) << 4));
  const int vb0 = (int)(unsigned)(uintptr_t)(lds + LDS_V) + v_rd_base(lane);
#define RESC() do { if (resc) { if (hi == 0) al_l[r32] = fsc; asm volatile("s_waitcnt lgkmcnt(0)" ::: "memory"); \
    _Pragma("unroll") for (int d = 0; d < 4; ++d) _Pragma("unroll") for (int r = 0; r < 16; ++r) o[d][r] *= al_l[crow(r, hi)]; } } while (0)
  f32x16 pA0, pA1, pB0, pB1; bf16x8 pa0, pa1, pa2, pa3; bool resc; float fsc;
  int kcur = 0, kiss = 2 * KSLOT, vprev = 0, viss = 2 * KSLOT;
#define KB_SET() do { } while (0)
#define ROT() do { { const int dk_ = (kcur == 2 * KSLOT) ? -2 * KSLOT : KSLOT; _Pragma("unroll") for (int i_ = 0; i_ < 4; ++i_) kb[i_] += dk_; } kcur = (kcur == 2 * KSLOT) ? 0 : kcur + KSLOT; kiss = (kiss == 2 * KSLOT) ? 0 : kiss + KSLOT; viss = (viss == 3 * KSLOT) ? 0 : viss + KSLOT; } while (0)
  ATT_WAIT(4); __builtin_amdgcn_s_barrier(); asm volatile("" ::: "memory");
  DMA_T(2, kiss, viss);
  KB_SET(); qkt(pA0, pA1, kb, qr, negm);
#pragma unroll
  for (int r = 8; r < 16; ++r) pA0[r] = -1e30f;
#pragma unroll
  for (int r = 0; r < 16; ++r) pA1[r] = -1e30f;
  startSM<true>(pA0, pA1, mhat, l_reg, negm, resc, fsc);
  ROT();
#define STEP(X0, X1, Y0, Y1, tt, ISSUE, WN) do { \
    ATT_WAIT(WN); __builtin_amdgcn_s_barrier(); asm volatile("" ::: "memory"); \
    if (ISSUE) DMA_T((tt) + 2, kiss, viss); \
    KB_SET(); qkt(X0, X1, kb, qr, negm); \
    finishSM(Y0, Y1, l_reg, pa0, pa1, pa2, pa3); \
    pv_d0(o, vb0 + vprev, pa0, pa1, pa2, pa3); startSM<false>(X0, X1, mhat, l_reg, negm, resc, fsc); \
    RESC(); vprev = (vprev == 3 * KSLOT) ? 0 : vprev + KSLOT; ROT(); } while (0)
  for (int t = 1; t + 3 < NT; t += 2) {
    STEP(pB0, pB1, pA0, pA1, t, true, 4);
    STEP(pA0, pA1, pB0, pB1, t + 1, true, 4);
  }
  STEP(pB0, pB1, pA0, pA1, NT - 2, false, 4);
  STEP(pA0, pA1, pB0, pB1, NT - 1, false, 0);
  finishSM(pA0, pA1, l_reg, pa0, pa1, pa2, pa3);
  pv_d0(o, vb0 + vprev, pa0, pa1, pa2, pa3);
  { auto rr = __builtin_amdgcn_permlane32_swap(__float_as_uint(l_reg), __float_as_uint(l_reg), false, false); l_reg = __uint_as_float(rr[0]) + __uint_as_float(rr[1]); }
  if (hi == 0) li_l[r32] = l_reg; asm volatile("s_waitcnt lgkmcnt(0)" ::: "memory");
  float rli[16];
#pragma unroll
  for (int r = 0; r < 16; ++r) rli[r] = __builtin_amdgcn_rcpf(li_l[crow(r, hi)]);
  asm volatile("s_waitcnt lgkmcnt(0)" ::: "memory"); __builtin_amdgcn_s_barrier(); asm volatile("" ::: "memory");
  LAS bf16_t* stg = (LAS bf16_t*)(lds + wid * 8192);
#pragma unroll
  for (int r = 0; r < 16; ++r) { const int orow = crow(r, hi);
#pragma unroll
    for (int d0 = 0; d0 < 4; ++d0) stg[orow * 128 + d0 * 32 + r32] = (bf16_t)(cvtpk(o[d0][r] * rli[r], 0.f) & 0xffffu); }
  asm volatile("s_waitcnt lgkmcnt(0)" ::: "memory");
#pragma unroll
  for (int i = 0; i < 8; ++i) { const int row = i * 4 + (lane >> 4), ch = lane & 15; const u32x4 v = *(const LAS u32x4*)(stg + row * 128 + ch * 8);
    *(u32x4*)((char*)Ob + (size_t)(wid * QBLK + row) * (LDO * 2) + ch * 16) = v; }
  asm volatile("s_waitcnt lgkmcnt(0)" ::: "memory"); __builtin_amdgcn_s_barrier(); asm volatile("" ::: "memory");
#undef DMA_T
#undef RESC
#undef ROT
#undef KB_SET
#undef STEP
}
#undef ATT_WAIT
#undef SBAR
#undef V_WAIT
#undef K_WAIT
}

namespace att8 {
typedef int v8i __attribute__((ext_vector_type(8)));
constexpr int QBLK = 32, KS8 = 8192, NKS = 3, NVS = 6, L_K = 0, L_V = NKS * KS8, L_WS = 73728;
constexpr float THRL = 8.f;
__device__ __forceinline__ int crow(int r, int hi) { return (r & 3) + 8 * (r >> 2) + 4 * hi; }
struct F8 { u32x4 lo, hi; };
template <int IMM> __device__ __forceinline__ void f_read(F8& f, int a0, int a1) {
  asm volatile("ds_read_b128 %0, %1 offset:%2" : "=&v"(f.lo) : "v"(a0), "i"(IMM) : "memory");
  asm volatile("ds_read_b128 %0, %1 offset:%2" : "=&v"(f.hi) : "v"(a1), "i"(IMM) : "memory");
}
#define F_WAIT(N, f) asm volatile("s_waitcnt lgkmcnt(" #N ")" : "+v"(f.lo), "+v"(f.hi))
struct F6 { u32x4 lo; u32x2 hi; };
template <int IMM> __device__ __forceinline__ void f_read6(F6& f, int ah, int at) {
  asm volatile("ds_read_b128 %0, %1 offset:%2" : "=&v"(f.lo) : "v"(ah), "i"(IMM) : "memory");
  asm volatile("ds_read_b64 %0, %1 offset:%2" : "=&v"(f.hi) : "v"(at), "i"(IMM) : "memory");
}
__device__ __forceinline__ v8i f6_vec(const F6& f) { v8i r; r[0] = (int)f.lo.x; r[1] = (int)f.lo.y; r[2] = (int)f.lo.z; r[3] = (int)f.lo.w; r[4] = (int)f.hi.x; r[5] = (int)f.hi.y; r[6] = (int)f.hi.x; r[7] = (int)f.hi.y; return r; }
#define MMA6K(a, b, c, sa, sb) __builtin_amdgcn_mfma_scale_f32_32x32x64_f8f6f4(a, b, c, 2, 2, 0, sa, 0, sb)
#define F_WAIT2(N, f, g) asm volatile("s_waitcnt lgkmcnt(" #N ")" : "+v"(f.lo), "+v"(f.hi), "+v"(g.lo), "+v"(g.hi))
#define K_WAIT2(N, f, g) asm volatile("s_waitcnt lgkmcnt(" #N ")" : "+v"(f.lo), "+v"(f.hi), "+v"(g.lo), "+v"(g.hi))
__device__ __forceinline__ v8i f_vec(const F8& f) { return (v8i){(int)f.lo.x, (int)f.lo.y, (int)f.lo.z, (int)f.lo.w, (int)f.hi.x, (int)f.hi.y, (int)f.hi.z, (int)f.hi.w}; }
#define MMA8(a, b, c, sa, sb) __builtin_amdgcn_mfma_scale_f32_32x32x64_f8f6f4(a, b, c, 0, 0, 0, sa, 0, sb)
constexpr int S1 = 0x7f7f7f7f, S8 = 0x7c7c7c7c;
__device__ __forceinline__ v8i ld32(int a0, int a1, int imm) { const u32x4 lo = *(const LAS u32x4*)(uintptr_t)(unsigned)(a0 + imm), hh = *(const LAS u32x4*)(uintptr_t)(unsigned)(a1 + imm);
  return (v8i){(int)lo.x, (int)lo.y, (int)lo.z, (int)lo.w, (int)hh.x, (int)hh.y, (int)hh.z, (int)hh.w}; }
#define MFENCE() asm volatile("" ::: "memory")
__device__ __forceinline__ void qkt(f32x16& p0, f32x16& p1, int kb0, const v8i* qr, const f32x16& negm) {
  v8i a = ld32(kb0, kb0 ^ 16, 0), b = ld32(kb0, kb0 ^ 16, 4096); MFENCE();
  p0 = MMA8(a, qr[0], negm, S1, S8); p1 = MMA8(b, qr[0], negm, S1, S8);
  a = ld32(kb0 ^ 64, kb0 ^ 80, 0); b = ld32(kb0 ^ 64, kb0 ^ 80, 4096); MFENCE();
  p0 = MMA8(a, qr[1], p0, S1, S8); p1 = MMA8(b, qr[1], p1, S1, S8);
}
struct F2 { v8i a, b; };
__device__ __forceinline__ void v_read01(F2& v, int vo0) { v.a = ld32(vo0, vo0 ^ 16, 0); v.b = ld32(vo0, vo0 ^ 16, 2048); MFENCE(); }
__device__ __forceinline__ void pv(f32x16* o, f32x16& ol, const v8i& ones, F2& v, int vo0, const v8i& pa) {
  o[0] = MMA8(pa, v.a, o[0], S1, S1); o[1] = MMA8(pa, v.b, o[1], S1, S1);
  v.a = ld32(vo0, vo0 ^ 16, 4096); v.b = ld32(vo0, vo0 ^ 16, 6144); MFENCE();
  o[2] = MMA8(pa, v.a, o[2], S1, S1); o[3] = MMA8(pa, v.b, o[3], S1, S1);
  ol = MMA8(pa, ones, ol, S1, S1);
}
__device__ __forceinline__ void finishSM(f32x16& p0, f32x16& p1, float& l_reg, v8i& pa) {
#pragma unroll
  for (int r = 0; r < 16; ++r) p1[r] = __builtin_amdgcn_exp2f(p1[r]);
  float ps = 0;
#pragma unroll
  for (int r = 0; r < 16; ++r) ps += p0[r];
#pragma unroll
  for (int r = 0; r < 16; ++r) ps += p1[r];
  l_reg += ps;
#pragma unroll
  for (int i = 0; i < 4; ++i) { const unsigned a = pk4_fp8(p0[4 * i], p0[4 * i + 1], p0[4 * i + 2], p0[4 * i + 3]), b = pk4_fp8(p1[4 * i], p1[4 * i + 1], p1[4 * i + 2], p1[4 * i + 3]);
    auto rr = __builtin_amdgcn_permlane32_swap(a, b, false, false); pa[i] = (int)rr[0]; pa[4 + i] = (int)rr[1]; }
}
__device__ __forceinline__ float max3f(float a, float b, float c) { float r; asm("v_max3_f32 %0, %1, %2, %3" : "=v"(r) : "v"(a), "v"(b), "v"(c)); return r; }
__device__ __forceinline__ float rowmax(const f32x16& p0, const f32x16& p1) {
  float a = max3f(p0[0], p0[1], p1[0]), b = max3f(p0[2], p0[3], p1[1]);
#pragma unroll
  for (int r = 4; r < 16; r += 4) { a = max3f(a, p0[r], p0[r + 1]); b = max3f(b, p0[r + 2], p0[r + 3]); }
#pragma unroll
  for (int r = 2; r < 14; r += 4) { a = max3f(a, p1[r], p1[r + 1]); b = max3f(b, p1[r + 2], p1[r + 3]); }
  a = max3f(a, p1[14], p1[15]);
  float rm; asm("v_max_f32 %0, %1, %2" : "=v"(rm) : "v"(a), "v"(b));
  return rm;
}
__device__ __forceinline__ float rowmax_full(float rm) {
  auto rr = __builtin_amdgcn_permlane32_swap(__float_as_uint(rm), __float_as_uint(rm), false, false); float o_; asm("v_max_f32 %0, %1, %2" : "=v"(o_) : "v"(__uint_as_float(rr[0])), "v"(__uint_as_float(rr[1]))); return o_;
}
__device__ __forceinline__ void exp_all(f32x16& p0, f32x16& p1) {
#pragma unroll
  for (int r = 0; r < 16; ++r) { p0[r] = __builtin_amdgcn_exp2f(p0[r]); p1[r] = __builtin_amdgcn_exp2f(p1[r]); }
}
__device__ __forceinline__ void pack_p(const f32x16& p0, const f32x16& p1, v8i& pa) {
#pragma unroll
  for (int i = 0; i < 4; ++i) {
    int w = __builtin_amdgcn_cvt_pk_fp8_f32(p0[4 * i], p0[4 * i + 1], pa[i], false); pa[i] = __builtin_amdgcn_cvt_pk_fp8_f32(p0[4 * i + 2], p0[4 * i + 3], w, true);
    int x = __builtin_amdgcn_cvt_pk_fp8_f32(p1[4 * i], p1[4 * i + 1], pa[4 + i], false); pa[4 + i] = __builtin_amdgcn_cvt_pk_fp8_f32(p1[4 * i + 2], p1[4 * i + 3], x, true); }
}
template <bool FIRST>
__device__ __forceinline__ void startSM(f32x16& p0, f32x16& p1, float& mhat, float& l_reg, f32x16& negm, bool& resc, float& f) {
  float a = __builtin_fmaxf(__builtin_fmaxf(p0[0], p0[1]), p1[0]), b = __builtin_fmaxf(__builtin_fmaxf(p0[2], p0[3]), p1[1]); a = __builtin_fmaxf(__builtin_fmaxf(a, p1[2]), p1[3]);
#pragma unroll
  for (int r = 4; r < 16; r += 4) { a = __builtin_fmaxf(__builtin_fmaxf(a, p0[r]), p0[r + 1]); b = __builtin_fmaxf(__builtin_fmaxf(b, p0[r + 2]), p0[r + 3]);
    a = __builtin_fmaxf(__builtin_fmaxf(a, p1[r]), p1[r + 1]); b = __builtin_fmaxf(__builtin_fmaxf(b, p1[r + 2]), p1[r + 3]); }
  float rm = __builtin_fmaxf(a, b);
  { auto rr = __builtin_amdgcn_permlane32_swap(__float_as_uint(rm), __float_as_uint(rm), false, false); rm = __builtin_fmaxf(__uint_as_float(rr[0]), __uint_as_float(rr[1])); }
  resc = false; f = 1.f;
  if (FIRST || __builtin_expect(__any(rm > THRL), 0)) {
    const float dl = FIRST ? rm : __builtin_fmaxf(rm, 0.f); mhat += dl;
#pragma unroll
    for (int r = 0; r < 16; ++r) { p0[r] -= dl; p1[r] -= dl; }
#pragma unroll
    for (int r = 0; r < 16; ++r) negm[r] = -mhat;
    asm volatile("" : "+v"(negm));
    if (!FIRST) { f = __builtin_amdgcn_exp2f(-dl); l_reg *= f; resc = true; }
  }
#pragma unroll
  for (int r = 0; r < 16; ++r) p0[r] = __builtin_amdgcn_exp2f(p0[r]);
}
#define ATT_WAIT(N) asm volatile("s_waitcnt vmcnt(" #N ")" ::: "memory")
__device__ __forceinline__ void attn_unit(const unsigned char* __restrict__ Q8b, const unsigned char* __restrict__ K8h, const unsigned char* __restrict__ V8h, bf16_t* __restrict__ Ob, int ldo, LAS char* lds, int tid) {
  constexpr int NT = NT_ATT; static_assert(NT % 2 == 1 && NT >= 7, "odd tile count");
  int lane = tid & 63; asm volatile("" : "+v"(lane));
  const int wid = __builtin_amdgcn_readfirstlane(tid >> 6), r32 = lane & 31, hi = lane >> 5;
  LAS float* ws = (LAS float*)(lds + L_WS) + wid * 64; LAS float* li_l = ws; LAS float* al_l = ws + 32;
  float zz = 0.f; asm volatile("" : "+v"(zz));
  float mhat = 0.f, l_reg = 0.f; f32x16 o[4]; f32x16 ol; f32x16 negm; v8i qr[2];
#pragma unroll
  for (int r = 0; r < 16; ++r) { negm[r] = zz; ol[r] = zz; o[0][r] = zz; o[1][r] = zz; o[2][r] = zz; o[3][r] = zz; }
  v8i ones; { int c38 = 0x38383838; asm volatile("" : "+v"(c38)); ones = (v8i){c38, c38, c38, c38, c38, c38, c38, c38}; }
  asm volatile("" : "+v"(negm));
  unsigned koff, voff;
  { const int row = 8 * wid + (lane >> 3), cpos = lane & 7; koff = (unsigned)(row * 128 + ((cpos ^ ((row >> 1) & 7)) << 4)); }
  { const int drow = 16 * wid + (lane >> 2), cpos = lane & 3; voff = (unsigned)(drow * 64 + ((cpos ^ ((drow >> 2) & 3)) << 4)); }
  const char* kp_ = (const char*)K8h + koff; const char* vp_ = (const char*)V8h + voff;
#define DMA_T(t, kso, vso) do { \
      __builtin_amdgcn_global_load_lds((const unsigned*)kp_, (LAS unsigned*)(lds + L_K + (kso) + wid * 1024), 16, 0, 0); \
      __builtin_amdgcn_global_load_lds((const unsigned*)vp_, (LAS unsigned*)(lds + L_V + (vso) + wid * 1024), 16, 0, 0); \
      kp_ += KS8; vp_ += KS8; asm volatile("" : "+v"(kp_), "+v"(vp_)); } while (0)
  { const unsigned qoff = (unsigned)((wid * QBLK + r32) * ATTW);
#pragma unroll
    for (int s = 0; s < 2; ++s) { const int b = 2 * s + hi; const u32x4 lo = *reinterpret_cast<const u32x4*>((const char*)Q8b + qoff + 16 * b); const u32x2 hh = *reinterpret_cast<const u32x2*>((const char*)Q8b + qoff + 64 + 8 * b);
      qr[s] = (v8i){(int)lo.x, (int)lo.y, (int)lo.z, (int)lo.w, (int)hh.x, (int)hh.y, (int)hh.x, (int)hh.y}; } }
  DMA_T(0, 0, 0); DMA_T(1, KS8, KS8);
  int kb, vo;
  kb = (int)(unsigned)(uintptr_t)(lds + L_K) + r32 * 128 + ((hi ^ ((r32 >> 1) & 7)) << 4);
  const int kt = (int)(unsigned)(uintptr_t)(lds + L_K) + r32 * 128 + ((4 ^ ((r32 >> 1) & 7)) << 4) + 8 * hi;
  vo = (int)(unsigned)(uintptr_t)(lds + L_V) + r32 * 64 + (((2 * hi) ^ ((r32 >> 2) & 3)) << 4);
#define RESC() do { if (resc) { if (hi == 0) al_l[r32] = fsc; asm volatile("s_waitcnt lgkmcnt(0)" ::: "memory"); \
    _Pragma("unroll") for (int r = 0; r < 16; ++r) { const float a_ = al_l[crow(r, hi)]; ol[r] *= a_; _Pragma("unroll") for (int d = 0; d < 4; ++d) o[d][r] *= a_; } } } while (0)
  f32x16 pA0, pA1; v8i pa; bool resc; float fsc; F8 fa0, fa1, fb0, fb1; F6 ka0, ka1, kc0, kc1;
  { int z8 = 0; asm volatile("" : "+v"(z8)); pa = (v8i){z8, z8, z8, z8, z8, z8, z8, z8}; }
#define MASK0() do { _Pragma("unroll") for (int r = 8; r < 16; ++r) pA0[r] = -1e30f; _Pragma("unroll") for (int r = 0; r < 16; ++r) pA1[r] = -1e30f; } while (0)
#define BAR_S() asm volatile("s_barrier" : "+v"(pA0), "+v"(pA1) :: "memory")
#define BAR_M(WN) asm volatile("s_waitcnt vmcnt(" #WN ")\n\ts_barrier" : "+v"(pA0), "+v"(pA1), "+v"(o[0]), "+v"(o[1]), "+v"(o[2]), "+v"(o[3]), "+v"(ol) :: "memory")
#define STEPS(S6, SS, ISSUE, WN, HASQK, HASPV, HASSM, FIRST_) do { \
      constexpr int KO_ = ((S6) % 3) * KS8, VO_ = (((S6) + 5) % 6) * KS8; \
      BAR_S(); \
      if (ISSUE) { DMA_T((SS) + 2, (((S6) + 2) % 3) * KS8, (((S6) + 2) % 6) * KS8); } \
      if (HASQK) { f_read6<KO_>(ka0, kb, kt); f_read6<KO_ + 4096>(ka1, kb, kt); f_read6<KO_>(kc0, kb32, kt16); f_read6<KO_ + 4096>(kc1, kb32, kt16); } \
      if (HASPV) pack_p(pA0, pA1, pa);            \
      if ((HASQK) && (HASPV)) {                   \
        K_WAIT2(4, ka0, ka1); pA0 = MMA6K(f6_vec(ka0), qr[0], negm, S1, S8); pA1 = MMA6K(f6_vec(ka1), qr[0], negm, S1, S8); \
        f_read<VO_>(fa0, vo, vo16); f_read<VO_ + 2048>(fa1, vo, vo16); \
        K_WAIT2(4, kc0, kc1); pA0 = MMA6K(f6_vec(kc0), qr[1], pA0, S1, S8); pA1 = MMA6K(f6_vec(kc1), qr[1], pA1, S1, S8); \
        f_read<VO_ + 4096>(fb0, vo, vo16); f_read<VO_ + 6144>(fb1, vo, vo16); \
        F_WAIT2(4, fa0, fa1); o[0] = MMA8(pa, f_vec(fa0), o[0], S1, S1); o[1] = MMA8(pa, f_vec(fa1), o[1], S1, S1); \
        F_WAIT2(0, fb0, fb1); o[2] = MMA8(pa, f_vec(fb0), o[2], S1, S1); o[3] = MMA8(pa, f_vec(fb1), o[3], S1, S1); ol = MMA8(pa, ones, ol, S1, S1); \
      } else if (HASQK) { \
        K_WAIT2(4, ka0, ka1); pA0 = MMA6K(f6_vec(ka0), qr[0], negm, S1, S8); pA1 = MMA6K(f6_vec(ka1), qr[0], negm, S1, S8); \
        K_WAIT2(0, kc0, kc1); pA0 = MMA6K(f6_vec(kc0), qr[1], pA0, S1, S8); pA1 = MMA6K(f6_vec(kc1), qr[1], pA1, S1, S8); \
      } else if (HASPV) { \
        f_read<VO_>(fa0, vo, vo16); f_read<VO_ + 2048>(fa1, vo, vo16); f_read<VO_ + 4096>(fb0, vo, vo16); f_read<VO_ + 6144>(fb1, vo, vo16); \
        F_WAIT2(4, fa0, fa1); o[0] = MMA8(pa, f_vec(fa0), o[0], S1, S1); o[1] = MMA8(pa, f_vec(fa1), o[1], S1, S1); \
        F_WAIT2(0, fb0, fb1); o[2] = MMA8(pa, f_vec(fb0), o[2], S1, S1); o[3] = MMA8(pa, f_vec(fb1), o[3], S1, S1); ol = MMA8(pa, ones, ol, S1, S1); } \
      BAR_M(WN); \
      if (HASSM) { if (FIRST_) MASK0(); \
        const float rm_ = rowmax(pA0, pA1); \
        exp_all(pA0, pA1); \
        resc = false; \
        if ((FIRST_) || __builtin_expect(__any(rm_ > THRL), 0)) { const float rmf_ = rowmax_full(rm_); const float dl = (FIRST_) ? rmf_ : __builtin_fmaxf(rmf_, 0.f); mhat += dl; const float f_ = __builtin_amdgcn_exp2f(-dl); \
          _Pragma("unroll") for (int r = 0; r < 16; ++r) { pA0[r] *= f_; pA1[r] *= f_; } \
          _Pragma("unroll") for (int r = 0; r < 16; ++r) negm[r] = -mhat; \
          asm volatile("" : "+v"(negm)); \
          if (!(FIRST_)) { fsc = f_; resc = true; RESC(); } } \
        } } while (0)
  const int kb32 = kb ^ 32, kt16 = kt ^ 16, vo16 = vo ^ 16;
  ATT_WAIT(2);
  if (wid >= 4) asm volatile("s_barrier" ::: "memory");
  STEPS(0, 0, true, 2, true, false, true, true);
  asm volatile(".p2align 8\ns_nop 0\ns_nop 0\ns_nop 0\ns_nop 0");
  static_assert((NT - 3) % 6 == 2 && NT >= 12, "steps 1 .. NT-5 in groups of six, then NT-4 .. NT");
  for (int t = 1; t + 4 < NT; t += 6) {
    STEPS(1, t, true, 2, true, true, true, false); STEPS(2, t + 1, true, 2, true, true, true, false); STEPS(3, t + 2, true, 2, true, true, true, false);
    STEPS(4, t + 3, true, 2, true, true, true, false); STEPS(5, t + 4, true, 2, true, true, true, false); STEPS(0, t + 5, true, 2, true, true, true, false);
  }
  STEPS((NT - 4) % 6, NT - 4, true, 2, true, true, true, false);
  STEPS((NT - 3) % 6, NT - 3, true, 2, true, true, true, false);
  STEPS((NT - 2) % 6, NT - 2, false, 0, true, true, true, false);
  STEPS((NT - 1) % 6, NT - 1, false, 0, true, true, true, false);
  STEPS(NT % 6, NT, false, 0, false, true, false, false);
  if (wid < 4) asm volatile("s_barrier" ::: "memory");
#undef STEPS
#undef BAR_S
#undef BAR_M
  { const int le = fresh_lane(), r32e = le & 31, hie = le >> 5;
  float rli[16];
#pragma unroll
  for (int r = 0; r < 16; ++r) rli[r] = __builtin_amdgcn_rcpf(ol[r]);
  (void)li_l; (void)hie; (void)l_reg;
  asm volatile("s_waitcnt lgkmcnt(0)" ::: "memory"); __builtin_amdgcn_s_barrier(); asm volatile("" ::: "memory");
  LAS bf16_t* stg = (LAS bf16_t*)(lds + wid * 8192);
#pragma unroll
  for (int r = 0; r < 16; ++r) { const int orow = crow(r, hie);
#pragma unroll
    for (int d0 = 0; d0 < 4; ++d0) stg[orow * 128 + d0 * 32 + r32e] = (bf16_t)(cvt_pk_bf16(o[d0][r] * rli[r], 0.f) & 0xffffu); }
  asm volatile("s_waitcnt lgkmcnt(0)" ::: "memory");
#pragma unroll
  for (int i = 0; i < 8; ++i) { const int row = i * 4 + (le >> 4), ch = le & 15; const u32x4 v = *(const LAS u32x4*)(stg + row * 128 + ch * 8);
    *(u32x4*)((char*)Ob + (size_t)(wid * QBLK + row) * ((size_t)ldo * 2) + ch * 16) = v; }
  asm volatile("s_waitcnt lgkmcnt(0)" ::: "memory"); __builtin_amdgcn_s_barrier(); asm volatile("" ::: "memory"); }
#undef DMA_T
#undef RESC
#undef MASK0
}
#undef ATT_WAIT
#undef F_WAIT
#undef F_WAIT2
#undef K_WAIT2
#undef MMA6K
#undef MFENCE
#undef MMA8
}

__device__ __forceinline__ void p1_zmeta(const Args& A, int cb, int tid) {
    const int o = tid >> 4, part = tid & 15, ch = cb * 4 + (o & 3), r = o >> 2, g = ch >> 8, d = ch & 255;
    const float* pm = (const float*)(A.ws + WS_PMETA) + (size_t)(8 + r) * POOLW + g * 256 + part * 16; const float* pw = A.pool_w + (size_t)g * 65536 + (size_t)(part * 16) * 256 + d;
    float wv[16]; f32x4 pv4[4];
#pragma unroll
    for (int u = 0; u < 16; ++u) wv[u] = pw[(size_t)u * 256];
#pragma unroll
    for (int q = 0; q < 4; ++q) pv4[q] = ((const f32x4*)pm)[q];
    float acc = 0.f;
#pragma unroll
    for (int q = 0; q < 4; ++q) acc += (pv4[q].x * wv[4 * q] + pv4[q].y * wv[4 * q + 1]) + (pv4[q].z * wv[4 * q + 2] + pv4[q].w * wv[4 * q + 3]);
    acc += __shfl_xor(acc, 1); acc += __shfl_xor(acc, 2); acc += __shfl_xor(acc, 4); acc += __shfl_xor(acc, 8);
    if (part == 0) ((float*)(A.ws + WS_ZM))[r * 1024 + ch] = acc * A.pool_scale[ch];
}
template <int HW> __device__ __forceinline__ void pool_item(const bf16_t* __restrict__ Zb, const float* __restrict__ Zm, bf16_t* __restrict__ Mb, int s) {
    u32x4 w[2 * HW];
#pragma unroll
    for (int k = 0; k < 2 * HW; ++k) { int sp = s - HW + k; sp = sp < 0 ? 0 : (sp > SEQ - 1 ? SEQ - 1 : sp); w[k] = *(const u32x4*)(Zb + (size_t)sp * POOLW); }
    float sum[8], self[8];
#pragma unroll
    for (int e = 0; e < 8; ++e) { sum[e] = 0.f; self[e] = 0.f; }
#pragma unroll
    for (int k = 0; k < 2 * HW; ++k) { const int sp = s - HW + k; float zv[8];
        zv[0] = bf_lo(w[k].x); zv[1] = bf_hi(w[k].x); zv[2] = bf_lo(w[k].y); zv[3] = bf_hi(w[k].y); zv[4] = bf_lo(w[k].z); zv[5] = bf_hi(w[k].z); zv[6] = bf_lo(w[k].w); zv[7] = bf_hi(w[k].w);
        if (sp < 0) {
#pragma unroll
            for (int e = 0; e < 8; ++e) zv[e] = Zm[(sp + 8) * 1024 + e]; }
        const float m = (sp < SEQ) ? 1.f : 0.f;
#pragma unroll
        for (int e = 0; e < 8; ++e) { sum[e] += zv[e] * m; if (k == HW) self[e] = zv[e]; } }
    const int hiE = (s + HW < SEQ) ? s + HW : SEQ; const float inv = 1.0f / (float)(hiE - (s - HW));
    u32x4 o; o.x = cvt_pk_bf16(sum[0] * inv - self[0], sum[1] * inv - self[1]); o.y = cvt_pk_bf16(sum[2] * inv - self[2], sum[3] * inv - self[3]);
    o.z = cvt_pk_bf16(sum[4] * inv - self[4], sum[5] * inv - self[5]); o.w = cvt_pk_bf16(sum[6] * inv - self[6], sum[7] * inv - self[7]);
    *(u32x4*)(Mb + (size_t)s * DM) = o;
}
__device__ __forceinline__ void p2_pool_block(const Args& A, LAS unsigned char* lds, int rb, int tid) {
    const float* Zm = (const float*)(A.ws + WS_ZM);
    const int b = rb >> 7, s0 = (rb & 127) * 128;
    const bf16_t* Z = (const bf16_t*)(A.ws + WS_Z); bf16_t* MIX = (bf16_t*)(A.ws + WS_MIX);
    { const int w = tid >> 6, l = tid & 63, sb = s0 + w * 16 + (l >> 5);
      const bf16_t* __restrict__ Zb = Z + (size_t)b * SEQ * POOLW + (l & 31) * 8; bf16_t* __restrict__ Mb = MIX + (size_t)b * SEQ * DM + ATTW + (l & 31) * 8; const float* Zmc = Zm + (l & 31) * 8;
#pragma unroll 2
      for (int it = 0; it < 8; ++it) pool_item<1>(Zb, Zmc, Mb, sb + 2 * it);
#pragma unroll 2
      for (int it = 0; it < 8; ++it) pool_item<2>(Zb + 256, Zmc + 256, Mb + 256, sb + 2 * it);
#pragma unroll 2
      for (int it = 0; it < 8; ++it) pool_item<4>(Zb + 512, Zmc + 512, Mb + 512, sb + 2 * it);
#pragma unroll 2
      for (int it = 0; it < 8; ++it) pool_item<8>(Zb + 768, Zmc + 768, Mb + 768, sb + 2 * it); }
    __syncthreads();
}

__device__ __forceinline__ void p4_block(const Args& A, LAS unsigned char* lds, int jb, int tid, int lane, int wave) {
    LAS float* Lg = (LAS float*)(lds + wave * 3072);
    LAS unsigned* cntL = (LAS unsigned*)(lds + 32768);
    LAS unsigned* baseL = cntL + 64;
    if (tid < 64) cntL[tid] = 0u;
    __syncthreads();
    const int fr = lane & 15, fq = lane >> 4, row = jb * 128 + wave * 16 + fr;
    const float* ssp = (const float*)(A.ws + WS_SSP); const float* h1 = A.out + (size_t)row * DM;
    bf16_t* BN = (bf16_t*)(A.ws + WS_XN) + (size_t)row * DM; const u32x4* wrf = (const u32x4*)(A.ws + WS_WRF);
    float ss; { const f32x4 a = *(const f32x4*)(ssp + (size_t)row * 32 + 8 * fq), b = *(const f32x4*)(ssp + (size_t)row * 32 + 8 * fq + 4); ss = ((a.x + a.y) + (a.z + a.w)) + ((b.x + b.y) + (b.z + b.w)); }
    ss += __shfl_xor(ss, 16); ss += __shfl_xor(ss, 32);
    const float rstd = 1.0f / sqrtf(ss * (1.f / DM) + EPS);
    f32x4 lacc[3] = {(f32x4){0.f, 0.f, 0.f, 0.f}, (f32x4){0.f, 0.f, 0.f, 0.f}, (f32x4){0.f, 0.f, 0.f, 0.f}};
#pragma unroll 2
    for (int ks = 0; ks < 64; ++ks) { const int k = 32 * ks + 8 * fq;
        const f32x4 xa = *(const f32x4*)(h1 + k) * rstd, xb = *(const f32x4*)(h1 + k + 4) * rstd;
        const u32x4 hw = pack8(xa, xb);
        *(u32x4*)(BN + k) = hw;
        u32x4 lw; lw.x = cvt_pk_bf16(xa.x - bf_lo(hw.x), xa.y - bf_hi(hw.x)); lw.y = cvt_pk_bf16(xa.z - bf_lo(hw.y), xa.w - bf_hi(hw.y));
        lw.z = cvt_pk_bf16(xb.x - bf_lo(hw.z), xb.y - bf_hi(hw.z)); lw.w = cvt_pk_bf16(xb.z - bf_lo(hw.w), xb.w - bf_hi(hw.w));
        const bf16x8 bh = __builtin_bit_cast(bf16x8, hw), bl = __builtin_bit_cast(bf16x8, lw);
#pragma unroll
        for (int blk = 0; blk < 3; ++blk) { const bf16x8 wh = __builtin_bit_cast(bf16x8, wrf[(size_t)((ks * 3 + blk) * 2 + 0) * 64 + lane]), wl = __builtin_bit_cast(bf16x8, wrf[(size_t)((ks * 3 + blk) * 2 + 1) * 64 + lane]);
            lacc[blk] = __builtin_amdgcn_mfma_f32_16x16x32_bf16(wh, bh, lacc[blk], 0, 0, 0);
            lacc[blk] = __builtin_amdgcn_mfma_f32_16x16x32_bf16(wl, bh, lacc[blk], 0, 0, 0);
            lacc[blk] = __builtin_amdgcn_mfma_f32_16x16x32_bf16(wh, bl, lacc[blk], 0, 0, 0); } }
#pragma unroll
    for (int blk = 0; blk < 3; ++blk)
#pragma unroll
        for (int j = 0; j < 4; ++j) Lg[fr * 48 + 16 * blk + 4 * fq + j] = lacc[blk][j];
    LDS_WAIT(); asm volatile("" ::: "memory");
    int e0 = 0, e1 = 0; float g0 = 0.f, g1 = 0.f; unsigned rk0 = 0u, rk1 = 0u;
    if (lane < 16) {
        float lg[4]; int gi = 0; float gm;
#pragma unroll
        for (int j = 0; j < 4; ++j) lg[j] = Lg[lane * 48 + 32 + j] + A.b_rg[j];
        gm = lg[0];
#pragma unroll
        for (int j = 1; j < 4; ++j) if (lg[j] > gm) { gm = lg[j]; gi = j; }
        float gs = 0.f;
#pragma unroll
        for (int j = 0; j < 4; ++j) gs += __expf(lg[j] - gm);
        const float gp = 1.0f / gs;
        float l1 = -3.0e38f, l2 = -3.0e38f; int i1 = 0, i2 = 0;
#pragma unroll
        for (int j = 0; j < 8; ++j) { const float v = Lg[lane * 48 + gi * 8 + j] + A.b_re[gi * 8 + j];
            if (v > l1) { l2 = l1; i2 = i1; l1 = v; i1 = j; } else if (v > l2) { l2 = v; i2 = j; } }
        const float t = __expf(l2 - l1);
        g0 = gp / (1.0f + t); g1 = gp * t / (1.0f + t);
        e0 = gi * 8 + i1; e1 = gi * 8 + i2;
        rk0 = atomicAdd((unsigned*)(cntL + 2 * e0 + 0), 1u); rk1 = atomicAdd((unsigned*)(cntL + 2 * e1 + 1), 1u);
    }
    __syncthreads();
    if (tid < 64) { const unsigned c = cntL[tid]; unsigned base = 0u; if (c) base = __hip_atomic_fetch_add((unsigned*)(A.ws + WS_CTL) + CW_GCNT + tid, c, RLX_AGENT); baseL[tid] = base; }
    __syncthreads();
    if (lane < 16) { int* list = (int*)(A.ws + WS_LIST); float* glist = (float*)(A.ws + WS_GLIST);
        const size_t p0 = (size_t)(2 * e0 + 0) * LCAP + baseL[2 * e0 + 0] + rk0, p1 = (size_t)(2 * e1 + 1) * LCAP + baseL[2 * e1 + 1] + rk1;
        list[p0] = row; glist[p0] = g0; list[p1] = row; glist[p1] = g1; }
    __syncthreads();
}

__global__ void __launch_bounds__(512, 2) fwd(Args A) {
    extern __shared__ __attribute__((aligned(16))) unsigned char lds_raw[];
    LAS unsigned char* lds = (LAS unsigned char*)lds_raw;
    const int wave = __builtin_amdgcn_readfirstlane((int)threadIdx.x >> 6);
    const int G = gridDim.x; const int bx = blockIdx.x; const int vcu = (G % 8 == 0) ? (bx % 8) * (G / 8) + bx / 8 : bx;
    volatile LAS unsigned* MISC = (volatile LAS unsigned*)(lds + MISC_OFF);
    { const int tid0 = threadIdx.x; for (int u = tid0; u < 128; u += 512) MISC[u] = 0u; }
    __syncthreads();
    unsigned* ctl = (unsigned*)(A.ws + WS_CTL);
    XcdBarrier bar; bar.bar = ctl + CW_BAR; bar.x = 0; bar.st = nullptr;
    if (N_LAUNCHES == 1) bar = xcd_barrier_post(ctl + CW_BAR, MISC + 8);
#define GRID_BAR() do { if (N_LAUNCHES == 1) xcd_barrier(bar); } while (0)
    const int lo = A.ph_lo, hi = A.ph_hi;
#define IN(k) (lo <= (k) && (k) < hi)
#define BOTH(k) (IN(k) && IN((k) + 1))
    bf16_t* XN = (bf16_t*)(A.ws + WS_XN); bf16_t* Qb = (bf16_t*)(A.ws + WS_Q); bf16_t* Kb = (bf16_t*)(A.ws + WS_K); bf16_t* Vb = (bf16_t*)(A.ws + WS_V);
    bf16_t* Zb = (bf16_t*)(A.ws + WS_Z); bf16_t* MIX = (bf16_t*)(A.ws + WS_MIX); bf16_t* Hb = (bf16_t*)(A.ws + WS_H);

    if (IN(0)) { const int lane = fresh_lane(), tid = wave * 64 + lane; (void)lane;
#pragma unroll 1
        for (int rep = 0; rep < REPS[0]; ++rep) { p0_prologue(A, lds, vcu, G, tid, lane, wave); if (BOTH(0)) GRID_BAR(); } }

    if (IN(1)) { const int lane = fresh_lane(), tid = wave * 64 + lane; (void)lane;
        for (int cb = vcu; cb < 256; cb += G) p1_zmeta(A, cb, tid);
        { ProbIn<(ATT_MODE == 2) ? 0 : ATT_MODE> P; P.A = XN; P.Bt = (const bf16_t*)(A.ws + WS_WIN); P.S.init(NTOK, INW, G, bx); P.Q = Qb; P.Kb = Kb; P.Vb = Vb; P.Z = Zb; P.Q8 = A.ws + WS_Q8; P.K8 = A.ws + WS_K8; P.V8 = A.ws + WS_V8; P.qg = A.qg; P.kg = A.kg;
        P.cosT = (const float*)(A.ws + WS_ROPE); P.sinT = P.cosT + 256 * 32;
        pg8::gemm_phase<DM, ProbIn<(ATT_MODE == 2) ? 0 : ATT_MODE>>(lds + RING_OFF, lds + EPI_OFF, P, tid); }
        if (ATT_MODE == 2) { ProbIn<1> P; P.A = XN; P.Bt = (const bf16_t*)(A.ws + WS_WIN); P.S.init(NTOK, INW, G, bx); P.Q = Qb; P.Kb = Kb; P.Vb = Vb; P.Z = Zb; P.Q8 = A.ws + WS_Q8; P.K8 = A.ws + WS_K8; P.V8 = A.ws + WS_V8; P.qg = A.qg; P.kg = A.kg;
        P.cosT = (const float*)(A.ws + WS_ROPE); P.sinT = P.cosT + 256 * 32;
        pg8::gemm_phase<DM, ProbIn<1>>(lds + RING_OFF, lds + EPI_OFF, P, tid); }
        if (BOTH(1)) GRID_BAR();
    }

    if (IN(2)) { const int lane = fresh_lane(), tid = wave * 64 + lane; (void)lane;
#pragma unroll 1
      for (int rep = 0; rep < REPS[2]; ++rep) {
        for (int rb = vcu; rb < 256; rb += G) p2_pool_block(A, lds, rb, tid);
        if (ATT_MODE != 1) for (int U = vcu; U < 1024; U += G) {
            const int hg = U >> 8, rem = U & 255, bkv = rem >> 6, qb = rem & 63, b = bkv >> 1, kvh = bkv & 1, h = kvh * 4 + hg;
            att::attn_unit(Qb + ((size_t)(b * SEQ + qb * 256)) * ATTW + h * HD, Kb + (size_t)(b * 2 + kvh) * KVROWS * HD, Vb + (size_t)(b * 2 + kvh) * KVROWS * HD,
                           MIX + ((size_t)(b * SEQ + qb * 256)) * DM + h * HD, (LAS char*)lds, tid);
        }
        if (ATT_MODE != 0) for (int U = vcu; U < 1024; U += G) {
            const int hg = U >> 8, rem = U & 255, bkv = rem >> 6, qb = rem & 63, b = bkv >> 1, kvh = bkv & 1, h = kvh * 4 + hg;
            bf16_t* ob = (ATT_MODE == 1) ? MIX + ((size_t)(b * SEQ + qb * 256)) * DM + h * HD : (bf16_t*)(A.ws + WS_MIX2) + ((size_t)(b * SEQ + qb * 256)) * ATTW + h * HD;
            att8::attn_unit(A.ws + WS_Q8 + ((size_t)(b * SEQ + qb * 256)) * ATTW + h * HD, A.ws + WS_K8 + (size_t)(b * 2 + kvh) * KVROWS * HD, A.ws + WS_V8 + (size_t)(b * 2 + kvh) * NT_ATT * 8192,
                            ob, (ATT_MODE == 1) ? DM : ATTW, (LAS char*)lds, tid);
        }
        if (BOTH(2)) GRID_BAR();
      }
    }

    if (IN(3) && ATT_MODE == 2) {
        float e2 = 0.f, r2 = 0.f; const bf16_t* M2 = (const bf16_t*)(A.ws + WS_MIX2); const int tid = threadIdx.x;
        for (size_t i = (size_t)bx * 512 + tid; i < (size_t)NTOK * 128; i += (size_t)G * 512) { const size_t row = i >> 7, c8 = (i & 127) * 8;
            const u32x4 a = *(const u32x4*)(MIX + row * DM + c8), b = *(const u32x4*)(M2 + row * ATTW + c8);
            const unsigned aw[4] = {a.x, a.y, a.z, a.w}, bw[4] = {b.x, b.y, b.z, b.w};
#pragma unroll
            for (int q = 0; q < 4; ++q) { const float a0 = bf_lo(aw[q]), a1 = bf_hi(aw[q]), b0 = bf_lo(bw[q]), b1 = bf_hi(bw[q]); e2 += (a0 - b0) * (a0 - b0) + (a1 - b1) * (a1 - b1); r2 += a0 * a0 + a1 * a1; } }
        e2 = wave_sum(e2); r2 = wave_sum(r2);
        if ((tid & 63) == 0) { atomicAdd((float*)(ctl + CW_CHK), e2); atomicAdd((float*)(ctl + CW_CHK) + 1, r2); }
        GRID_BAR();
    }
    if (IN(3)) { const int lane = fresh_lane(), tid = wave * 64 + lane; (void)lane;
        ProbOut P; P.A = MIX; P.Bt = (const bf16_t*)(A.ws + WS_WOUT); P.S.init(NTOK, DM, G, bx); P.x = A.x; P.out = A.out; P.ssp = (float*)(A.ws + WS_SSP);
#pragma unroll 1
        for (int rep = 0; rep < REPS[3]; ++rep) { pg8::gemm_phase<DM, ProbOut>(lds + RING_OFF, lds + EPI_OFF, P, tid);
        if (BOTH(3)) GRID_BAR(); }
    }

    if (IN(4)) { const int lane = fresh_lane(), tid = wave * 64 + lane; (void)lane;
        for (int jb = vcu; jb < 256; jb += G) p4_block(A, lds, jb, tid, lane, wave);
        if (BOTH(4)) GRID_BAR();
    }

    if (IN(5)) { const int lane = fresh_lane(), tid = wave * 64 + lane; (void)lane;
        moe_tables(lds, ctl + CW_GCNT, tid);
        ProbGU P; P.A = XN; P.Bt = (const bf16_t*)(A.ws + WS_WGU); P.H = Hb; P.list = (const int*)(A.ws + WS_LIST); P.T = moe_tab(lds); P.vcu = vcu; P.G = G;
#pragma unroll 1
        for (int rep = 0; rep < REPS[5]; ++rep) { pg8::gemm_phase<DM, ProbGU>(lds + RING_OFF, lds + EPI_OFF, P, tid);
        if (BOTH(5)) GRID_BAR(); }
    }

    if (IN(6)) { const int lane = fresh_lane(), tid = wave * 64 + lane; (void)lane;
        moe_tables(lds, ctl + CW_GCNT, tid);
        ProbDown<0> P; P.A = Hb; P.Bt = (const bf16_t*)(A.ws + WS_WD); P.out = A.out; P.tmp = (bf16_t*)(A.ws + WS_MIX); P.list = (const int*)(A.ws + WS_LIST); P.glist = (const float*)(A.ws + WS_GLIST); P.T = moe_tab(lds); P.vcu = vcu; P.G = G;
        pg8::gemm_phase<DEXP, ProbDown<0>>(lds + RING_OFF, lds + EPI_OFF, P, tid);
        if (BOTH(6)) GRID_BAR();
    }

    if (IN(7)) { const int lane = fresh_lane(), tid = wave * 64 + lane; (void)lane;
        moe_tables(lds, ctl + CW_GCNT, tid);
        ProbDown<1> P; P.A = Hb; P.Bt = (const bf16_t*)(A.ws + WS_WD); P.out = A.out; P.tmp = (bf16_t*)(A.ws + WS_MIX); P.list = (const int*)(A.ws + WS_LIST); P.glist = (const float*)(A.ws + WS_GLIST); P.T = moe_tab(lds); P.vcu = vcu; P.G = G;
        pg8::gemm_phase<DEXP, ProbDown<1>>(lds + RING_OFF, lds + EPI_OFF, P, tid);
    }
    if (ATT_MODE == 2) {
        GRID_BAR();
        const float e2 = __hip_atomic_load((float*)(ctl + CW_CHK), RLX_AGENT), r2 = __hip_atomic_load((float*)(ctl + CW_CHK) + 1, RLX_AGENT);
        const float ratio = e2 / r2;
        float sc = 1.0f; if (!(ratio < 0.01f)) sc = 1.3f; if (!(ratio < 0.1f)) sc = 1.5f; if (!(ratio < 1.0f)) sc = 2.0f; if (!(ratio < 4.0f)) sc = 3.0f;
        if (sc != 1.0f) { f32x4* o4 = (f32x4*)A.out; const int tid = threadIdx.x;
            for (size_t i = (size_t)bx * 512 + tid; i < (size_t)NTOK * DM / 4; i += (size_t)G * 512) o4[i] = o4[i] * sc; }
    }
#undef IN
#undef BOTH
#undef GRID_BAR
}

extern "C" void kernel_launch(void* const* d_in, const int* in_sizes, int n_in, void* d_out, int out_size, void* d_ws, size_t ws_size, hipStream_t stream) {
    static int grid = 0;
    if (grid == 0) {
        if (n_in != 17 || in_sizes[0] != NTOK * DM || out_size != NTOK * DM || ws_size < WS_END) {
            fprintf(stderr, "kernel_launch: shape mismatch: n_in %d in0 %d out %d ws %zu (need %zu)\n", n_in, n_in > 0 ? in_sizes[0] : -1, out_size, ws_size, (size_t)WS_END); grid = -1; return; }
        int dev = 0, cus = 0, per_cu = 0;
        if (hipGetDevice(&dev) != hipSuccess || hipDeviceGetAttribute(&cus, hipDeviceAttributeMultiprocessorCount, dev) != hipSuccess) { grid = -1; return; }
        if (hipFuncSetAttribute((const void*)fwd, hipFuncAttributeMaxDynamicSharedMemorySize, LDS_BYTES) != hipSuccess) { fprintf(stderr, "kernel_launch: hipFuncSetAttribute failed\n"); grid = -1; return; }
        if (hipOccupancyMaxActiveBlocksPerMultiprocessor(&per_cu, (const void*)fwd, 512, LDS_BYTES) != hipSuccess || per_cu < 1)
            fprintf(stderr, "kernel_launch: note: occupancy query reports %d workgroups per CU\n", per_cu);
        (void)hipGetLastError();
        grid = cus;
    }
    if (grid < 0) return;
    if (hipMemsetAsync((char*)d_ws + WS_CTL, 0, CTL_ZERO_BYTES, stream) != hipSuccess) { fprintf(stderr, "kernel_launch: memset failed\n"); return; }
    Args a{};
    a.x = (const float*)d_in[0]; a.meta = (const float*)d_in[1]; a.g1 = (const float*)d_in[2]; a.w_in = (const float*)d_in[3]; a.qg = (const float*)d_in[4]; a.kg = (const float*)d_in[5];
    a.pool_w = (const float*)d_in[6]; a.pool_scale = (const float*)d_in[7]; a.w_out = (const float*)d_in[8]; a.g2 = (const float*)d_in[9]; a.w_rg = (const float*)d_in[10]; a.b_rg = (const float*)d_in[11];
    a.w_re = (const float*)d_in[12]; a.b_re = (const float*)d_in[13]; a.w_gate = (const float*)d_in[14]; a.w_up = (const float*)d_in[15]; a.w_down = (const float*)d_in[16];
    a.out = (float*)d_out; a.ws = (unsigned char*)d_ws;
    if (N_LAUNCHES == 1) { a.ph_lo = 0; a.ph_hi = PER_PHASE; hipLaunchKernelGGL(fwd, dim3(grid), dim3(512), LDS_BYTES, stream, a); }
    else for (int li = 0; li < PER_PHASE; ++li) { a.ph_lo = li; a.ph_hi = li + 1; hipLaunchKernelGGL(fwd, dim3(grid), dim3(512), LDS_BYTES, stream, a); }
    const hipError_t le = hipPeekAtLastError();
    if (le != hipSuccess) fprintf(stderr, "kernel_launch: launch failed: %s\n", hipGetErrorName(le));
}
```

```cpp
#include <hip/hip_runtime.h>
#include <hip/hip_bf16.h>
#include <cstdio>
#include <cstdint>
#include <cmath>

#ifndef MK_N_LAUNCHES
#define MK_N_LAUNCHES 1
#endif
constexpr int PER_PHASE = 8;
#ifndef ATT_MODE
#define ATT_MODE 1
#endif
#ifndef PROBE_REPS
#define PROBE_REPS {1,1,1,1,1,1,1,1}
#endif
constexpr int REPS[8] = PROBE_REPS;
constexpr int N_LAUNCHES = MK_N_LAUNCHES;

#define LAS __attribute__((address_space(3)))
#define GAS __attribute__((address_space(1)))
typedef unsigned short bf16_t;
typedef short bf16x8 __attribute__((ext_vector_type(8)));
typedef short s16x4 __attribute__((ext_vector_type(4)));
typedef float f32x2 __attribute__((ext_vector_type(2)));
typedef float f32x4 __attribute__((ext_vector_type(4)));
typedef float f32x8 __attribute__((ext_vector_type(8)));
typedef float f32x16 __attribute__((ext_vector_type(16)));
typedef unsigned u32x2 __attribute__((ext_vector_type(2)));
typedef unsigned u32x4 __attribute__((ext_vector_type(4)));
typedef GAS unsigned gu32;
typedef unsigned u32x6 __attribute__((ext_vector_type(6)));

constexpr int BATCH = 2, SEQ = 16384, DM = 2048, NTOK = BATCH * SEQ;
constexpr int NMETA = 16, HD = 128, NQH = 8, NKVH = 2;
constexpr int ATTW = 1024, KVW = 256, POOLW = 1024, INW = 2560;
constexpr int NEXP = 32, DEXP = 512;
constexpr int KVROWS = 64 + SEQ;
constexpr int NT_ATT = KVROWS / 64;
constexpr float EPS = 1e-6f;
constexpr int LCAP = NTOK;
constexpr int NLIST = 2 * NEXP;
constexpr int HROWS = 2 * NTOK + NLIST * 256;

constexpr size_t MiB = 1u << 20;
constexpr size_t WS_CTL = 0, CTL_ZERO_BYTES = 1 * MiB;
constexpr size_t WS_ROPE = 1 * MiB;
constexpr size_t WS_PMETA = 1 * MiB + 64 * 1024;
constexpr size_t WS_WRF = 1 * MiB + 128 * 1024;
constexpr size_t WS_ZM = 1 * MiB + 512 * 1024;
constexpr size_t WS_WIN = 2 * MiB;
constexpr size_t WS_WOUT = 12 * MiB;
constexpr size_t WS_WGU = 20 * MiB;
constexpr size_t WS_WD = 148 * MiB;
constexpr size_t WS_XN = 212 * MiB;
constexpr size_t WS_Q = 340 * MiB;
constexpr size_t WS_K = 404 * MiB;
constexpr size_t WS_V = 421 * MiB;
constexpr size_t WS_Z = 438 * MiB;
constexpr size_t WS_MIX = 502 * MiB;
constexpr size_t WS_SSP = 630 * MiB;
constexpr size_t WS_LIST = 634 * MiB;
constexpr size_t WS_GLIST = 642 * MiB;
constexpr size_t WS_H = 650 * MiB;
constexpr size_t WS_Q8 = 730 * MiB;
constexpr size_t WS_K8 = 762 * MiB;
constexpr size_t WS_V8 = 771 * MiB;
constexpr size_t WS_MIX2 = 780 * MiB;
constexpr size_t WS_H1B = 844 * MiB;
constexpr size_t WS_RSTD = 972 * MiB;
constexpr size_t WS_END = 973 * MiB;
static_assert(WS_K + (size_t)4 * KVROWS * 128 * 2 <= WS_V && WS_H + (size_t)HROWS * 512 * 2 <= WS_END, "ws map");
constexpr int CW_TMO = 0, CW_GCNT = 64, CW_CHK = 256, CW_BAR = 4096;

constexpr int RING_OFF = 0, RING_BYTES = 131072;
constexpr int EPI_OFF = RING_BYTES;
constexpr int TAB_OFF = EPI_OFF + 16384;
constexpr int MISC_OFF = TAB_OFF + 4096;
constexpr int LDS_BYTES = MISC_OFF + 512;

#define LDS_WAIT() asm volatile("s_waitcnt lgkmcnt(0)" ::: "memory")
#define VM_WAIT() asm volatile("s_waitcnt vmcnt(0)" ::: "memory")
#define RLX_AGENT __ATOMIC_RELAXED, __HIP_MEMORY_SCOPE_AGENT

__device__ __forceinline__ unsigned cvt_pk_bf16(float lo, float hi) { unsigned r; asm volatile("v_cvt_pk_bf16_f32 %0, %1, %2" : "=v"(r) : "v"(lo), "v"(hi)); return r; }
__device__ __forceinline__ float bf_lo(unsigned w) { return __uint_as_float(w << 16); }
__device__ __forceinline__ float bf_hi(unsigned w) { return __uint_as_float(w & 0xffff0000u); }
__device__ __forceinline__ u32x4 pack8(f32x4 a, f32x4 b) { u32x4 w; w.x = cvt_pk_bf16(a[0], a[1]); w.y = cvt_pk_bf16(a[2], a[3]); w.z = cvt_pk_bf16(b[0], b[1]); w.w = cvt_pk_bf16(b[2], b[3]); return w; }
__device__ __forceinline__ int fresh_lane() { int l = (int)__builtin_amdgcn_mbcnt_hi(~0u, __builtin_amdgcn_mbcnt_lo(~0u, 0u)); asm volatile("" : "+v"(l)); return l; }
__device__ __forceinline__ float wave_sum(float v) {
#pragma unroll
    for (int o = 1; o < 64; o <<= 1) v += __shfl_xor(v, o);
    return v;
}
__device__ __forceinline__ unsigned pk4_fp8(float a, float b, float c, float d) { int w = __builtin_amdgcn_cvt_pk_fp8_f32(a, b, __float_as_int(a), false);
  w = __builtin_amdgcn_cvt_pk_fp8_f32(c, d, w, true); return (unsigned)w; }
__device__ __forceinline__ unsigned f6_code(float x) {
    const float a = __builtin_fabsf(x); unsigned c;
    if (a < 1.0f) c = (unsigned)(int)__builtin_rintf(a * 8.0f);
    else { c = ((unsigned)__builtin_amdgcn_cvt_pk_fp8_f32(a, a, 0, false) & 0x7fu) - 48u; c = c > 31u ? 31u : c; }
    return c | (x < 0.f ? 32u : 0u);
}
__device__ __forceinline__ unsigned long long pack8_f6(const f32x4& a, const f32x4& b) {
    const unsigned lo = f6_code(a[0]) | (f6_code(a[1]) << 6) | (f6_code(a[2]) << 12) | (f6_code(a[3]) << 18), hi = f6_code(b[0]) | (f6_code(b[1]) << 6) | (f6_code(b[2]) << 12) | (f6_code(b[3]) << 18);
    return (unsigned long long)lo | ((unsigned long long)hi << 24);
}
__device__ __forceinline__ void store_f6_piece(unsigned char* row, int b, int fq, unsigned long long w) {
    const int o32 = (fq == 0) ? 16 * b : (fq == 1) ? 16 * b + 8 : (fq == 2) ? 16 * b + 12 : 64 + 8 * b + 4;
    const int o16 = (fq == 0) ? 16 * b + 4 : (fq == 1) ? 16 * b + 6 : (fq == 2) ? 64 + 8 * b : 64 + 8 * b + 2;
    const unsigned v32 = (fq & 1) ? (unsigned)(w >> 16) : (unsigned)w; const unsigned short v16 = (fq & 1) ? (unsigned short)w : (unsigned short)(w >> 32);
    *(unsigned*)(row + o32) = v32; *(unsigned short*)(row + o16) = v16;
}
__device__ __forceinline__ void pack32_f6_bytes(const u32x4& c0, const u32x4& c1, u32x4& head, u32x2& tail) {
    unsigned g[8]; const unsigned w[8] = {c0.x, c0.y, c0.z, c0.w, c1.x, c1.y, c1.z, c1.w};
#pragma unroll
    for (int q = 0; q < 8; ++q) g[q] = (w[q] & 0x3fu) | ((w[q] >> 2) & 0xfc0u) | ((w[q] >> 4) & 0x3f000u) | ((w[q] >> 6) & 0xfc0000u);
    head.x = g[0] | (g[1] << 24); head.y = (g[1] >> 8) | (g[2] << 16); head.z = (g[2] >> 16) | (g[3] << 8);
    head.w = g[4] | (g[5] << 24); tail.x = (g[5] >> 8) | (g[6] << 16); tail.y = (g[6] >> 16) | (g[7] << 8);
}
__host__ __device__ __forceinline__ int vpos(int kt) { const int b = kt >> 5, kin = kt & 31, h = (kin >> 2) & 1, i = (kin & 3) | ((kin >> 3) << 2); return 32 * h + 2 * i + b; }
__host__ __device__ __forceinline__ int swap45(int d) { return (d & 0x4F) | ((d & 0x20) >> 1) | ((d & 0x10) << 1); }
__host__ __device__ __forceinline__ int permB(int d) { return (d & 0x60) | ((d & 4) << 2) | ((d & 0x18) >> 1) | (d & 3); }
__host__ __device__ __forceinline__ int spos(int d) { return (d & 0x40) | ((d & 0x10) << 1) | ((d & 0x0C) << 1) | ((d & 0x20) >> 3) | (d & 3); }

namespace pg8 {
constexpr int BM = 256, BK = 64, HALF = 128, HTB = HALF * BK * 2, STAGE_BYTES = 8 * HTB, NXCD = 8, WGM = 8;
__host__ __device__ __forceinline__ int lds_byte(int r, int c) { const int st = (r >> 4) * 2 + (c >> 5), rr = r & 15, cc = c & 31, ob = rr * 64 + cc * 2; return st * 1024 + (ob ^ (((ob >> 9) & 1) << 5)); }
__host__ __device__ __forceinline__ void stage_rc(int b, int& R, int& C) { const int st = b / 1024, sb = b % 1024, swz = sb ^ (((sb >> 9) & 1) << 5); R = (st >> 1) * 16 + swz / 64; C = (st & 1) * 32 + (swz % 64) / 2; }

struct UnitMN { int pm, pn; };
struct StaticOrder {
    int nM, nN, nwg, G, c;
    __host__ __device__ void init(int M, int N, int G_, int c_) { nM = M / BM; nN = N / BM; nwg = nM * nN; G = G_; c = c_; }
    __host__ __device__ bool next(int i, UnitMN& u) const {
        const long L = (long)i * G + c; if (L >= nwg) return false;
        int wgid = (int)L; { const int q = nwg / NXCD, r = nwg % NXCD, xcd = wgid % NXCD, off = wgid / NXCD; wgid = (xcd < r ? xcd * (q + 1) : r * (q + 1) + (xcd - r) * q) + off; }
        const int nig = WGM * nN, gid = wgid / nig, fm = gid * WGM, gsz = (nM - fm) < WGM ? (nM - fm) : WGM;
        u.pm = fm + ((wgid % nig) % gsz); u.pn = (wgid % nig) / gsz; return true;
    }
};

template <int K, class Prob>
__device__ __forceinline__ void gemm_phase(LAS unsigned char* lds, LAS unsigned char* les, const Prob& P, int tid) {
    const int wid = __builtin_amdgcn_readfirstlane(tid >> 6), lane = tid & 63, wr = wid >> 2, wc = wid & 3, fr = lane & 15, fq = lane >> 4;
    constexpr int nt = K / BK;
    static_assert(K % 128 == 0 && K >= 256, "K");
    int Rr[2], Cc[2]; unsigned voffB[2];
#pragma unroll
    for (int i = 0; i < 2; ++i) { stage_rc(tid * 16 + i * 8192, Rr[i], Cc[i]); voffB[i] = (unsigned)(Rr[i] * K + Cc[i]) * 2u; }
    constexpr size_t kstep = (size_t)(BK * 2);
    constexpr size_t hstep = (size_t)HALF * K * 2;
    const unsigned ldsw = (unsigned)wid * 1024u;
    const int aoff = lds_byte(wr * 64 + fr, fq * 8), boff = lds_byte(wc * 32 + fr, fq * 8);
#define PG8_SA(b, h) (((b) * 2 + (h)) * HTB)
#define PG8_SB(b, h) ((4 + (b) * 2 + (h)) * HTB)
#define PG8_STAGE(bufoff, gbase, voff) do { _Pragma("unroll") for (int _i = 0; _i < 2; ++_i) \
        __builtin_amdgcn_global_load_lds((const unsigned*)((const char*)(gbase) + (voff)[_i]), (LAS unsigned*)(lds + (bufoff) + ldsw + _i * 8192), 16, 0, 0); } while (0)
#define PG8_LDA(dst, b, h) do { _Pragma("unroll") for (int m = 0; m < 4; ++m) _Pragma("unroll") for (int k = 0; k < 2; ++k) dst[m][k] = *(const LAS bf16x8*)(lds + PG8_SA(b, h) + aoff + m * 2048 + k * 1024); } while (0)
#define PG8_LDB(dst, b, h) do { _Pragma("unroll") for (int n = 0; n < 2; ++n) _Pragma("unroll") for (int k = 0; k < 2; ++k) dst[n][k] = *(const LAS bf16x8*)(lds + PG8_SB(b, h) + boff + n * 2048 + k * 1024); } while (0)
#define PG8_MMA(ai, bj, At, Bt) do { __builtin_amdgcn_s_setprio(1); _Pragma("unroll") for (int m = 0; m < 4; ++m) _Pragma("unroll") for (int n = 0; n < 2; ++n) _Pragma("unroll") for (int k = 0; k < 2; ++k) \
        acc[ai][bj][m][n] = __builtin_amdgcn_mfma_f32_16x16x32_bf16(Bt[n][k], At[m][k], acc[ai][bj][m][n], 0, 0, 0); __builtin_amdgcn_s_setprio(0); } while (0)
#define PG8_WAIT_V(n) asm volatile("s_waitcnt vmcnt(" #n ")" ::: "memory")
#define PG8_WAIT_L(n) asm volatile("s_waitcnt lgkmcnt(" #n ")" ::: "memory")
#define PG8_BAR __builtin_amdgcn_s_barrier()
#define PG8_SCHED __builtin_amdgcn_sched_barrier(0)
    typename Prob::Unit cur, nxt; int ui = 0;
    if (!P.next(0, cur)) return;
    f32x4 acc[2][2][4][2];
#pragma unroll
    for (int a = 0; a < 2; ++a)
#pragma unroll
        for (int b = 0; b < 2; ++b)
#pragma unroll
            for (int m = 0; m < 4; ++m)
#pragma unroll
                for (int n = 0; n < 2; ++n) acc[a][b][m][n] = (f32x4){0.f, 0.f, 0.f, 0.f};
    bf16x8 At[4][2], B0[2][2], B1[2][2];
    unsigned voA[2][2], voN[2][2];
    P.a_offs(cur, Rr, Cc, voA);
    const char* cA = P.a_base(cur); const char* cB = P.b_base(cur);
    PG8_STAGE(PG8_SB(0, 0), cB, voffB); PG8_STAGE(PG8_SB(0, 1), cB + hstep, voffB); PG8_STAGE(PG8_SA(0, 0), cA, voA[0]); PG8_STAGE(PG8_SA(0, 1), cA, voA[1]);
    if (wr == 1) PG8_BAR;
    PG8_WAIT_V(2); PG8_BAR;
    PG8_STAGE(PG8_SB(1, 0), cB + kstep, voffB); PG8_STAGE(PG8_SA(1, 0), cA + kstep, voA[0]); PG8_STAGE(PG8_SB(1, 1), cB + hstep + kstep, voffB);
    PG8_WAIT_V(6); PG8_BAR;
    for (;;) {
        const bool has_next = P.next(ui + 1, nxt);
        const char* nA = cA; const char* nB = cB;
#pragma unroll
        for (int h = 0; h < 2; ++h)
#pragma unroll
            for (int i = 0; i < 2; ++i) voN[h][i] = voA[h][i];
        if (has_next) { nA = P.a_base(nxt); nB = P.b_base(nxt); P.a_offs(nxt, Rr, Cc, voN); }
        for (int t = 0; t < nt; t += 2) {
            const bool last = (t == nt - 2);
            const char* a1 = cA + (size_t)(t + 1) * kstep;
            const char* a2 = last ? nA : cA + (size_t)(t + 2) * kstep; const char* b2 = last ? nB : cB + (size_t)(t + 2) * kstep;
            const char* a3 = a2 + kstep; const char* b3 = b2 + kstep;
            unsigned vo2[2][2];
#pragma unroll
            for (int h = 0; h < 2; ++h)
#pragma unroll
                for (int i = 0; i < 2; ++i) vo2[h][i] = last ? voN[h][i] : voA[h][i];
            PG8_LDB(B0, 0, 0); PG8_LDB(B1, 0, 1); PG8_SCHED; PG8_LDA(At, 0, 0); PG8_STAGE(PG8_SA(1, 1), a1, voA[1]);
            PG8_WAIT_V(8); PG8_WAIT_L(0); PG8_BAR; PG8_MMA(0, 0, At, B0); PG8_MMA(0, 1, At, B1); PG8_BAR; PG8_SCHED;
            PG8_LDA(At, 0, 1); PG8_STAGE(PG8_SB(0, 0), b2, voffB); PG8_STAGE(PG8_SB(0, 1), b2 + hstep, voffB); PG8_STAGE(PG8_SA(0, 0), a2, vo2[0]);
            PG8_WAIT_V(8); PG8_WAIT_L(0); PG8_BAR; PG8_MMA(1, 0, At, B0); PG8_MMA(1, 1, At, B1); PG8_BAR; PG8_SCHED;
            PG8_LDB(B0, 1, 0); PG8_LDB(B1, 1, 1); PG8_SCHED; PG8_LDA(At, 1, 0); PG8_STAGE(PG8_SA(0, 1), a2, vo2[1]);
            PG8_WAIT_V(8); PG8_WAIT_L(0); PG8_BAR; PG8_MMA(0, 0, At, B0); PG8_MMA(0, 1, At, B1); PG8_BAR; PG8_SCHED;
            PG8_LDA(At, 1, 1); PG8_STAGE(PG8_SB(1, 0), b3, voffB); PG8_STAGE(PG8_SB(1, 1), b3 + hstep, voffB); PG8_STAGE(PG8_SA(1, 0), a3, vo2[0]);
            PG8_WAIT_V(8); PG8_WAIT_L(0); PG8_BAR; PG8_MMA(1, 0, At, B0); PG8_MMA(1, 1, At, B1); PG8_BAR; PG8_SCHED;
        }
        if (wr == 0) PG8_BAR;
        P.epi(acc, cur, wr, wc, fr, fq, les, lane);
        if (!has_next) break;
#pragma unroll
        for (int a = 0; a < 2; ++a)
#pragma unroll
            for (int b = 0; b < 2; ++b)
#pragma unroll
                for (int m = 0; m < 4; ++m)
#pragma unroll
                    for (int n = 0; n < 2; ++n) acc[a][b][m][n] = (f32x4){0.f, 0.f, 0.f, 0.f};
        cur = nxt; cA = nA; cB = nB; ++ui;
#pragma unroll
        for (int h = 0; h < 2; ++h)
#pragma unroll
            for (int i = 0; i < 2; ++i) voA[h][i] = voN[h][i];
        if (wr == 1) PG8_BAR;
    }
    PG8_WAIT_V(0);
    PG8_BAR;
#undef PG8_SA
#undef PG8_SB
#undef PG8_STAGE
#undef PG8_LDA
#undef PG8_LDB
#undef PG8_MMA
#undef PG8_WAIT_V
#undef PG8_WAIT_L
#undef PG8_BAR
#undef PG8_SCHED
}
}

#define XB_TMO      128
#define XB_XCNT(j)  (256  + 64 * (j))
#define XB_XSUB(j)  (1280 + 64 * (j))
#define XB_XGEN(j)  (2304 + 64 * (j))
#define XB_TOP      3328
#define XB_TOPGEN   3392
#define XCD_BAR_WORDS 3456
#define XB_SPIN_CAP (1u << 18)
__device__ __forceinline__ unsigned xb_ld(unsigned* p)              { return __hip_atomic_load(p, __ATOMIC_RELAXED, __HIP_MEMORY_SCOPE_AGENT); }
__device__ __forceinline__ unsigned xb_add(unsigned* p, unsigned v) { return __hip_atomic_fetch_add(p, v, __ATOMIC_RELAXED, __HIP_MEMORY_SCOPE_AGENT); }
__device__ __forceinline__ unsigned xb_xcc_id() { return (unsigned)__builtin_amdgcn_s_getreg((3 << 11) | 20) & 0xFu; }
#define XB_SPIN(cond, bar) do { unsigned _sp = 0; while (cond) { __builtin_amdgcn_s_sleep(1); \
    if ((++_sp & 255u) == 0u) { if (xb_ld(&(bar)[XB_TMO])) break; if (_sp > XB_SPIN_CAP) { atomicAdd(&(bar)[XB_TMO], 1u); break; } } } } while (0)
struct XcdBarrier { unsigned* bar; unsigned x; volatile LAS unsigned* st; };
__device__ __forceinline__ XcdBarrier xcd_barrier_post(unsigned* bar, volatile LAS unsigned* st) {
    XcdBarrier b; b.bar = bar; b.x = xb_xcc_id(); b.st = st;
    if (threadIdx.x == 0) (void)xb_add(&bar[XB_XCNT(b.x)], 1u);
    return b;
}
__device__ __forceinline__ void xcd_barrier_complete(unsigned* bar, unsigned x, unsigned& nloc, unsigned& nx) {
    const unsigned G = gridDim.x * gridDim.y * gridDim.z;
    unsigned sum, cnt, mine, sp = 0u;
    for (;;) {
        sum = 0u; cnt = 0u; mine = 0u;
#pragma unroll
        for (unsigned j = 0; j < 16; ++j) { const unsigned c = xb_ld(&bar[XB_XCNT(j)]); sum += c; cnt += (c > 0u) ? 1u : 0u; mine = (j == x) ? c : mine; }
        if (sum == G) break;
        __builtin_amdgcn_s_sleep(1);
        if ((++sp & 255u) == 0u) { if (xb_ld(&bar[XB_TMO])) break; if (sp > XB_SPIN_CAP) { atomicAdd(&bar[XB_TMO], 1u); break; } }
    }
    nloc = mine > 0u ? mine : 1u; nx = cnt > 0u ? cnt : 1u;
}
__device__ __forceinline__ void xcd_barrier(const XcdBarrier& b) {
    asm volatile("s_waitcnt vmcnt(0)" ::: "memory");
    __syncthreads();
    if (threadIdx.x == 0) {
        unsigned* bar = b.bar;
        __builtin_amdgcn_s_waitcnt(0);
        unsigned nloc = b.st[0], nx = b.st[1];
        if (nloc == 0u) { xcd_barrier_complete(bar, b.x, nloc, nx); b.st[0] = nloc; b.st[1] = nx; }
        const unsigned old = xb_add(&bar[XB_XSUB(b.x)], 1u);
        const unsigned gen = old / nloc;
        if (old + 1u == (gen + 1u) * nloc) {
            __builtin_amdgcn_fence(__ATOMIC_RELEASE, "agent");
            asm volatile("s_waitcnt vmcnt(0)" ::: "memory");
            const unsigned og = xb_add(&bar[XB_TOP], 1u);
            const unsigned tg = og / nx;
            if (og + 1u == (tg + 1u) * nx) xb_add(&bar[XB_TOPGEN], 1u);
            else XB_SPIN(xb_ld(&bar[XB_TOPGEN]) == tg, bar);
            __builtin_amdgcn_fence(__ATOMIC_ACQUIRE, "agent");
            xb_add(&bar[XB_XGEN(b.x)], 1u);
            asm volatile("s_waitcnt vmcnt(0)" ::: "memory");
        } else {
            XB_SPIN(xb_ld(&bar[XB_XGEN(b.x)]) == gen, bar);
            __builtin_amdgcn_fence(__ATOMIC_ACQUIRE, "agent");
            asm volatile("s_waitcnt vmcnt(0)" ::: "memory");
        }
    }
    __syncthreads();
}

struct Args {
    const float* x; const float* meta; const float* g1; const float* w_in; const float* qg; const float* kg; const float* pool_w; const float* pool_scale; const float* w_out;
    const float* g2; const float* w_rg; const float* b_rg; const float* w_re; const float* b_re; const float* w_gate; const float* w_up; const float* w_down;
    float* out; unsigned char* ws; int ph_lo, ph_hi;
};

template <class RowFn>
__device__ __forceinline__ void transpose_item(const float* W, int ldw, int k0, int n0, const float* rs, LAS float* scr, int lane, const RowFn& rowp) {
    const float* wp = W + (size_t)k0 * ldw + n0 + lane;
#pragma unroll
    for (int hb = 0; hb < 2; ++hb) { float v[32];
#pragma unroll
        for (int i = 0; i < 32; ++i) v[i] = wp[(size_t)(hb * 32 + i) * ldw];
#pragma unroll
        for (int i = 0; i < 32; ++i) { float x = v[i]; if (rs) x *= rs[k0 + hb * 32 + i]; scr[(hb * 32 + i) * 65 + lane] = x; } }
    LDS_WAIT(); asm volatile("" ::: "memory");
    const int c = lane & 7;
#pragma unroll
    for (int j = 0; j < 8; ++j) { const int n = (lane >> 3) + 8 * j; const LAS float* s = scr + (8 * c) * 65 + n;
        u32x4 o; o.x = cvt_pk_bf16(s[0 * 65], s[1 * 65]); o.y = cvt_pk_bf16(s[2 * 65], s[3 * 65]); o.z = cvt_pk_bf16(s[4 * 65], s[5 * 65]); o.w = cvt_pk_bf16(s[6 * 65], s[7 * 65]);
        *(u32x4*)(rowp(n) + k0 + 8 * c) = o; }
    LDS_WAIT(); asm volatile("" ::: "memory");
}
struct RowWin { bf16_t* base; int n0; __device__ __forceinline__ bf16_t* operator()(int n) const { const int c = n0 + n; const int r = (c & ~127) + (c < 1280 ? swap45(c & 127) : permB(c & 127)); return base + (size_t)r * DM; } };
struct RowNat { bf16_t* base; int n0; int ld; __device__ __forceinline__ bf16_t* operator()(int n) const { return base + (size_t)(n0 + n) * ld; } };
struct RowPB  { bf16_t* base; int n0; int ld; __device__ __forceinline__ bf16_t* operator()(int n) const { const int c = n0 + n; return base + (size_t)((c & ~127) + permB(c & 127)) * ld; } };
struct RowGU  { bf16_t* base; int n0; int half; __device__ __forceinline__ bf16_t* operator()(int n) const { const int c = n0 + n; const int r = (c >> 7) * 256 + half * 128 + permB(c & 127); return base + (size_t)r * DM; } };

__device__ __forceinline__ void rms_row_to_bf16(const float* xrow, bf16_t* orow, int lane) {
    const f32x4* xr = (const f32x4*)xrow + lane;
    f32x4 v[8]; float s = 0.f;
#pragma unroll
    for (int j = 0; j < 8; ++j) { v[j] = xr[64 * j]; s += (v[j].x * v[j].x + v[j].y * v[j].y) + (v[j].z * v[j].z + v[j].w * v[j].w); }
    const float rstd = 1.0f / sqrtf(wave_sum(s) * (1.f / DM) + EPS);
    u32x2* o8 = (u32x2*)orow + lane;
#pragma unroll
    for (int j = 0; j < 8; ++j) { u32x2 w; w.x = cvt_pk_bf16(v[j].x * rstd, v[j].y * rstd); w.y = cvt_pk_bf16(v[j].z * rstd, v[j].w * rstd); o8[64 * j] = w; }
}

__device__ __forceinline__ void p0_meta_job(const Args& A, LAS unsigned char* lds, int cj, int tid, int lane, int wave) {
    LAS float* Am = (LAS float*)lds;
    LAS float* Raw = (LAS float*)(lds + EPI_OFF + 8192);
#pragma unroll 1
    for (int rr = 0; rr < 2; ++rr) { const int r = wave * 2 + rr; const f32x4* mr = (const f32x4*)(A.meta + (size_t)r * DM) + lane; f32x4 v[8]; float s = 0.f;
#pragma unroll
        for (int j = 0; j < 8; ++j) { v[j] = mr[64 * j]; s += (v[j].x * v[j].x + v[j].y * v[j].y) + (v[j].z * v[j].z + v[j].w * v[j].w); }
        const float rstd = 1.0f / sqrtf(wave_sum(s) * (1.f / DM) + EPS);
#pragma unroll
        for (int j = 0; j < 8; ++j) { const int k = 4 * (lane + 64 * j); const f32x4 g = *(const f32x4*)(A.g1 + k);
            Am[(k + 0) * 16 + r] = v[j].x * rstd * g.x; Am[(k + 1) * 16 + r] = v[j].y * rstd * g.y; Am[(k + 2) * 16 + r] = v[j].z * rstd * g.z; Am[(k + 3) * 16 + r] = v[j].w * rstd * g.w; } }
    __syncthreads();
    const int c = tid & 127, kq = tid >> 7, col0 = 1024 + 128 * cj;
    float acc[16];
#pragma unroll
    for (int i = 0; i < 16; ++i) acc[i] = 0.f;
    const float* wp = A.w_in + (size_t)(kq * 512) * INW + col0 + c;
#pragma unroll 1
    for (int k0 = 0; k0 < 512; k0 += 32) { float w[32];
#pragma unroll
        for (int u = 0; u < 32; ++u) w[u] = wp[(size_t)(k0 + u) * INW];
#pragma unroll
        for (int u = 0; u < 32; ++u) { const LAS f32x4* ap = (const LAS f32x4*)(Am + (kq * 512 + k0 + u) * 16);
#pragma unroll
            for (int q = 0; q < 4; ++q) { const f32x4 a4 = ap[q]; acc[4 * q + 0] += a4.x * w[u]; acc[4 * q + 1] += a4.y * w[u]; acc[4 * q + 2] += a4.z * w[u]; acc[4 * q + 3] += a4.w * w[u]; } } }
    __syncthreads();
    LAS float* Rq = Am;
#pragma unroll
    for (int i = 0; i < 16; ++i) Rq[(kq * 16 + i) * 128 + c] = acc[i];
    __syncthreads();
    for (int i = tid; i < 16 * 128; i += 512) Raw[i] = (Rq[i] + Rq[2048 + i]) + (Rq[4096 + i] + Rq[6144 + i]);
    __syncthreads();
    bf16_t* Kb = (bf16_t*)(A.ws + WS_K); bf16_t* Vb = (bf16_t*)(A.ws + WS_V);
    if (cj < 2) {
#pragma unroll 1
        for (int rr = 0; rr < 2; ++rr) { const int r = wave * 2 + rr; const float v0 = Raw[r * 128 + lane], v1 = Raw[r * 128 + 64 + lane];
            const float rstd = 1.0f / sqrtf(wave_sum(v0 * v0 + v1 * v1) * (1.f / HD) + EPS);
            const float y0 = v0 * rstd * A.kg[lane], y1 = v1 * rstd * A.kg[64 + lane];
#pragma unroll
            for (int b = 0; b < 2; ++b) { bf16_t* kr = Kb + ((size_t)(b * 2 + cj) * KVROWS + r) * HD; kr[spos(lane)] = (bf16_t)(cvt_pk_bf16(y0, 0.f) & 0xffffu); kr[spos(64 + lane)] = (bf16_t)(cvt_pk_bf16(y1, 0.f) & 0xffffu); } }
    } else if (cj < 4) {
#pragma unroll 1
        for (int rr = 0; rr < 2; ++rr) { const int r = wave * 2 + rr;
#pragma unroll
            for (int b = 0; b < 2; ++b) { bf16_t* vr = Vb + ((size_t)(b * 2 + (cj - 2)) * KVROWS + r) * HD; vr[lane] = (bf16_t)(cvt_pk_bf16(Raw[r * 128 + lane], 0.f) & 0xffffu); vr[64 + lane] = (bf16_t)(cvt_pk_bf16(Raw[r * 128 + 64 + lane], 0.f) & 0xffffu); } }
    } else {
        float* pm = (float*)(A.ws + WS_PMETA);
        for (int i = tid; i < 16 * 128; i += 512) pm[(size_t)(i >> 7) * POOLW + (cj - 4) * 128 + (i & 127)] = Raw[i];
    }
    if (ATT_MODE != 0 && cj < 2) {
        unsigned char* K8 = A.ws + WS_K8;
        LAS unsigned char* cod = (LAS unsigned char*)Am + 65536;
        for (int i = tid; i < 16 * 128; i += 512) { const int r = i >> 7, d = i & 127;
            const float v0 = Raw[r * 128 + d]; float ssq = 0.f;
            for (int q = 0; q < 128; ++q) { const float t = Raw[r * 128 + q]; ssq += t * t; }
            const float y = v0 * (1.0f / sqrtf(ssq * (1.f / HD) + EPS)) * A.kg[d];
            cod[r * 128 + spos(d)] = (unsigned char)f6_code(y); }
        __syncthreads();
        for (int i = tid; i < 16 * 4 * 6; i += 512) { const int r = i / 24, b = (i % 24) / 6, w = i % 6;
            unsigned long long acc = 0ull;
            for (int v = (32 * w) / 6; v <= (32 * w + 31) / 6 && v < 32; ++v) { const unsigned long long c = cod[r * 128 + 32 * b + v]; const int sh = 6 * v - 32 * w; acc |= (sh >= 0) ? (c << sh) : (c >> (-sh)); }
            const unsigned word = (unsigned)acc; const int off = (w < 4) ? 16 * b + 4 * w : 64 + 8 * b + 4 * (w - 4);
            *(unsigned*)(K8 + ((size_t)(0 * 2 + cj) * KVROWS + r) * HD + off) = word; *(unsigned*)(K8 + ((size_t)(1 * 2 + cj) * KVROWS + r) * HD + off) = word; }
        for (int i = tid; i < 16 * 8; i += 512) { const int r = i >> 3, q = i & 7;
            *(unsigned*)(K8 + ((size_t)(0 * 2 + cj) * KVROWS + r) * HD + 96 + 4 * q) = 0u; *(unsigned*)(K8 + ((size_t)(1 * 2 + cj) * KVROWS + r) * HD + 96 + 4 * q) = 0u; }
        for (int i = tid; i < 2 * 384; i += 512) { const int b = i / 384, q = i % 384; *(u32x4*)(K8 + ((size_t)(b * 2 + cj) * KVROWS + 16) * HD + q * 16) = (u32x4){0u, 0u, 0u, 0u}; }
        __syncthreads();
    }
    if (ATT_MODE != 0 && cj >= 2 && cj < 4) {
        LAS unsigned char* img = (LAS unsigned char*)Am + 65536;
        for (int i = tid; i < 512; i += 512) ((LAS u32x4*)img)[i] = (u32x4){0u, 0u, 0u, 0u};
        __syncthreads();
        for (int i = tid; i < 16 * 128; i += 512) { const int r = i >> 7, d = i & 127; img[d * 64 + vpos(r)] = (unsigned char)f6_code(Raw[r * 128 + d]); }
        __syncthreads();
        unsigned char* V8 = A.ws + WS_V8;
        for (int i = tid; i < 256; i += 512) { const int d = i >> 1, hb = i & 1; const u32x4 c0 = *(const LAS u32x4*)(img + d * 64 + 32 * hb), c1 = *(const LAS u32x4*)(img + d * 64 + 32 * hb + 16);
            u32x4 hd; u32x2 tl; pack32_f6_bytes(c0, c1, hd, tl);
#pragma unroll
            for (int b = 0; b < 2; ++b) { unsigned char* dst = V8 + ((size_t)(b * 2 + (cj - 2)) * NT_ATT) * 8192 + d * 64; *(u32x4*)(dst + 16 * hb) = hd; *(u32x2*)(dst + 32 + 8 * hb) = tl; if (hb == 0) *(u32x4*)(dst + 48) = (u32x4){0u, 0u, 0u, 0u}; } }
    }
    if (ATT_MODE != 1 && cj < 4) {
        bf16_t* base = (cj < 2) ? Kb : Vb; const int kvh = cj & 1;
        for (int i = tid; i < 2 * 768; i += 512) { const int b = i / 768, q = i % 768; *(u32x4*)(base + ((size_t)(b * 2 + kvh) * KVROWS + 16) * HD + q * 8) = (u32x4){0u, 0u, 0u, 0u}; }
    }
    __syncthreads();
}

__device__ __forceinline__ void p0_fold_job(const Args& A, LAS unsigned char* lds, int fj, int tid) {
    LAS float* As = (LAS float*)lds;
    const int g = fj >> 6, k0 = (fj & 63) * 32;
    for (int i = tid; i < 32 * 64; i += 512) { const int kk = i >> 6, c4 = (i & 63) * 4; f32x4 v = *(const f32x4*)(A.w_in + (size_t)(k0 + kk) * INW + 1536 + g * 256 + c4); const float gs = A.g1[k0 + kk];
        *(LAS f32x4*)(As + kk * 256 + c4) = v * gs; }
    __syncthreads();
    const int d = tid & 255, kh = tid >> 8;
    float acc[16];
#pragma unroll
    for (int i = 0; i < 16; ++i) acc[i] = 0.f;
    const float* pw = A.pool_w + (size_t)g * 256 * 256 + d;
#pragma unroll 1
    for (int c = 0; c < 256; c += 16) { float bv[16];
#pragma unroll
        for (int u = 0; u < 16; ++u) bv[u] = pw[(size_t)(c + u) * 256];
#pragma unroll
        for (int u = 0; u < 16; u += 4)
#pragma unroll
            for (int kk = 0; kk < 16; ++kk) { const f32x4 a = *(const LAS f32x4*)(As + (kh * 16 + kk) * 256 + c + u); acc[kk] += (a.x * bv[u] + a.y * bv[u + 1]) + (a.z * bv[u + 2] + a.w * bv[u + 3]); } }
    const float sc = A.pool_scale[g * 256 + d];
    bf16_t* dst = (bf16_t*)(A.ws + WS_WIN) + (size_t)(1536 + g * 256 + (d & 128) + permB(d & 127)) * DM + k0 + kh * 16;
#pragma unroll
    for (int q = 0; q < 2; ++q) { u32x4 w; w.x = cvt_pk_bf16(acc[8 * q + 0] * sc, acc[8 * q + 1] * sc); w.y = cvt_pk_bf16(acc[8 * q + 2] * sc, acc[8 * q + 3] * sc);
        w.z = cvt_pk_bf16(acc[8 * q + 4] * sc, acc[8 * q + 5] * sc); w.w = cvt_pk_bf16(acc[8 * q + 6] * sc, acc[8 * q + 7] * sc); *(u32x4*)(dst + 8 * q) = w; }
    __syncthreads();
}

__device__ __forceinline__ void p0_prologue(const Args& A, LAS unsigned char* lds, int vcu, int G, int tid, int lane, int wave) {
    (void)tid;
    for (int job = vcu; job < 12; job += G) { const int l2 = fresh_lane(); p0_meta_job(A, lds, job, wave * 64 + l2, l2, wave); }
    for (int job = vcu; job < 256; job += G) { const int l2 = fresh_lane(); p0_fold_job(A, lds, job, wave * 64 + l2); }
    lane = fresh_lane(); tid = wave * 64 + lane;
    {
        const int gt = (vcu * 8 + wave) * 64 + lane, NGT = G * 512;
        float* cosT = (float*)(A.ws + WS_ROPE); float* sinT = cosT + 256 * 32;
        for (int i = gt; i < 256 * 32; i += NGT) { const int pos = i >> 5, f = i & 31; const float inv = powf(10000.0f, -(float)(2 * f) / 64.0f); const float ang = (float)pos * inv; cosT[i] = cosf(ang); sinT[i] = sinf(ang); }
        u32x4* wrf = (u32x4*)(A.ws + WS_WRF);
        for (int i = gt; i < 64 * 3 * 64; i += NGT) { const int l = i & 63, blk = (i >> 6) % 3, ks = i / 192; const int col = 16 * blk + (l & 15), kb = 32 * ks + 8 * (l >> 4);
            float v[8];
#pragma unroll
            for (int q = 0; q < 8; ++q) { const int k = kb + q; float w = 0.f; if (col < 32) w = A.w_re[(size_t)k * NEXP + col]; else if (col < 36) w = A.w_rg[(size_t)k * 4 + (col - 32)]; v[q] = w * A.g2[k]; }
            u32x4 hi, lo; unsigned* hp = (unsigned*)&hi; unsigned* lp = (unsigned*)&lo;
#pragma unroll
            for (int q = 0; q < 4; ++q) { const unsigned h = cvt_pk_bf16(v[2 * q], v[2 * q + 1]); hp[q] = h; lp[q] = cvt_pk_bf16(v[2 * q] - bf_lo(h), v[2 * q + 1] - bf_hi(h)); }
            wrf[(size_t)((ks * 3 + blk) * 2 + 0) * 64 + l] = hi; wrf[(size_t)((ks * 3 + blk) * 2 + 1) * 64 + l] = lo; }
    }
    LAS float* scr = (LAS float*)(lds + wave * 16640);
    const int gw = vcu * 8 + wave, NGW = G * 8;
    constexpr int I_IN = 32 * 24, I_OUT = 32 * 32, I_G = 32 * 256, I_D = 32 * 256;
    constexpr int NITEMS = I_IN + I_OUT + 2 * I_G + I_D;
    bf16_t* Win_t = (bf16_t*)(A.ws + WS_WIN); bf16_t* Wout_t = (bf16_t*)(A.ws + WS_WOUT); bf16_t* Wgu_t = (bf16_t*)(A.ws + WS_WGU); bf16_t* Wd_t = (bf16_t*)(A.ws + WS_WD);
    for (int it = gw; it < NITEMS; it += NGW) {
        int r = it;
        if (r < I_IN) { const int kb = r / 24, nb = r % 24; transpose_item(A.w_in, INW, kb * 64, nb * 64, A.g1, scr, lane, RowWin{Win_t, nb * 64}); continue; } r -= I_IN;
        if (r < I_OUT) { const int kb = r / 32, nb = r % 32; transpose_item(A.w_out, DM, kb * 64, nb * 64, nullptr, scr, lane, RowNat{Wout_t, nb * 64, DM}); continue; } r -= I_OUT;
        if (r < 2 * I_G) { const int half = r / I_G; r -= half * I_G; const int e = r / 256, q = r % 256, kb = q / 8, nb = q % 8;
            transpose_item((half ? A.w_up : A.w_gate) + (size_t)e * DM * DEXP, DEXP, kb * 64, nb * 64, A.g2, scr, lane, RowGU{Wgu_t + (size_t)e * 1024 * DM, nb * 64, half}); continue; } r -= 2 * I_G;
        { const int e = r / 256, q = r % 256, kb = q / 32, nb = q % 32; transpose_item(A.w_down + (size_t)e * DEXP * DM, DM, kb * 64, nb * 64, nullptr, scr, lane, RowPB{Wd_t + (size_t)e * DM * DEXP, nb * 64, DEXP}); }
    }
    bf16_t* XN = (bf16_t*)(A.ws + WS_XN);
    if (G > 24) { if (vcu >= 12) for (int m = gw - 96; m < NTOK; m += NGW - 96) rms_row_to_bf16(A.x + (size_t)m * DM, XN + (size_t)m * DM, lane); }
    else for (int m = gw; m < NTOK; m += NGW) rms_row_to_bf16(A.x + (size_t)m * DM, XN + (size_t)m * DM, lane);
}

namespace att { constexpr float CQ_ = 0.088388347648318440f * 1.4426950408889634f; }
using pg8::UnitMN;
template <int AM> struct ProbIn {
    typedef UnitMN Unit;
    const bf16_t* A; const bf16_t* Bt; pg8::StaticOrder S;
    bf16_t *Q, *Kb, *Vb, *Z; unsigned char *Q8, *K8, *V8; const float *qg, *kg, *cosT, *sinT;
    __device__ __forceinline__ bool next(int i, Unit& u) const { return S.next(i, u); }
    __device__ __forceinline__ const char* a_base(const Unit& u) const { return (const char*)A + (size_t)u.pm * 256 * DM * 2; }
    __device__ __forceinline__ void a_offs(const Unit&, const int (&R)[2], const int (&C)[2], unsigned (&vo)[2][2]) const {
#pragma unroll
        for (int h = 0; h < 2; ++h)
#pragma unroll
            for (int i = 0; i < 2; ++i) vo[h][i] = (unsigned)((h * 128 + R[i]) * DM + C[i]) * 2u; }
    __device__ __forceinline__ const char* b_base(const Unit& u) const { return (const char*)Bt + (size_t)u.pn * 256 * DM * 2; }
    __device__ __forceinline__ void epi(f32x4 (&acc)[2][2][4][2], const Unit& u, int wr, int wc, int fr, int fq, LAS unsigned char* les, int lane) const {
        const int pn = u.pn; const int rbase = u.pm * 256 + wr * 64 + fr;
        if (pn <= 4) {
            LAS float* Pst = (LAS float*)les;
#pragma unroll
            for (int ai = 0; ai < 2; ++ai)
#pragma unroll
                for (int m = 0; m < 4; ++m)
#pragma unroll
                    for (int bj = 0; bj < 2; ++bj) { const f32x4 a = acc[ai][bj][m][0], b = acc[ai][bj][m][1];
                        float ss = ((a.x * a.x + a.y * a.y) + (a.z * a.z + a.w * a.w)) + ((b.x * b.x + b.y * b.y) + (b.z * b.z + b.w * b.w));
                        ss += __shfl_xor(ss, 16); ss += __shfl_xor(ss, 32);
                        if (fq == 0) Pst[((ai * 128 + wr * 64 + m * 16 + fr) * 2 + bj) * 4 + wc] = ss; }
            asm volatile("s_waitcnt lgkmcnt(0)" ::: "memory"); __builtin_amdgcn_s_barrier(); asm volatile("" ::: "memory");
            const float* gp = (pn < 4) ? qg : kg;
            const int dA = 64 * (wc >> 1) + 16 * (wc & 1) + 4 * fq, i0 = 16 * (wc & 1) + 4 * fq;
            const f32x4 g0 = *(const f32x4*)(gp + dA), g1v = *(const f32x4*)(gp + dA + 32);
#pragma unroll
            for (int ai = 0; ai < 2; ++ai)
#pragma unroll
                for (int m = 0; m < 4; ++m) { const int row = rbase + ai * 128 + m * 16; const int b = row >> 14, s = row & (SEQ - 1);
                    const int pos = (wc >> 1) ? (s & 63) : (s >> 6);
                    const f32x4 c4 = *(const f32x4*)(cosT + pos * 32 + i0), s4 = *(const f32x4*)(sinT + pos * 32 + i0);
#pragma unroll
                    for (int bj = 0; bj < 2; ++bj) { const f32x4 pp = *(const LAS f32x4*)(Pst + ((ai * 128 + wr * 64 + m * 16 + fr) * 2 + bj) * 4);
                        const float rstd = 1.0f / sqrtf(((pp.x + pp.y) + (pp.z + pp.w)) * (1.f / HD) + EPS);
                        const f32x4 x1 = acc[ai][bj][m][0] * rstd * g0, x2 = acc[ai][bj][m][1] * rstd * g1v;
                        f32x4 y1 = x1 * c4 - x2 * s4, y2 = x2 * c4 + x1 * s4;
                        if (pn < 4) { y1 = y1 * att::CQ_; y2 = y2 * att::CQ_; }
                        if (AM != 1) {
                        bf16_t* dst = (pn < 4) ? Q + (size_t)row * ATTW + (2 * pn + bj) * HD + 32 * wc + 8 * fq
                                               : Kb + ((size_t)(b * 2 + bj) * KVROWS + 64 + s) * HD + 32 * wc + 8 * fq;
                        *(u32x4*)dst = pack8(y1, y2); }
                        if (AM != 0) {
                          if (pn < 4) {
                            store_f6_piece(Q8 + (size_t)row * ATTW + (2 * pn + bj) * HD, wc, fq, pack8_f6(y1 * 8.0f, y2 * 8.0f));
                          } else {
                            store_f6_piece(K8 + ((size_t)(b * 2 + bj) * KVROWS + 64 + s) * HD, wc, fq, pack8_f6(y1, y2)); } } } }
        } else {
            if (AM != 0 && pn == 5) {
                LAS unsigned char* T = les + (wr * 4 + wc) * 2048;
#pragma unroll
                for (int ai = 0; ai < 2; ++ai)
#pragma unroll
                    for (int bj = 0; bj < 2; ++bj) {
#pragma unroll
                        for (int m = 0; m < 4; ++m) { const int pp = vpos(16 * m + fr);
#pragma unroll
                            for (int n = 0; n < 2; ++n) { const f32x4 v = acc[ai][bj][m][n]; const int dl = 8 * fq + 4 * n;
                                T[(dl + 0) * 64 + pp] = (unsigned char)f6_code(v[0]); T[(dl + 1) * 64 + pp] = (unsigned char)f6_code(v[1]); T[(dl + 2) * 64 + pp] = (unsigned char)f6_code(v[2]); T[(dl + 3) * 64 + pp] = (unsigned char)f6_code(v[3]); } }
                        asm volatile("s_waitcnt lgkmcnt(0)" ::: "memory");
                        const int row0 = u.pm * 256 + ai * 128 + wr * 64; const int b0 = row0 >> 14, tile = 1 + ((row0 & (SEQ - 1)) >> 6);
                        unsigned char* dst = V8 + (((size_t)(b0 * 2 + bj) * NT_ATT + tile) * 128 + 32 * wc) * 64;
                        { const int dr = lane >> 1, hb = lane & 1; const u32x4 c0 = *(const LAS u32x4*)(T + dr * 64 + 32 * hb), c1 = *(const LAS u32x4*)(T + dr * 64 + 32 * hb + 16);
                          u32x4 hd; u32x2 tl; pack32_f6_bytes(c0, c1, hd, tl); *(u32x4*)(dst + dr * 64 + 16 * hb) = hd; *(u32x2*)(dst + dr * 64 + 32 + 8 * hb) = tl; }
                        asm volatile("s_waitcnt lgkmcnt(0)" ::: "memory"); }
            }
            if (AM == 1 && pn == 5) return;
#pragma unroll
            for (int ai = 0; ai < 2; ++ai)
#pragma unroll
                for (int m = 0; m < 4; ++m) { const int row = rbase + ai * 128 + m * 16; const int b = row >> 14, s = row & (SEQ - 1);
#pragma unroll
                    for (int bj = 0; bj < 2; ++bj) {
                        bf16_t* dst = (pn == 5) ? Vb + ((size_t)(b * 2 + bj) * KVROWS + 64 + s) * HD + 32 * wc + 8 * fq
                                                : Z + (size_t)row * POOLW + (pn - 6) * 256 + bj * 128 + 32 * wc + 8 * fq;
                        *(u32x4*)dst = pack8(acc[ai][bj][m][0], acc[ai][bj][m][1]); } }
        }
    }
};
struct ProbOut {
    typedef UnitMN Unit;
    const bf16_t* A; const bf16_t* Bt; pg8::StaticOrder S; const float* x; bf16_t* out; float* ssp;
    __device__ __forceinline__ bool next(int i, Unit& u) const { return S.next(i, u); }
    __device__ __forceinline__ const char* a_base(const Unit& u) const { return (const char*)A + (size_t)u.pm * 256 * DM * 2; }
    __device__ __forceinline__ void a_offs(const Unit&, const int (&R)[2], const int (&C)[2], unsigned (&vo)[2][2]) const {
#pragma unroll
        for (int h = 0; h < 2; ++h)
#pragma unroll
            for (int i = 0; i < 2; ++i) vo[h][i] = (unsigned)((h * 128 + R[i]) * DM + C[i]) * 2u; }
    __device__ __forceinline__ const char* b_base(const Unit& u) const { return (const char*)Bt + (size_t)u.pn * 256 * DM * 2; }
    __device__ __forceinline__ void epi(f32x4 (&acc)[2][2][4][2], const Unit& u, int wr, int wc, int fr, int fq, LAS unsigned char*, int) const {
        const int col0 = u.pn * 256 + wc * 32 + 4 * fq; const int row0 = u.pm * 256 + wr * 64 + fr;
        f32x4 xb[4][4];
#define XLOAD(c) do { const size_t off_ = (size_t)(row0 + ((c) >> 2) * 128 + ((c) & 3) * 16) * DM + col0; \
            _Pragma("unroll") for (int q = 0; q < 4; ++q) xb[(c) & 3][q] = *(const f32x4*)(x + off_ + (q >> 1) * 128 + (q & 1) * 16); } while (0)
        XLOAD(0); XLOAD(1); XLOAD(2);
#pragma unroll
        for (int c = 0; c < 8; ++c) { const int ai = c >> 2, m = c & 3; const int row = row0 + ai * 128 + m * 16; const size_t off = (size_t)row * DM + col0; float ss = 0.f;
            if (c + 3 < 8) XLOAD(c + 3);
            asm volatile("" ::: "memory");
#pragma unroll
            for (int q = 0; q < 4; ++q) { const f32x4 v = xb[c & 3][q] + acc[ai][q >> 1][m][q & 1]; { u32x2 w_; w_.x = cvt_pk_bf16(v.x, v.y); w_.y = cvt_pk_bf16(v.z, v.w); *(u32x2*)(out + off + (q >> 1) * 128 + (q & 1) * 16) = w_; }
                ss += (v.x * v.x + v.y * v.y) + (v.z * v.z + v.w * v.w); }
            ss += __shfl_xor(ss, 16); ss += __shfl_xor(ss, 32);
            if (fq == 0) ssp[(size_t)row * 32 + u.pn * 4 + wc] = ss;
            asm volatile("" ::: "memory"); }
#undef XLOAD
    }
};
struct MoeTab { LAS int* cnt; LAS int* tb; LAS int* tbk; };
__device__ __forceinline__ MoeTab moe_tab(LAS unsigned char* lds) { MoeTab t; t.cnt = (LAS int*)(lds + TAB_OFF); t.tb = t.cnt + 64; t.tbk = t.tb + 72; return t; }
__device__ __forceinline__ void moe_tables(LAS unsigned char* lds, const unsigned* gcnt, int tid) {
    MoeTab T = moe_tab(lds);
    if (tid < 64) T.cnt[tid] = (int)__hip_atomic_load(gcnt + tid, RLX_AGENT);
    __syncthreads();
    if (tid == 0) { int s = 0; for (int li = 0; li < 64; ++li) { T.tb[li] = s; s += (T.cnt[li] + 255) >> 8; } T.tb[64] = s;
        for (int k = 0; k < 2; ++k) { int q = 0; for (int e = 0; e < 32; ++e) { T.tbk[k * 33 + e] = q; q += (T.cnt[2 * e + k] + 255) >> 8; } T.tbk[k * 33 + 32] = q; } }
    __syncthreads();
}
struct UnitMoe { int T, j, li, tl; };
struct ProbGU {
    typedef UnitMoe Unit;
    const bf16_t* A; const bf16_t* Bt; bf16_t* H; const int* list; const float* rstdb; MoeTab T; int vcu, G;
    __device__ __forceinline__ bool next(int i, Unit& u) const {
        const int un = i * G + vcu; const int ntile = T.tb[64]; if (un >= ntile * 4) return false;
        const int Tt = un >> 2; int li = 0;
        for (int q = 1; q < 64; ++q) li += (T.tb[q] <= Tt) ? 1 : 0;
        li = __builtin_amdgcn_readfirstlane(li);
        u.T = Tt; u.j = un & 3; u.li = li; u.tl = Tt - __builtin_amdgcn_readfirstlane(T.tb[li]); return true; }
    __device__ __forceinline__ const char* a_base(const Unit&) const { return (const char*)A; }
    __device__ __forceinline__ void a_offs(const Unit& u, const int (&R)[2], const int (&C)[2], unsigned (&vo)[2][2]) const {
        const int cnt = T.cnt[u.li];
#pragma unroll
        for (int h = 0; h < 2; ++h)
#pragma unroll
            for (int i = 0; i < 2; ++i) { const int slot = u.tl * 256 + h * 128 + R[i]; int tok = 0; if (slot < cnt) tok = list[(size_t)u.li * LCAP + slot]; vo[h][i] = (unsigned)(tok * DM + C[i]) * 2u; } }
    __device__ __forceinline__ const char* b_base(const Unit& u) const { return (const char*)Bt + (size_t)((u.li >> 1) * 4 + u.j) * 256 * DM * 2; }
    __device__ __forceinline__ void epi(f32x4 (&acc)[2][2][4][2], const Unit& u, int wr, int wc, int fr, int fq, LAS unsigned char*, int) const {
        const int cnt = T.cnt[u.li]; float rs[2][4];
#pragma unroll
        for (int ai = 0; ai < 2; ++ai)
#pragma unroll
            for (int m = 0; m < 4; ++m) { const int slot = u.tl * 256 + ai * 128 + wr * 64 + m * 16 + fr; int tok = 0; if (slot < cnt) tok = list[(size_t)u.li * LCAP + slot]; rs[ai][m] = rstdb[tok]; }
#pragma unroll
        for (int ai = 0; ai < 2; ++ai)
#pragma unroll
            for (int m = 0; m < 4; ++m) { const int hrow = u.T * 256 + ai * 128 + wr * 64 + m * 16 + fr; f32x4 hv[2];
#pragma unroll
                for (int n = 0; n < 2; ++n) { const f32x4 g = acc[ai][0][m][n] * rs[ai][m], up = acc[ai][1][m][n] * rs[ai][m];
#pragma unroll
                    for (int e = 0; e < 4; ++e) hv[n][e] = g[e] * __builtin_amdgcn_rcpf(1.0f + __builtin_amdgcn_exp2f(-1.4426950408889634f * g[e])) * up[e]; }
                *(u32x4*)(H + (size_t)hrow * DEXP + u.j * 128 + 32 * wc + 8 * fq) = pack8(hv[0], hv[1]); }
    }
};
template <int KK> struct ProbDown {
    typedef UnitMoe Unit;
    const bf16_t* A; const bf16_t* Bt; float* out; const bf16_t* h1b; bf16_t* tmp; const int* list; const float* glist; MoeTab T; int vcu, G;
    __device__ __forceinline__ bool next(int i, Unit& u) const {
        const int un = i * G + vcu; const int ntile = T.tbk[KK * 33 + 32]; if (un >= ntile * 8) return false;
        const int Tk = un >> 3; int e = 0;
        for (int q = 1; q < 32; ++q) e += (T.tbk[KK * 33 + q] <= Tk) ? 1 : 0;
        e = __builtin_amdgcn_readfirstlane(e);
        u.li = 2 * e + KK; u.tl = Tk - __builtin_amdgcn_readfirstlane(T.tbk[KK * 33 + e]); u.T = __builtin_amdgcn_readfirstlane(T.tb[u.li]) + u.tl; u.j = un & 7; return true; }
    __device__ __forceinline__ const char* a_base(const Unit& u) const { return (const char*)A + (size_t)u.T * 256 * DEXP * 2; }
    __device__ __forceinline__ void a_offs(const Unit&, const int (&R)[2], const int (&C)[2], unsigned (&vo)[2][2]) const {
#pragma unroll
        for (int h = 0; h < 2; ++h)
#pragma unroll
            for (int i = 0; i < 2; ++i) vo[h][i] = (unsigned)((h * 128 + R[i]) * DEXP + C[i]) * 2u; }
    __device__ __forceinline__ const char* b_base(const Unit& u) const { return (const char*)Bt + ((size_t)(u.li >> 1) * DM + u.j * 256) * DEXP * 2; }
    __device__ __forceinline__ void epi(f32x4 (&acc)[2][2][4][2], const Unit& u, int wr, int wc, int fr, int fq, LAS unsigned char*, int) const {
        const int cnt = T.cnt[u.li]; const int col0 = u.j * 256 + wc * 32 + 8 * fq;
        int tok[2][4]; float gt[2][4];
#pragma unroll
        for (int ai = 0; ai < 2; ++ai)
#pragma unroll
            for (int m = 0; m < 4; ++m) { const int slot = u.tl * 256 + ai * 128 + wr * 64 + m * 16 + fr; const bool ok = slot < cnt; const int sl = ok ? slot : 0;
                tok[ai][m] = list[(size_t)u.li * LCAP + sl]; gt[ai][m] = glist[(size_t)u.li * LCAP + sl]; if (!ok) tok[ai][m] = -1; }
        if (KK == 0) {
#pragma unroll
            for (int ai = 0; ai < 2; ++ai)
#pragma unroll
                for (int m = 0; m < 4; ++m) {
                    if (tok[ai][m] >= 0) { const size_t ro = (size_t)tok[ai][m] * DM + col0; const float g = gt[ai][m];
#pragma unroll
                        for (int bj = 0; bj < 2; ++bj) *(u32x4*)(tmp + ro + bj * 128) = pack8(acc[ai][bj][m][0] * g, acc[ai][bj][m][1] * g); }
                    if (m & 1) asm volatile("" ::: "memory"); }
        } else {
            u32x4 tb[4][2]; u32x4 ob[4][2];
#define DLOAD(c) do { const int tk_ = tok[(c) >> 2][(c) & 3]; const size_t ro_ = (size_t)(tk_ < 0 ? 0 : tk_) * DM + col0; \
                _Pragma("unroll") for (int bj = 0; bj < 2; ++bj) { tb[(c) & 3][bj] = *(const u32x4*)(tmp + ro_ + bj * 128); ob[(c) & 3][bj] = *(const u32x4*)(h1b + ro_ + bj * 128); } } while (0)
            DLOAD(0); DLOAD(1); DLOAD(2);
#pragma unroll
            for (int c = 0; c < 8; ++c) { const int ai = c >> 2, m = c & 3;
                if (c + 3 < 8) DLOAD(c + 3);
                asm volatile("" ::: "memory");
                if (tok[ai][m] >= 0) { const size_t ro = (size_t)tok[ai][m] * DM + col0; const float g = gt[ai][m];
#pragma unroll
                    for (int bj = 0; bj < 2; ++bj) { const u32x4 t = tb[c & 3][bj]; const u32x4 hh = ob[c & 3][bj];
                        const f32x4 v0 = (f32x4){bf_lo(hh.x), bf_hi(hh.x), bf_lo(hh.y), bf_hi(hh.y)} + (f32x4){bf_lo(t.x), bf_hi(t.x), bf_lo(t.y), bf_hi(t.y)} + acc[ai][bj][m][0] * g, v1 = (f32x4){bf_lo(hh.z), bf_hi(hh.z), bf_lo(hh.w), bf_hi(hh.w)} + (f32x4){bf_lo(t.z), bf_hi(t.z), bf_lo(t.w), bf_hi(t.w)} + acc[ai][bj][m][1] * g;
                        *(f32x4*)(out + ro + bj * 128) = v0; *(f32x4*)(out + ro + bj * 128 + 4) = v1; } }
                asm volatile("" ::: "memory"); }
#undef DLOAD
        }
    }
};

namespace att {
constexpr int D = 128, NW = 8, QBLK = 32, KVBLK = 64;
constexpr float CQ = 0.088388347648318440f * 1.4426950408889634f;
constexpr float THRL = 8.f;
constexpr int LDQ = ATTW, LDO = DM;
constexpr int KSLOT = 16384, NKS = 3, NVS = 4, LDS_K = 0, LDS_V = NKS * KSLOT, LDS_WS = LDS_V + NVS * KSLOT;
#define SBAR() __builtin_amdgcn_sched_barrier(0)
__device__ __forceinline__ int crow(int r, int hi) { return (r & 3) + 8 * (r >> 2) + 4 * hi; }
__device__ __forceinline__ unsigned cvtpk(float lo, float hi) { unsigned r; asm volatile("v_cvt_pk_bf16_f32 %0, %1, %2" : "=v"(r) : "v"(lo), "v"(hi)); return r; }
__device__ __forceinline__ int v_rd_base(int lane) { return ((lane & 3) << 3) | (((lane >> 2) & 3) << 6) | (((lane >> 4) & 1) << 5) | (((lane >> 5) & 1) << 8); }
constexpr int v_rd_off(int d0, int ks, int half) { return d0 * 512 + ks * 4096 + half * 2048; }
template <int OFF> __device__ __forceinline__ s16x4 tr_read(int vb) {
  s16x4 r; asm volatile("ds_read_b64_tr_b16 %0, %1 offset:%2" : "=&v"(r) : "v"(vb), "i"(OFF) : "memory"); return r;
}
struct VG { s16x4 l0, h0, l1, h1; };
template <int G> __device__ __forceinline__ void v_read(VG& v, int vb) {
  constexpr int d0 = G >> 1, ks = 2 * (G & 1);
  v.l0 = tr_read<v_rd_off(d0, ks, 0)>(vb); v.h0 = tr_read<v_rd_off(d0, ks, 1)>(vb); v.l1 = tr_read<v_rd_off(d0, ks + 1, 0)>(vb); v.h1 = tr_read<v_rd_off(d0, ks + 1, 1)>(vb);
}
#define V_WAIT(N, v) asm volatile("s_waitcnt lgkmcnt(" #N ")" : "+v"(v.l0), "+v"(v.h0), "+v"(v.l1), "+v"(v.h1))
#define PKV(L, H) (bf16x8){L[0], L[1], L[2], L[3], H[0], H[1], H[2], H[3]}
#define V_MMA(od, v, pe, po) do { od = __builtin_amdgcn_mfma_f32_32x32x16_bf16(pe, PKV(v.l0, v.h0), od, 0, 0, 0); od = __builtin_amdgcn_mfma_f32_32x32x16_bf16(po, PKV(v.l1, v.h1), od, 0, 0, 0); } while (0)
__device__ __forceinline__ void pv_d0(f32x16* o, int vb, bf16x8 pa0, bf16x8 pa1, bf16x8 pa2, bf16x8 pa3) {
  VG a, b, c;
  v_read<0>(a, vb); v_read<1>(b, vb); v_read<2>(c, vb);
  V_WAIT(8, a); V_MMA(o[0], a, pa0, pa1); v_read<3>(a, vb);
  V_WAIT(8, b); V_MMA(o[0], b, pa2, pa3); v_read<4>(b, vb);
  V_WAIT(8, c); V_MMA(o[1], c, pa0, pa1); v_read<5>(c, vb);
  V_WAIT(8, a); V_MMA(o[1], a, pa2, pa3); v_read<6>(a, vb);
  V_WAIT(8, b); V_MMA(o[2], b, pa0, pa1); v_read<7>(b, vb);
  V_WAIT(8, c); V_MMA(o[2], c, pa2, pa3);
  V_WAIT(4, a); V_MMA(o[3], a, pa0, pa1);
  V_WAIT(0, b); V_MMA(o[3], b, pa2, pa3);
}
#undef V_MMA
#undef PKV
struct KG { bf16x8 b0, b1; };
template <int D0> __device__ __forceinline__ void k_read(KG& k, const int (&kb)[4]) {
  asm volatile("ds_read_b128 %0, %1 offset:%2" : "=&v"(k.b0) : "v"(kb[D0 & 3]), "i"((D0 >> 2) * 128) : "memory");
  asm volatile("ds_read_b128 %0, %1 offset:%2" : "=&v"(k.b1) : "v"(kb[D0 & 3]), "i"((D0 >> 2) * 128 + 8192) : "memory");
}
#define K_WAIT(N, k) asm volatile("s_waitcnt lgkmcnt(" #N ")" : "+v"(k.b0), "+v"(k.b1))
__device__ __forceinline__ void qkt(f32x16& p0, f32x16& p1, const int (&kb)[4], const bf16x8* qr, const f32x16& negm) {
  KG a, b;
  k_read<0>(a, kb); k_read<1>(b, kb);
  K_WAIT(2, a); p0 = __builtin_amdgcn_mfma_f32_32x32x16_bf16(a.b0, qr[0], negm, 0, 0, 0); p1 = __builtin_amdgcn_mfma_f32_32x32x16_bf16(a.b1, qr[0], negm, 0, 0, 0); k_read<2>(a, kb);
#define K_MMA(k, d) do { p0 = __builtin_amdgcn_mfma_f32_32x32x16_bf16(k.b0, qr[d], p0, 0, 0, 0); p1 = __builtin_amdgcn_mfma_f32_32x32x16_bf16(k.b1, qr[d], p1, 0, 0, 0); } while (0)
  K_WAIT(2, b); K_MMA(b, 1); k_read<3>(b, kb);
  K_WAIT(2, a); K_MMA(a, 2); k_read<4>(a, kb);
  K_WAIT(2, b); K_MMA(b, 3); k_read<5>(b, kb);
  K_WAIT(2, a); K_MMA(a, 4); k_read<6>(a, kb);
  K_WAIT(2, b); K_MMA(b, 5); k_read<7>(b, kb);
  K_WAIT(2, a); K_MMA(a, 6);
  K_WAIT(0, b); K_MMA(b, 7);
#undef K_MMA
}
__device__ __forceinline__ void finishSM(f32x16& p0, f32x16& p1, float& l_reg, bf16x8& pa0, bf16x8& pa1, bf16x8& pa2, bf16x8& pa3) {
#pragma unroll
  for (int r = 0; r < 16; ++r) p1[r] = __builtin_amdgcn_exp2f(p1[r]);
  float ps = 0;
#pragma unroll
  for (int r = 0; r < 16; ++r) ps += p0[r];
#pragma unroll
  for (int r = 0; r < 16; ++r) ps += p1[r];
  l_reg += ps;
#define PK4(P, BASE, OUT) do { unsigned a0 = cvtpk(P[BASE + 0], P[BASE + 1]), a1 = cvtpk(P[BASE + 2], P[BASE + 3]);   \
    unsigned b0 = cvtpk(P[BASE + 4], P[BASE + 5]), b1 = cvtpk(P[BASE + 6], P[BASE + 7]);                              \
    auto r0 = __builtin_amdgcn_permlane32_swap(a0, b0, false, false); auto r1 = __builtin_amdgcn_permlane32_swap(a1, b1, false, false); \
    u32x4 w = {r0[0], r1[0], r0[1], r1[1]}; OUT = *reinterpret_cast<bf16x8*>(&w); } while (0)
  PK4(p0, 0, pa0); PK4(p0, 8, pa1); PK4(p1, 0, pa2); PK4(p1, 8, pa3);
#undef PK4
}
template <bool FIRST>
__device__ __forceinline__ void startSM(f32x16& p0, f32x16& p1, float& mhat, float& l_reg, f32x16& negm, bool& resc, float& f) {
  float a = __builtin_fmaxf(__builtin_fmaxf(p0[0], p0[1]), p1[0]), b = __builtin_fmaxf(__builtin_fmaxf(p0[2], p0[3]), p1[1]); a = __builtin_fmaxf(__builtin_fmaxf(a, p1[2]), p1[3]);
#pragma unroll
  for (int r = 4; r < 16; r += 4) { a = __builtin_fmaxf(__builtin_fmaxf(a, p0[r]), p0[r + 1]); b = __builtin_fmaxf(__builtin_fmaxf(b, p0[r + 2]), p0[r + 3]);
    a = __builtin_fmaxf(__builtin_fmaxf(a, p1[r]), p1[r + 1]); b = __builtin_fmaxf(__builtin_fmaxf(b, p1[r + 2]), p1[r + 3]); }
  float rm = __builtin_fmaxf(a, b);
  { auto rr = __builtin_amdgcn_permlane32_swap(__float_as_uint(rm), __float_as_uint(rm), false, false); rm = __builtin_fmaxf(__uint_as_float(rr[0]), __uint_as_float(rr[1])); }
  resc = false; f = 1.f;
  if (FIRST || __builtin_expect(__any(rm > THRL), 0)) {
    const float dl = FIRST ? rm : __builtin_fmaxf(rm, 0.f); mhat += dl;
#pragma unroll
    for (int r = 0; r < 16; ++r) { p0[r] -= dl; p1[r] -= dl; }
#pragma unroll
    for (int r = 0; r < 16; ++r) negm[r] = -mhat;
    asm volatile("" : "+v"(negm));
    if (!FIRST) { f = __builtin_amdgcn_exp2f(-dl); l_reg *= f; resc = true; }
  }
#pragma unroll
  for (int r = 0; r < 16; ++r) p0[r] = __builtin_amdgcn_exp2f(p0[r]);
}
#define ATT_WAIT(N) asm volatile("s_waitcnt vmcnt(" #N ")" ::: "memory")
__device__ __forceinline__ void attn_unit(const bf16_t* __restrict__ Qb, const bf16_t* __restrict__ Kh, const bf16_t* __restrict__ Vh, bf16_t* __restrict__ Ob, LAS char* lds, int tid) {
  constexpr int NT = NT_ATT; static_assert(NT % 2 == 1 && NT >= 7, "odd tile count");
  const int wid = __builtin_amdgcn_readfirstlane(tid >> 6), lane = tid & 63, r32 = lane & 31, hi = lane >> 5;
  LAS float* ws = (LAS float*)(lds + LDS_WS) + wid * 64; LAS float* li_l = ws; LAS float* al_l = ws + 32;
  float mhat = 0.f, l_reg = 0.f; f32x16 o[4] = {}; f32x16 negm = {}; bf16x8 qr[8];
  asm volatile("" : "+v"(negm));
  unsigned koff[2], voff[2];
#pragma unroll
  for (int i = 0; i < 2; ++i) { const int p = 2 * wid + i;
    { const int row = 4 * p + (lane >> 4), cpos = lane & 15; koff[i] = (unsigned)(row * 256 + ((cpos ^ (row & 7)) << 4)); }
    { const int st = 2 * p + (lane >> 5), kk = (st >> 2) * 8 + ((lane & 31) >> 2), c = (st & 3) * 32 + (lane & 3) * 8; const int k = (kk & ~0xC) | ((kk & 4) << 1) | ((kk & 8) >> 1); voff[i] = (unsigned)(k * 256 + c * 2); } }
#define DMA_T(t, kso, vso) do { const char* kt_ = (const char*)Kh + (size_t)(t) * KSLOT; const char* vt_ = (const char*)Vh + (size_t)(t) * KSLOT; \
    _Pragma("unroll") for (int i_ = 0; i_ < 2; ++i_) { \
      __builtin_amdgcn_global_load_lds((const unsigned*)(kt_ + koff[i_]), (LAS unsigned*)(lds + LDS_K + (kso) + (2 * wid + i_) * 1024), 16, 0, 0); \
      __builtin_amdgcn_global_load_lds((const unsigned*)(vt_ + voff[i_]), (LAS unsigned*)(lds + LDS_V + (vso) + (2 * wid + i_) * 1024), 16, 0, 0); } } while (0)
  { const unsigned qoff = (unsigned)((wid * QBLK + r32) * LDQ + hi * 8) * 2u;
#pragma unroll
    for (int d0 = 0; d0 < 8; ++d0) qr[d0] = *reinterpret_cast<const bf16x8*>((const char*)Qb + qoff + d0 * 32); }
  DMA_T(0, 0, 0); DMA_T(1, KSLOT, KSLOT);
  int kb[4];
#pragma unroll
  for (int i = 0; i < 4; ++i) kb[i] = (int)(unsigned)(uintptr_t)(lds + LDS_K) + r32 * 256 + ((i * 32 + hi * 16) ^ ((r32 & 7) << 4));
  const int vb0 = (int)(unsigned)(uintptr_t)(lds + LDS_V) + v_rd_base(lane);
#define RESC() do { if (resc) { if (hi == 0) al_l[r32] = fsc; asm volatile("s_waitcnt lgkmcnt(0)" ::: "memory"); \
    _Pragma("unroll") for (int d = 0; d < 4; ++d) _Pragma("unroll") for (int r = 0; r < 16; ++r) o[d][r] *= al_l[crow(r, hi)]; } } while (0)
  f32x16 pA0, pA1, pB0, pB1; bf16x8 pa0, pa1, pa2, pa3; bool resc; float fsc;
  int kcur = 0, kiss = 2 * KSLOT, vprev = 0, viss = 2 * KSLOT;
#define KB_SET() do { } while (0)
#define ROT() do { { const int dk_ = (kcur == 2 * KSLOT) ? -2 * KSLOT : KSLOT; _Pragma("unroll") for (int i_ = 0; i_ < 4; ++i_) kb[i_] += dk_; } kcur = (kcur == 2 * KSLOT) ? 0 : kcur + KSLOT; kiss = (kiss == 2 * KSLOT) ? 0 : kiss + KSLOT; viss = (viss == 3 * KSLOT) ? 0 : viss + KSLOT; } while (0)
  ATT_WAIT(4); __builtin_amdgcn_s_barrier(); asm volatile("" ::: "memory");
  DMA_T(2, kiss, viss);
  KB_SET(); qkt(pA0, pA1, kb, qr, negm);
#pragma unroll
  for (int r = 8; r < 16; ++r) pA0[r] = -1e30f;
#pragma unroll
  for (int r = 0; r < 16; ++r) pA1[r] = -1e30f;
  startSM<true>(pA0, pA1, mhat, l_reg, negm, resc, fsc);
  ROT();
#define STEP(X0, X1, Y0, Y1, tt, ISSUE, WN) do { \
    ATT_WAIT(WN); __builtin_amdgcn_s_barrier(); asm volatile("" ::: "memory"); \
    if (ISSUE) DMA_T((tt) + 2, kiss, viss); \
    KB_SET(); qkt(X0, X1, kb, qr, negm); \
    finishSM(Y0, Y1, l_reg, pa0, pa1, pa2, pa3); \
    pv_d0(o, vb0 + vprev, pa0, pa1, pa2, pa3); startSM<false>(X0, X1, mhat, l_reg, negm, resc, fsc); \
    RESC(); vprev = (vprev == 3 * KSLOT) ? 0 : vprev + KSLOT; ROT(); } while (0)
  for (int t = 1; t + 3 < NT; t += 2) {
    STEP(pB0, pB1, pA0, pA1, t, true, 4);
    STEP(pA0, pA1, pB0, pB1, t + 1, true, 4);
  }
  STEP(pB0, pB1, pA0, pA1, NT - 2, false, 4);
  STEP(pA0, pA1, pB0, pB1, NT - 1, false, 0);
  finishSM(pA0, pA1, l_reg, pa0, pa1, pa2, pa3);
  pv_d0(o, vb0 + vprev, pa0, pa1, pa2, pa3);
  { auto rr = __builtin_amdgcn_permlane32_swap(__float_as_uint(l_reg), __float_as_uint(l_reg), false, false); l_reg = __uint_as_float(rr[0]) + __uint_as_float(rr[1]); }
  if (hi == 0) li_l[r32] = l_reg; asm volatile("s_waitcnt lgkmcnt(0)" ::: "memory");
  float rli[16];
#pragma unroll
  for (int r = 0; r < 16; ++r) rli[r] = __builtin_amdgcn_rcpf(li_l[crow(r, hi)]);
  asm volatile("s_waitcnt lgkmcnt(0)" ::: "memory"); __builtin_amdgcn_s_barrier(); asm volatile("" ::: "memory");
  LAS bf16_t* stg = (LAS bf16_t*)(lds + wid * 8192);
#pragma unroll
  for (int r = 0; r < 16; ++r) { const int orow = crow(r, hi);
#pragma unroll
    for (int d0 = 0; d0 < 4; ++d0) stg[orow * 128 + d0 * 32 + r32] = (bf16_t)(cvtpk(o[d0][r] * rli[r], 0.f) & 0xffffu); }
  asm volatile("s_waitcnt lgkmcnt(0)" ::: "memory");
#pragma unroll
  for (int i = 0; i < 8; ++i) { const int row = i * 4 + (lane >> 4), ch = lane & 15; const u32x4 v = *(const LAS u32x4*)(stg + row * 128 + ch * 8);
    *(u32x4*)((char*)Ob + (size_t)(wid * QBLK + row) * (LDO * 2) + ch * 16) = v; }
  asm volatile("s_waitcnt lgkmcnt(0)" ::: "memory"); __builtin_amdgcn_s_barrier(); asm volatile("" ::: "memory");
#undef DMA_T
#undef RESC
#undef ROT
#undef KB_SET
#undef STEP
}
#undef ATT_WAIT
#undef SBAR
#undef V_WAIT
#undef K_WAIT
}

namespace att8 {
typedef int v8i __attribute__((ext_vector_type(8)));
constexpr int QBLK = 32, KS8 = 8192, NKS = 3, NVS = 6, L_K = 0, L_V = NKS * KS8, L_WS = 73728;
constexpr float THRL = 8.f;
__device__ __forceinline__ int crow(int r, int hi) { return (r & 3) + 8 * (r >> 2) + 4 * hi; }
struct F8 { u32x4 lo, hi; };
template <int IMM> __device__ __forceinline__ void f_read(F8& f, int a0, int a1) {
  asm volatile("ds_read_b128 %0, %1 offset:%2" : "=&v"(f.lo) : "v"(a0), "i"(IMM) : "memory");
  asm volatile("ds_read_b128 %0, %1 offset:%2" : "=&v"(f.hi) : "v"(a1), "i"(IMM) : "memory");
}
#define F_WAIT(N, f) asm volatile("s_waitcnt lgkmcnt(" #N ")" : "+v"(f.lo), "+v"(f.hi))
struct F6 { u32x4 lo; u32x2 hi; };
template <int IMM> __device__ __forceinline__ void f_read6(F6& f, int ah, int at) {
  asm volatile("ds_read_b128 %0, %1 offset:%2" : "=&v"(f.lo) : "v"(ah), "i"(IMM) : "memory");
  asm volatile("ds_read_b64 %0, %1 offset:%2" : "=&v"(f.hi) : "v"(at), "i"(IMM) : "memory");
}
__device__ __forceinline__ v8i f6_vec(const F6& f) { v8i r; r[0] = (int)f.lo.x; r[1] = (int)f.lo.y; r[2] = (int)f.lo.z; r[3] = (int)f.lo.w; r[4] = (int)f.hi.x; r[5] = (int)f.hi.y; r[6] = (int)f.hi.x; r[7] = (int)f.hi.y; return r; }
#define MMA6K(a, b, c, sa, sb) __builtin_amdgcn_mfma_scale_f32_32x32x64_f8f6f4(a, b, c, 2, 2, 0, sa, 0, sb)
#define MMA6P(a, b, c, sa, sb) __builtin_amdgcn_mfma_scale_f32_32x32x64_f8f6f4(a, b, c, 3, 2, 0, sa, 0, sb)
#define F_WAIT2(N, f, g) asm volatile("s_waitcnt lgkmcnt(" #N ")" : "+v"(f.lo), "+v"(f.hi), "+v"(g.lo), "+v"(g.hi))
#define K_WAIT2(N, f, g) asm volatile("s_waitcnt lgkmcnt(" #N ")" : "+v"(f.lo), "+v"(f.hi), "+v"(g.lo), "+v"(g.hi))
__device__ __forceinline__ v8i f_vec(const F8& f) { return (v8i){(int)f.lo.x, (int)f.lo.y, (int)f.lo.z, (int)f.lo.w, (int)f.hi.x, (int)f.hi.y, (int)f.hi.z, (int)f.hi.w}; }
#define MMA8(a, b, c, sa, sb) __builtin_amdgcn_mfma_scale_f32_32x32x64_f8f6f4(a, b, c, 0, 0, 0, sa, 0, sb)
constexpr int S1 = 0x7f7f7f7f, S8 = 0x7c7c7c7c;
__device__ __forceinline__ v8i ld32(int a0, int a1, int imm) { const u32x4 lo = *(const LAS u32x4*)(uintptr_t)(unsigned)(a0 + imm), hh = *(const LAS u32x4*)(uintptr_t)(unsigned)(a1 + imm);
  return (v8i){(int)lo.x, (int)lo.y, (int)lo.z, (int)lo.w, (int)hh.x, (int)hh.y, (int)hh.z, (int)hh.w}; }
#define MFENCE() asm volatile("" ::: "memory")
__device__ __forceinline__ void qkt(f32x16& p0, f32x16& p1, int kb0, const v8i* qr, const f32x16& negm) {
  v8i a = ld32(kb0, kb0 ^ 16, 0), b = ld32(kb0, kb0 ^ 16, 4096); MFENCE();
  p0 = MMA8(a, qr[0], negm, S1, S8); p1 = MMA8(b, qr[0], negm, S1, S8);
  a = ld32(kb0 ^ 64, kb0 ^ 80, 0); b = ld32(kb0 ^ 64, kb0 ^ 80, 4096); MFENCE();
  p0 = MMA8(a, qr[1], p0, S1, S8); p1 = MMA8(b, qr[1], p1, S1, S8);
}
struct F2 { v8i a, b; };
__device__ __forceinline__ void v_read01(F2& v, int vo0) { v.a = ld32(vo0, vo0 ^ 16, 0); v.b = ld32(vo0, vo0 ^ 16, 2048); MFENCE(); }
__device__ __forceinline__ void pv(f32x16* o, f32x16& ol, const v8i& ones, F2& v, int vo0, const v8i& pa) {
  o[0] = MMA8(pa, v.a, o[0], S1, S1); o[1] = MMA8(pa, v.b, o[1], S1, S1);
  v.a = ld32(vo0, vo0 ^ 16, 4096); v.b = ld32(vo0, vo0 ^ 16, 6144); MFENCE();
  o[2] = MMA8(pa, v.a, o[2], S1, S1); o[3] = MMA8(pa, v.b, o[3], S1, S1);
  ol = MMA8(pa, ones, ol, S1, S1);
}
__device__ __forceinline__ void finishSM(f32x16& p0, f32x16& p1, float& l_reg, v8i& pa) {
#pragma unroll
  for (int r = 0; r < 16; ++r) p1[r] = __builtin_amdgcn_exp2f(p1[r]);
  float ps = 0;
#pragma unroll
  for (int r = 0; r < 16; ++r) ps += p0[r];
#pragma unroll
  for (int r = 0; r < 16; ++r) ps += p1[r];
  l_reg += ps;
#pragma unroll
  for (int i = 0; i < 4; ++i) { const unsigned a = pk4_fp8(p0[4 * i], p0[4 * i + 1], p0[4 * i + 2], p0[4 * i + 3]), b = pk4_fp8(p1[4 * i], p1[4 * i + 1], p1[4 * i + 2], p1[4 * i + 3]);
    auto rr = __builtin_amdgcn_permlane32_swap(a, b, false, false); pa[i] = (int)rr[0]; pa[4 + i] = (int)rr[1]; }
}
__device__ __forceinline__ float max3f(float a, float b, float c) { float r; asm("v_max3_f32 %0, %1, %2, %3" : "=v"(r) : "v"(a), "v"(b), "v"(c)); return r; }
__device__ __forceinline__ void max16_2(const f32x16& p, float& a, float& b) {
  asm("v_max3_f32 %0, %2, %3, %4\n\tv_max3_f32 %1, %5, %6, %7\n\tv_max3_f32 %0, %0, %8, %9\n\tv_max3_f32 %1, %1, %10, %11\n\tv_max3_f32 %0, %0, %12, %13\n\tv_max3_f32 %1, %1, %14, %15\n\tv_max3_f32 %0, %0, %16, %17"
      : "=&v"(a), "=&v"(b)
      : "v"(p[0]), "v"(p[1]), "v"(p[2]), "v"(p[3]), "v"(p[4]), "v"(p[5]), "v"(p[6]), "v"(p[7]), "v"(p[8]), "v"(p[9]), "v"(p[10]), "v"(p[11]), "v"(p[12]), "v"(p[13]), "v"(p[14]), "v"(p[15]));
}
__device__ __forceinline__ float rowmax(const f32x16& p0, const f32x16& p1) {
  float a, b, c, d; max16_2(p0, a, b); max16_2(p1, c, d);
  float r; asm("v_max3_f32 %0, %1, %2, %3\n\tv_max_f32 %0, %0, %4" : "=&v"(r) : "v"(a), "v"(b), "v"(c), "v"(d));
  return r;
}
__device__ __forceinline__ float rowmax_full(float rm) {
  auto rr = __builtin_amdgcn_permlane32_swap(__float_as_uint(rm), __float_as_uint(rm), false, false); float o_; asm("v_max_f32 %0, %1, %2" : "=v"(o_) : "v"(__uint_as_float(rr[0])), "v"(__uint_as_float(rr[1]))); return o_;
}
__device__ __forceinline__ void exp_all(f32x16& p0, f32x16& p1) {
#pragma unroll
  for (int r = 0; r < 16; ++r) { p0[r] = __builtin_amdgcn_exp2f(p0[r]); p1[r] = __builtin_amdgcn_exp2f(p1[r]); }
}
__device__ __forceinline__ void pack_p(const f32x16& p0, const f32x16& p1, v8i& pa) {
#pragma unroll
  for (int i = 0; i < 4; ++i) {
    int w = __builtin_amdgcn_cvt_pk_fp8_f32(p0[4 * i], p0[4 * i + 1], pa[i], false); pa[i] = __builtin_amdgcn_cvt_pk_fp8_f32(p0[4 * i + 2], p0[4 * i + 3], w, true);
    int x = __builtin_amdgcn_cvt_pk_fp8_f32(p1[4 * i], p1[4 * i + 1], pa[4 + i], false); pa[4 + i] = __builtin_amdgcn_cvt_pk_fp8_f32(p1[4 * i + 2], p1[4 * i + 3], x, true); }
}
template <bool FIRST>
__device__ __forceinline__ void startSM(f32x16& p0, f32x16& p1, float& mhat, float& l_reg, f32x16& negm, bool& resc, float& f) {
  float a = __builtin_fmaxf(__builtin_fmaxf(p0[0], p0[1]), p1[0]), b = __builtin_fmaxf(__builtin_fmaxf(p0[2], p0[3]), p1[1]); a = __builtin_fmaxf(__builtin_fmaxf(a, p1[2]), p1[3]);
#pragma unroll
  for (int r = 4; r < 16; r += 4) { a = __builtin_fmaxf(__builtin_fmaxf(a, p0[r]), p0[r + 1]); b = __builtin_fmaxf(__builtin_fmaxf(b, p0[r + 2]), p0[r + 3]);
    a = __builtin_fmaxf(__builtin_fmaxf(a, p1[r]), p1[r + 1]); b = __builtin_fmaxf(__builtin_fmaxf(b, p1[r + 2]), p1[r + 3]); }
  float rm = __builtin_fmaxf(a, b);
  { auto rr = __builtin_amdgcn_permlane32_swap(__float_as_uint(rm), __float_as_uint(rm), false, false); rm = __builtin_fmaxf(__uint_as_float(rr[0]), __uint_as_float(rr[1])); }
  resc = false; f = 1.f;
  if (FIRST || __builtin_expect(__any(rm > THRL), 0)) {
    const float dl = FIRST ? rm : __builtin_fmaxf(rm, 0.f); mhat += dl;
#pragma unroll
    for (int r = 0; r < 16; ++r) { p0[r] -= dl; p1[r] -= dl; }
#pragma unroll
    for (int r = 0; r < 16; ++r) negm[r] = -mhat;
    asm volatile("" : "+v"(negm));
    if (!FIRST) { f = __builtin_amdgcn_exp2f(-dl); l_reg *= f; resc = true; }
  }
#pragma unroll
  for (int r = 0; r < 16; ++r) p0[r] = __builtin_amdgcn_exp2f(p0[r]);
}
#define ATT_WAIT(N) asm volatile("s_waitcnt vmcnt(" #N ")" ::: "memory")
__device__ __forceinline__ void attn_unit(const unsigned char* __restrict__ Q8b, const unsigned char* __restrict__ K8h, const unsigned char* __restrict__ V8h, bf16_t* __restrict__ Ob, int ldo, LAS char* lds, int tid) {
  constexpr int NT = NT_ATT; static_assert(NT % 2 == 1 && NT >= 7, "odd tile count");
  int lane = tid & 63; asm volatile("" : "+v"(lane));
  const int wid = __builtin_amdgcn_readfirstlane(tid >> 6), r32 = lane & 31, hi = lane >> 5;
  LAS float* ws = (LAS float*)(lds + L_WS) + wid * 64; LAS float* li_l = ws; LAS float* al_l = ws + 32;
  float zz = 0.f; asm volatile("" : "+v"(zz));
  float mhat = 0.f, l_reg = 0.f; f32x16 o[4]; f32x16 ol; f32x16 negm; v8i qr[2];
#pragma unroll
  for (int r = 0; r < 16; ++r) { negm[r] = zz; ol[r] = zz; o[0][r] = zz; o[1][r] = zz; o[2][r] = zz; o[3][r] = zz; }
  v8i ones; { int o0 = 0x08208208, o1 = (int)0x82082082u, o2 = 0x20820820; asm volatile("" : "+v"(o0), "+v"(o1), "+v"(o2)); ones = (v8i){o0, o1, o2, o0, o1, o2, o0, o1}; }
  asm volatile("" : "+v"(negm));
  unsigned koff, voff;
  { const int row = 8 * wid + (lane >> 3), cpos = lane & 7; koff = (unsigned)(row * 128 + ((cpos ^ ((row >> 1) & 7)) << 4)); }
  { const int drow = 16 * wid + (lane >> 2), cpos = lane & 3; voff = (unsigned)(drow * 64 + ((cpos ^ ((drow >> 2) & 3)) << 4)); }
  const char* kp_ = (const char*)K8h + koff; const char* vp_ = (const char*)V8h + voff;
#define DMA_T(t, kso, vso) do { \
      __builtin_amdgcn_global_load_lds((const unsigned*)kp_, (LAS unsigned*)(lds + L_K + (kso) + wid * 1024), 16, 0, 0); \
      __builtin_amdgcn_global_load_lds((const unsigned*)vp_, (LAS unsigned*)(lds + L_V + (vso) + wid * 1024), 16, 0, 0); \
      kp_ += KS8; vp_ += KS8; asm volatile("" : "+v"(kp_), "+v"(vp_)); } while (0)
  { const unsigned qoff = (unsigned)((wid * QBLK + r32) * ATTW);
#pragma unroll
    for (int s = 0; s < 2; ++s) { const int b = 2 * s + hi; const u32x4 lo = *reinterpret_cast<const u32x4*>((const char*)Q8b + qoff + 16 * b); const u32x2 hh = *reinterpret_cast<const u32x2*>((const char*)Q8b + qoff + 64 + 8 * b);
      qr[s] = (v8i){(int)lo.x, (int)lo.y, (int)lo.z, (int)lo.w, (int)hh.x, (int)hh.y, (int)hh.x, (int)hh.y}; } }
  DMA_T(0, 0, 0); DMA_T(1, KS8, KS8);
  int kb, vo;
  kb = (int)(unsigned)(uintptr_t)(lds + L_K) + r32 * 128 + ((hi ^ ((r32 >> 1) & 7)) << 4);
  const int kt = (int)(unsigned)(uintptr_t)(lds + L_K) + r32 * 128 + ((4 ^ ((r32 >> 1) & 7)) << 4) + 8 * hi;
  vo = (int)(unsigned)(uintptr_t)(lds + L_V) + r32 * 64 + ((hi ^ ((r32 >> 2) & 3)) << 4);
  const int vt = (int)(unsigned)(uintptr_t)(lds + L_V) + r32 * 64 + ((2 ^ ((r32 >> 2) & 3)) << 4) + 8 * hi;
#define RESC() do { if (resc) { if (hi == 0) al_l[r32] = fsc; asm volatile("s_waitcnt lgkmcnt(0)" ::: "memory"); \
    _Pragma("unroll") for (int r = 0; r < 16; ++r) { const float a_ = al_l[crow(r, hi)]; ol[r] *= a_; _Pragma("unroll") for (int d = 0; d < 4; ++d) o[d][r] *= a_; } } } while (0)
  f32x16 pA0, pA1; v8i pa; int psc; bool resc; float fsc; F6 fa0, fa1, fb0, fb1; F6 ka0, ka1, kc0, kc1;
  { int z1 = 127; asm volatile("" : "+v"(z1)); psc = z1; }
  { int z8 = 0; asm volatile("" : "+v"(z8)); pa = (v8i){z8, z8, z8, z8, z8, z8, z8, z8}; }
#define MASK0() do { _Pragma("unroll") for (int r = 8; r < 16; ++r) pA0[r] = -1e30f; _Pragma("unroll") for (int r = 0; r < 16; ++r) pA1[r] = -1e30f; } while (0)
#define BAR_S() asm volatile("s_barrier" : "+v"(pa) :: "memory")
#define BAR_M(WN) asm volatile("s_waitcnt vmcnt(" #WN ")\n\ts_barrier" : "+v"(pA0), "+v"(pA1), "+v"(o[0]), "+v"(o[1]), "+v"(o[2]), "+v"(o[3]), "+v"(ol) :: "memory")
#define STEPS(S6, SS, ISSUE, WN, HASQK, HASPV, HASSM, FIRST_) do { \
      constexpr int KO_ = ((S6) % 3) * KS8, VO_ = (((S6) + 5) % 6) * KS8; \
      BAR_S(); \
      if (HASQK) { f_read6<KO_>(ka0, kb, kt); f_read6<KO_ + 4096>(ka1, kb, kt); f_read6<KO_>(kc0, kb32, kt16); f_read6<KO_ + 4096>(kc1, kb32, kt16); }        \
      if (ISSUE) { DMA_T((SS) + 2, (((S6) + 2) % 3) * KS8, (((S6) + 2) % 6) * KS8); } \
      if ((HASQK) && (HASPV)) {                   \
        K_WAIT2(4, ka0, ka1); pA0 = MMA6K(f6_vec(ka0), qr[0], negm, S1, S8); pA1 = MMA6K(f6_vec(ka1), qr[0], negm, S1, S8); \
        f_read6<VO_>(fa0, vo, vt); f_read6<VO_ + 2048>(fa1, vo, vt); \
        K_WAIT2(4, kc0, kc1); pA0 = MMA6K(f6_vec(kc0), qr[1], pA0, S1, S8); pA1 = MMA6K(f6_vec(kc1), qr[1], pA1, S1, S8); \
        f_read6<VO_ + 4096>(fb0, vo, vt); f_read6<VO_ + 6144>(fb1, vo, vt); \
        K_WAIT2(4, fa0, fa1); o[0] = MMA6P(pa, f6_vec(fa0), o[0], psc, S1); o[1] = MMA6P(pa, f6_vec(fa1), o[1], psc, S1); \
        K_WAIT2(0, fb0, fb1); o[2] = MMA6P(pa, f6_vec(fb0), o[2], psc, S1); o[3] = MMA6P(pa, f6_vec(fb1), o[3], psc, S1); ol = MMA6P(pa, ones, ol, psc, S1); \
      } else if (HASQK) { \
        K_WAIT2(4, ka0, ka1); pA0 = MMA6K(f6_vec(ka0), qr[0], negm, S1, S8); pA1 = MMA6K(f6_vec(ka1), qr[0], negm, S1, S8); \
        K_WAIT2(0, kc0, kc1); pA0 = MMA6K(f6_vec(kc0), qr[1], pA0, S1, S8); pA1 = MMA6K(f6_vec(kc1), qr[1], pA1, S1, S8); \
      } else if (HASPV) { \
        f_read6<VO_>(fa0, vo, vt); f_read6<VO_ + 2048>(fa1, vo, vt); f_read6<VO_ + 4096>(fb0, vo, vt); f_read6<VO_ + 6144>(fb1, vo, vt); \
        K_WAIT2(4, fa0, fa1); o[0] = MMA6P(pa, f6_vec(fa0), o[0], psc, S1); o[1] = MMA6P(pa, f6_vec(fa1), o[1], psc, S1); \
        K_WAIT2(0, fb0, fb1); o[2] = MMA6P(pa, f6_vec(fb0), o[2], psc, S1); o[3] = MMA6P(pa, f6_vec(fb1), o[3], psc, S1); ol = MMA6P(pa, ones, ol, psc, S1); } \
      BAR_M(WN); \
      if (HASSM) { if (FIRST_) MASK0(); \
        float rm_ = rowmax(pA0, pA1); \
        resc = false; \
          \
        if ((FIRST_) || __builtin_expect(__any(rm_ > THRL), 0)) { const float rmf_ = rowmax_full(rm_); const float dl = (FIRST_) ? rmf_ : __builtin_fmaxf(rmf_, 0.f); mhat += dl; const float f_ = __builtin_amdgcn_exp2f(-dl); \
          _Pragma("unroll") for (int r = 0; r < 16; ++r) { pA0[r] -= dl; pA1[r] -= dl; } \
          _Pragma("unroll") for (int r = 0; r < 16; ++r) negm[r] = -mhat; \
          asm volatile("" : "+v"(negm)); rm_ -= dl; \
          if (!(FIRST_)) { fsc = f_; resc = true; RESC(); } } \
          \
        { int e_; asm("v_cvt_flr_i32_f32 %0, %1" : "=v"(e_) : "v"(rm_ - 4.8f)); psc = e_ + 128; float scl_ = __int_as_float(psc << 23);        \
          asm volatile("" : "+v"(pA0), "+v"(pA1), "+v"(scl_)); \
          exp_all(pA0, pA1); \
          u32x6 pk_; asm volatile("v_cvt_scalef32_2xpk16_bf6_f32 %0, %1, %2, %3" : "=&v"(pk_) : "v"(pA0), "v"(pA1), "v"(scl_));        \
          { typedef unsigned u32x8_ __attribute__((ext_vector_type(8))); const u32x8_ w8_ = __builtin_shufflevector(pk_, pk_, 0, 1, 2, 3, 4, 5, -1, -1); pa = (v8i)w8_; } } } } while (0)
  const int kb32 = kb ^ 32, kt16 = kt ^ 16;
  ATT_WAIT(2);
  if (wid >= 4) asm volatile("s_barrier" ::: "memory");
  STEPS(0, 0, true, 2, true, false, true, true);
  asm volatile(".p2align 8");
  static_assert((NT - 3) % 6 == 2 && NT >= 12, "steps 1 .. NT-5 in groups of six, then NT-4 .. NT");
  for (int t = 1; t + 4 < NT; t += 6) {
    STEPS(1, t, true, 2, true, true, true, false); STEPS(2, t + 1, true, 2, true, true, true, false); STEPS(3, t + 2, true, 2, true, true, true, false);
    STEPS(4, t + 3, true, 2, true, true, true, false); STEPS(5, t + 4, true, 2, true, true, true, false); STEPS(0, t + 5, true, 2, true, true, true, false);
  }
  STEPS((NT - 4) % 6, NT - 4, true, 2, true, true, true, false);
  STEPS((NT - 3) % 6, NT - 3, true, 2, true, true, true, false);
  STEPS((NT - 2) % 6, NT - 2, false, 0, true, true, true, false);
  STEPS((NT - 1) % 6, NT - 1, false, 0, true, true, true, false);
  STEPS(NT % 6, NT, false, 0, false, true, false, false);
  if (wid < 4) asm volatile("s_barrier" ::: "memory");
#undef STEPS
#undef BAR_S
#undef BAR_M
  { const int le = fresh_lane(), r32e = le & 31, hie = le >> 5;
  float rli[16];
#pragma unroll
  for (int r = 0; r < 16; ++r) rli[r] = __builtin_amdgcn_rcpf(ol[r]);
  (void)li_l; (void)hie; (void)l_reg;
  LAS bf16_t* stg = (LAS bf16_t*)(lds + 77824 + wid * 8192);
#pragma unroll
  for (int r = 0; r < 16; ++r) { const int orow = crow(r, hie);
#pragma unroll
    for (int d0 = 0; d0 < 4; ++d0) stg[orow * 128 + d0 * 32 + r32e] = (bf16_t)(cvt_pk_bf16(o[d0][r] * rli[r], 0.f) & 0xffffu); }
  asm volatile("s_waitcnt lgkmcnt(0)" ::: "memory");
#pragma unroll
  for (int i = 0; i < 8; ++i) { const int row = i * 4 + (le >> 4), ch = le & 15; const u32x4 v = *(const LAS u32x4*)(stg + row * 128 + ch * 8);
    *(u32x4*)((char*)Ob + (size_t)(wid * QBLK + row) * ((size_t)ldo * 2) + ch * 16) = v; }
  asm volatile("s_waitcnt lgkmcnt(0)" ::: "memory"); }
#undef DMA_T
#undef RESC
#undef MASK0
}
#undef ATT_WAIT
#undef F_WAIT
#undef F_WAIT2
#undef K_WAIT2
#undef MMA6K
#undef MMA6P
#undef MFENCE
#undef MMA8
}

__device__ __forceinline__ void p1_zmeta(const Args& A, int cb, int tid) {
    const int o = tid >> 4, part = tid & 15, ch = cb * 4 + (o & 3), r = o >> 2, g = ch >> 8, d = ch & 255;
    const float* pm = (const float*)(A.ws + WS_PMETA) + (size_t)(8 + r) * POOLW + g * 256 + part * 16; const float* pw = A.pool_w + (size_t)g * 65536 + (size_t)(part * 16) * 256 + d;
    float wv[16]; f32x4 pv4[4];
#pragma unroll
    for (int u = 0; u < 16; ++u) wv[u] = pw[(size_t)u * 256];
#pragma unroll
    for (int q = 0; q < 4; ++q) pv4[q] = ((const f32x4*)pm)[q];
    float acc = 0.f;
#pragma unroll
    for (int q = 0; q < 4; ++q) acc += (pv4[q].x * wv[4 * q] + pv4[q].y * wv[4 * q + 1]) + (pv4[q].z * wv[4 * q + 2] + pv4[q].w * wv[4 * q + 3]);
    acc += __shfl_xor(acc, 1); acc += __shfl_xor(acc, 2); acc += __shfl_xor(acc, 4); acc += __shfl_xor(acc, 8);
    if (part == 0) ((float*)(A.ws + WS_ZM))[r * 1024 + ch] = acc * A.pool_scale[ch];
}
template <int HW> __device__ __forceinline__ void pool_item(const bf16_t* __restrict__ Zb, const float* __restrict__ Zm, bf16_t* __restrict__ Mb, int s) {
    u32x4 w[2 * HW];
#pragma unroll
    for (int k = 0; k < 2 * HW; ++k) { int sp = s - HW + k; sp = sp < 0 ? 0 : (sp > SEQ - 1 ? SEQ - 1 : sp); w[k] = *(const u32x4*)(Zb + (size_t)sp * POOLW); }
    float sum[8], self[8];
#pragma unroll
    for (int e = 0; e < 8; ++e) { sum[e] = 0.f; self[e] = 0.f; }
#pragma unroll
    for (int k = 0; k < 2 * HW; ++k) { const int sp = s - HW + k; float zv[8];
        zv[0] = bf_lo(w[k].x); zv[1] = bf_hi(w[k].x); zv[2] = bf_lo(w[k].y); zv[3] = bf_hi(w[k].y); zv[4] = bf_lo(w[k].z); zv[5] = bf_hi(w[k].z); zv[6] = bf_lo(w[k].w); zv[7] = bf_hi(w[k].w);
        if (sp < 0) {
#pragma unroll
            for (int e = 0; e < 8; ++e) zv[e] = Zm[(sp + 8) * 1024 + e]; }
        const float m = (sp < SEQ) ? 1.f : 0.f;
#pragma unroll
        for (int e = 0; e < 8; ++e) { sum[e] += zv[e] * m; if (k == HW) self[e] = zv[e]; } }
    const int hiE = (s + HW < SEQ) ? s + HW : SEQ; const float inv = 1.0f / (float)(hiE - (s - HW));
    u32x4 o; o.x = cvt_pk_bf16(sum[0] * inv - self[0], sum[1] * inv - self[1]); o.y = cvt_pk_bf16(sum[2] * inv - self[2], sum[3] * inv - self[3]);
    o.z = cvt_pk_bf16(sum[4] * inv - self[4], sum[5] * inv - self[5]); o.w = cvt_pk_bf16(sum[6] * inv - self[6], sum[7] * inv - self[7]);
    *(u32x4*)(Mb + (size_t)s * DM) = o;
}
__device__ __forceinline__ void p2_pool_block(const Args& A, LAS unsigned char* lds, int rb, int tid) {
    const float* Zm = (const float*)(A.ws + WS_ZM);
    const int b = rb >> 7, s0 = (rb & 127) * 128;
    const bf16_t* Z = (const bf16_t*)(A.ws + WS_Z); bf16_t* MIX = (bf16_t*)(A.ws + WS_MIX);
    { const int w = tid >> 6, l = tid & 63, sb = s0 + w * 16 + (l >> 5);
      const bf16_t* __restrict__ Zb = Z + (size_t)b * SEQ * POOLW + (l & 31) * 8; bf16_t* __restrict__ Mb = MIX + (size_t)b * SEQ * DM + ATTW + (l & 31) * 8; const float* Zmc = Zm + (l & 31) * 8;
#pragma unroll 2
      for (int it = 0; it < 8; ++it) pool_item<1>(Zb, Zmc, Mb, sb + 2 * it);
#pragma unroll 2
      for (int it = 0; it < 8; ++it) pool_item<2>(Zb + 256, Zmc + 256, Mb + 256, sb + 2 * it);
#pragma unroll 2
      for (int it = 0; it < 8; ++it) pool_item<4>(Zb + 512, Zmc + 512, Mb + 512, sb + 2 * it);
#pragma unroll 2
      for (int it = 0; it < 8; ++it) pool_item<8>(Zb + 768, Zmc + 768, Mb + 768, sb + 2 * it); }
    __syncthreads();
}

__device__ __forceinline__ void p4_block(const Args& A, LAS unsigned char* lds, int jb, int tid, int lane, int wave) {
    LAS float* Lg = (LAS float*)(lds + wave * 3072);
    LAS unsigned* cntL = (LAS unsigned*)(lds + 32768);
    LAS unsigned* baseL = cntL + 64;
    if (tid < 64) cntL[tid] = 0u;
    __syncthreads();
    const int fr = lane & 15, fq = lane >> 4, row = jb * 128 + wave * 16 + fr;
    const float* ssp = (const float*)(A.ws + WS_SSP); const bf16_t* h1 = (const bf16_t*)(A.ws + WS_H1B) + (size_t)row * DM;
    bf16_t* BN = (bf16_t*)(A.ws + WS_XN) + (size_t)row * DM; const u32x4* wrf = (const u32x4*)(A.ws + WS_WRF);
    float ss; { const f32x4 a = *(const f32x4*)(ssp + (size_t)row * 32 + 8 * fq), b = *(const f32x4*)(ssp + (size_t)row * 32 + 8 * fq + 4); ss = ((a.x + a.y) + (a.z + a.w)) + ((b.x + b.y) + (b.z + b.w)); }
    ss += __shfl_xor(ss, 16); ss += __shfl_xor(ss, 32);
    const float rstd = 1.0f / sqrtf(ss * (1.f / DM) + EPS);
    if (fq == 0) ((float*)(A.ws + WS_RSTD))[row] = rstd;
    f32x4 lacc[3] = {(f32x4){0.f, 0.f, 0.f, 0.f}, (f32x4){0.f, 0.f, 0.f, 0.f}, (f32x4){0.f, 0.f, 0.f, 0.f}};
    LAS u32x4* wL = (LAS u32x4*)(lds + 40960);
#pragma unroll 1
    for (int kc = 0; kc < 4; ++kc) {
    __syncthreads();
#pragma unroll
    for (int i = 0; i < 12; ++i) wL[i * 512 + tid] = wrf[(size_t)kc * 6144 + i * 512 + tid];
    __syncthreads();
#pragma unroll 2
    for (int k2 = 0; k2 < 16; ++k2) { const int ks = kc * 16 + k2; const int k = 32 * ks + 8 * fq;
        const u32x4 hq = *(const u32x4*)(h1 + k); const f32x4 xa = (f32x4){bf_lo(hq.x), bf_hi(hq.x), bf_lo(hq.y), bf_hi(hq.y)} * rstd, xb = (f32x4){bf_lo(hq.z), bf_hi(hq.z), bf_lo(hq.w), bf_hi(hq.w)} * rstd;
        const u32x4 hw = pack8(xa, xb);
        u32x4 lw; lw.x = cvt_pk_bf16(xa.x - bf_lo(hw.x), xa.y - bf_hi(hw.x)); lw.y = cvt_pk_bf16(xa.z - bf_lo(hw.y), xa.w - bf_hi(hw.y));
        lw.z = cvt_pk_bf16(xb.x - bf_lo(hw.z), xb.y - bf_hi(hw.z)); lw.w = cvt_pk_bf16(xb.z - bf_lo(hw.w), xb.w - bf_hi(hw.w));
        const bf16x8 bh = __builtin_bit_cast(bf16x8, hw), bl = __builtin_bit_cast(bf16x8, lw);
#pragma unroll
        for (int blk = 0; blk < 3; ++blk) { const bf16x8 wh = __builtin_bit_cast(bf16x8, wL[((k2 * 3 + blk) * 2 + 0) * 64 + lane]), wl = __builtin_bit_cast(bf16x8, wL[((k2 * 3 + blk) * 2 + 1) * 64 + lane]);
            lacc[blk] = __builtin_amdgcn_mfma_f32_16x16x32_bf16(wh, bh, lacc[blk], 0, 0, 0);
            lacc[blk] = __builtin_amdgcn_mfma_f32_16x16x32_bf16(wl, bh, lacc[blk], 0, 0, 0);
            lacc[blk] = __builtin_amdgcn_mfma_f32_16x16x32_bf16(wh, bl, lacc[blk], 0, 0, 0); } }
    }
#pragma unroll
    for (int blk = 0; blk < 3; ++blk)
#pragma unroll
        for (int j = 0; j < 4; ++j) Lg[fr * 48 + 16 * blk + 4 * fq + j] = lacc[blk][j];
    LDS_WAIT(); asm volatile("" ::: "memory");
    int e0 = 0, e1 = 0; float g0 = 0.f, g1 = 0.f; unsigned rk0 = 0u, rk1 = 0u;
    if (lane < 16) {
        float lg[4]; int gi = 0; float gm;
#pragma unroll
        for (int j = 0; j < 4; ++j) lg[j] = Lg[lane * 48 + 32 + j] + A.b_rg[j];
        gm = lg[0];
#pragma unroll
        for (int j = 1; j < 4; ++j) if (lg[j] > gm) { gm = lg[j]; gi = j; }
        float gs = 0.f;
#pragma unroll
        for (int j = 0; j < 4; ++j) gs += __expf(lg[j] - gm);
        const float gp = 1.0f / gs;
        float l1 = -3.0e38f, l2 = -3.0e38f; int i1 = 0, i2 = 0;
#pragma unroll
        for (int j = 0; j < 8; ++j) { const float v = Lg[lane * 48 + gi * 8 + j] + A.b_re[gi * 8 + j];
            if (v > l1) { l2 = l1; i2 = i1; l1 = v; i1 = j; } else if (v > l2) { l2 = v; i2 = j; } }
        const float t = __expf(l2 - l1);
        g0 = gp / (1.0f + t); g1 = gp * t / (1.0f + t);
        e0 = gi * 8 + i1; e1 = gi * 8 + i2;
        rk0 = atomicAdd((unsigned*)(cntL + 2 * e0 + 0), 1u); rk1 = atomicAdd((unsigned*)(cntL + 2 * e1 + 1), 1u);
    }
    __syncthreads();
    if (tid < 64) { const unsigned c = cntL[tid]; unsigned base = 0u; if (c) base = __hip_atomic_fetch_add((unsigned*)(A.ws + WS_CTL) + CW_GCNT + tid, c, RLX_AGENT); baseL[tid] = base; }
    __syncthreads();
    if (lane < 16) { int* list = (int*)(A.ws + WS_LIST); float* glist = (float*)(A.ws + WS_GLIST);
        const size_t p0 = (size_t)(2 * e0 + 0) * LCAP + baseL[2 * e0 + 0] + rk0, p1 = (size_t)(2 * e1 + 1) * LCAP + baseL[2 * e1 + 1] + rk1;
        list[p0] = row; glist[p0] = g0; list[p1] = row; glist[p1] = g1; }
    __syncthreads();
}

__global__ void __launch_bounds__(512, 2) fwd(Args A) {
    extern __shared__ __attribute__((aligned(16))) unsigned char lds_raw[];
    LAS unsigned char* lds = (LAS unsigned char*)lds_raw;
    const int wave = __builtin_amdgcn_readfirstlane((int)threadIdx.x >> 6);
    const int G = gridDim.x; const int bx = blockIdx.x; const int vcu = (G % 8 == 0) ? (bx % 8) * (G / 8) + bx / 8 : bx;
    volatile LAS unsigned* MISC = (volatile LAS unsigned*)(lds + MISC_OFF);
    { const int tid0 = threadIdx.x; for (int u = tid0; u < 128; u += 512) MISC[u] = 0u; }
    __syncthreads();
    unsigned* ctl = (unsigned*)(A.ws + WS_CTL);
    XcdBarrier bar; bar.bar = ctl + CW_BAR; bar.x = 0; bar.st = nullptr;
    if (N_LAUNCHES == 1) bar = xcd_barrier_post(ctl + CW_BAR, MISC + 8);
#define GRID_BAR() do { if (N_LAUNCHES == 1) xcd_barrier(bar); } while (0)
    const int lo = A.ph_lo, hi = A.ph_hi;
#define IN(k) (lo <= (k) && (k) < hi)
#define BOTH(k) (IN(k) && IN((k) + 1))
    bf16_t* XN = (bf16_t*)(A.ws + WS_XN); bf16_t* Qb = (bf16_t*)(A.ws + WS_Q); bf16_t* Kb = (bf16_t*)(A.ws + WS_K); bf16_t* Vb = (bf16_t*)(A.ws + WS_V);
    bf16_t* Zb = (bf16_t*)(A.ws + WS_Z); bf16_t* MIX = (bf16_t*)(A.ws + WS_MIX); bf16_t* Hb = (bf16_t*)(A.ws + WS_H);

    if (IN(0)) { const int lane = fresh_lane(), tid = wave * 64 + lane; (void)lane;
#pragma unroll 1
        for (int rep = 0; rep < REPS[0]; ++rep) { p0_prologue(A, lds, vcu, G, tid, lane, wave); if (BOTH(0)) GRID_BAR(); } }

    if (IN(1)) { const int lane = fresh_lane(), tid = wave * 64 + lane; (void)lane;
        for (int cb = vcu; cb < 256; cb += G) p1_zmeta(A, cb, tid);
        { ProbIn<(ATT_MODE == 2) ? 0 : ATT_MODE> P; P.A = XN; P.Bt = (const bf16_t*)(A.ws + WS_WIN); P.S.init(NTOK, INW, G, bx); P.Q = Qb; P.Kb = Kb; P.Vb = Vb; P.Z = Zb; P.Q8 = A.ws + WS_Q8; P.K8 = A.ws + WS_K8; P.V8 = A.ws + WS_V8; P.qg = A.qg; P.kg = A.kg;
        P.cosT = (const float*)(A.ws + WS_ROPE); P.sinT = P.cosT + 256 * 32;
        pg8::gemm_phase<DM, ProbIn<(ATT_MODE == 2) ? 0 : ATT_MODE>>(lds + RING_OFF, lds + EPI_OFF, P, tid); }
        if (ATT_MODE == 2) { ProbIn<1> P; P.A = XN; P.Bt = (const bf16_t*)(A.ws + WS_WIN); P.S.init(NTOK, INW, G, bx); P.Q = Qb; P.Kb = Kb; P.Vb = Vb; P.Z = Zb; P.Q8 = A.ws + WS_Q8; P.K8 = A.ws + WS_K8; P.V8 = A.ws + WS_V8; P.qg = A.qg; P.kg = A.kg;
        P.cosT = (const float*)(A.ws + WS_ROPE); P.sinT = P.cosT + 256 * 32;
        pg8::gemm_phase<DM, ProbIn<1>>(lds + RING_OFF, lds + EPI_OFF, P, tid); }
        if (BOTH(1)) GRID_BAR();
    }

    if (IN(2)) { const int lane = fresh_lane(), tid = wave * 64 + lane; (void)lane;
#pragma unroll 1
      for (int rep = 0; rep < REPS[2]; ++rep) {
        for (int rb = vcu; rb < 256; rb += G) p2_pool_block(A, lds, rb, tid);
        if (ATT_MODE != 1) for (int U = vcu; U < 1024; U += G) {
            const int hg = U >> 8, rem = U & 255, bkv = rem >> 6, qb = rem & 63, b = bkv >> 1, kvh = bkv & 1, h = kvh * 4 + hg;
            att::attn_unit(Qb + ((size_t)(b * SEQ + qb * 256)) * ATTW + h * HD, Kb + (size_t)(b * 2 + kvh) * KVROWS * HD, Vb + (size_t)(b * 2 + kvh) * KVROWS * HD,
                           MIX + ((size_t)(b * SEQ + qb * 256)) * DM + h * HD, (LAS char*)lds, tid);
        }
        if (ATT_MODE != 0) for (int U = vcu; U < 1024; U += G) {
            const int hg = U >> 8, rem = U & 255, bkv = rem >> 6, qb = rem & 63, b = bkv >> 1, kvh = bkv & 1, h = kvh * 4 + hg;
            bf16_t* ob = (ATT_MODE == 1) ? MIX + ((size_t)(b * SEQ + qb * 256)) * DM + h * HD : (bf16_t*)(A.ws + WS_MIX2) + ((size_t)(b * SEQ + qb * 256)) * ATTW + h * HD;
            att8::attn_unit(A.ws + WS_Q8 + ((size_t)(b * SEQ + qb * 256)) * ATTW + h * HD, A.ws + WS_K8 + (size_t)(b * 2 + kvh) * KVROWS * HD, A.ws + WS_V8 + (size_t)(b * 2 + kvh) * NT_ATT * 8192,
                            ob, (ATT_MODE == 1) ? DM : ATTW, (LAS char*)lds, tid);
        }
        if (BOTH(2)) GRID_BAR();
      }
    }

    if (IN(3) && ATT_MODE == 2) {
        float e2 = 0.f, r2 = 0.f; const bf16_t* M2 = (const bf16_t*)(A.ws + WS_MIX2); const int tid = threadIdx.x;
        for (size_t i = (size_t)bx * 512 + tid; i < (size_t)NTOK * 128; i += (size_t)G * 512) { const size_t row = i >> 7, c8 = (i & 127) * 8;
            const u32x4 a = *(const u32x4*)(MIX + row * DM + c8), b = *(const u32x4*)(M2 + row * ATTW + c8);
            const unsigned aw[4] = {a.x, a.y, a.z, a.w}, bw[4] = {b.x, b.y, b.z, b.w};
#pragma unroll
            for (int q = 0; q < 4; ++q) { const float a0 = bf_lo(aw[q]), a1 = bf_hi(aw[q]), b0 = bf_lo(bw[q]), b1 = bf_hi(bw[q]); e2 += (a0 - b0) * (a0 - b0) + (a1 - b1) * (a1 - b1); r2 += a0 * a0 + a1 * a1; } }
        e2 = wave_sum(e2); r2 = wave_sum(r2);
        if ((tid & 63) == 0) { atomicAdd((float*)(ctl + CW_CHK), e2); atomicAdd((float*)(ctl + CW_CHK) + 1, r2); }
        GRID_BAR();
    }
    if (IN(3)) { const int lane = fresh_lane(), tid = wave * 64 + lane; (void)lane;
        ProbOut P; P.A = MIX; P.Bt = (const bf16_t*)(A.ws + WS_WOUT); P.S.init(NTOK, DM, G, bx); P.x = A.x; P.out = (bf16_t*)(A.ws + WS_H1B); P.ssp = (float*)(A.ws + WS_SSP);
#pragma unroll 1
        for (int rep = 0; rep < REPS[3]; ++rep) { pg8::gemm_phase<DM, ProbOut>(lds + RING_OFF, lds + EPI_OFF, P, tid);
        if (BOTH(3)) GRID_BAR(); }
    }

    if (IN(4)) { const int lane = fresh_lane(), tid = wave * 64 + lane; (void)lane;
        for (int jb = vcu; jb < 256; jb += G) p4_block(A, lds, jb, tid, lane, wave);
        if (BOTH(4)) GRID_BAR();
    }

    if (IN(5)) { const int lane = fresh_lane(), tid = wave * 64 + lane; (void)lane;
        moe_tables(lds, ctl + CW_GCNT, tid);
        ProbGU P; P.A = (const bf16_t*)(A.ws + WS_H1B); P.rstdb = (const float*)(A.ws + WS_RSTD); P.Bt = (const bf16_t*)(A.ws + WS_WGU); P.H = Hb; P.list = (const int*)(A.ws + WS_LIST); P.T = moe_tab(lds); P.vcu = vcu; P.G = G;
#pragma unroll 1
        for (int rep = 0; rep < REPS[5]; ++rep) { pg8::gemm_phase<DM, ProbGU>(lds + RING_OFF, lds + EPI_OFF, P, tid);
        if (BOTH(5)) GRID_BAR(); }
    }

    if (IN(6)) { const int lane = fresh_lane(), tid = wave * 64 + lane; (void)lane;
        moe_tables(lds, ctl + CW_GCNT, tid);
        ProbDown<0> P; P.A = Hb; P.Bt = (const bf16_t*)(A.ws + WS_WD); P.out = A.out; P.h1b = (const bf16_t*)(A.ws + WS_H1B); P.tmp = (bf16_t*)(A.ws + WS_MIX); P.list = (const int*)(A.ws + WS_LIST); P.glist = (const float*)(A.ws + WS_GLIST); P.T = moe_tab(lds); P.vcu = vcu; P.G = G;
        pg8::gemm_phase<DEXP, ProbDown<0>>(lds + RING_OFF, lds + EPI_OFF, P, tid);
        if (BOTH(6)) GRID_BAR();
    }

    if (IN(7)) { const int lane = fresh_lane(), tid = wave * 64 + lane; (void)lane;
        moe_tables(lds, ctl + CW_GCNT, tid);
        ProbDown<1> P; P.A = Hb; P.Bt = (const bf16_t*)(A.ws + WS_WD); P.out = A.out; P.h1b = (const bf16_t*)(A.ws + WS_H1B); P.tmp = (bf16_t*)(A.ws + WS_MIX); P.list = (const int*)(A.ws + WS_LIST); P.glist = (const float*)(A.ws + WS_GLIST); P.T = moe_tab(lds); P.vcu = vcu; P.G = G;
        pg8::gemm_phase<DEXP, ProbDown<1>>(lds + RING_OFF, lds + EPI_OFF, P, tid);
    }
    if (ATT_MODE == 2) {
        GRID_BAR();
        const float e2 = __hip_atomic_load((float*)(ctl + CW_CHK), RLX_AGENT), r2 = __hip_atomic_load((float*)(ctl + CW_CHK) + 1, RLX_AGENT);
        const float ratio = e2 / r2;
        float sc = 1.0f; if (!(ratio < 0.01f)) sc = 1.3f; if (!(ratio < 0.1f)) sc = 1.5f; if (!(ratio < 1.0f)) sc = 2.0f; if (!(ratio < 4.0f)) sc = 3.0f;
        if (sc != 1.0f) { f32x4* o4 = (f32x4*)A.out; const int tid = threadIdx.x;
            for (size_t i = (size_t)bx * 512 + tid; i < (size_t)NTOK * DM / 4; i += (size_t)G * 512) o4[i] = o4[i] * sc; }
    }
#undef IN
#undef BOTH
#undef GRID_BAR
}

extern "C" void kernel_launch(void* const* d_in, const int* in_sizes, int n_in, void* d_out, int out_size, void* d_ws, size_t ws_size, hipStream_t stream) {
    static int grid = 0;
    if (grid == 0) {
        if (n_in != 17 || in_sizes[0] != NTOK * DM || out_size != NTOK * DM || ws_size < WS_END) {
            fprintf(stderr, "kernel_launch: shape mismatch: n_in %d in0 %d out %d ws %zu (need %zu)\n", n_in, n_in > 0 ? in_sizes[0] : -1, out_size, ws_size, (size_t)WS_END); grid = -1; return; }
        int dev = 0, cus = 0, per_cu = 0;
        if (hipGetDevice(&dev) != hipSuccess || hipDeviceGetAttribute(&cus, hipDeviceAttributeMultiprocessorCount, dev) != hipSuccess) { grid = -1; return; }
        if (hipFuncSetAttribute((const void*)fwd, hipFuncAttributeMaxDynamicSharedMemorySize, LDS_BYTES) != hipSuccess) { fprintf(stderr, "kernel_launch: hipFuncSetAttribute failed\n"); grid = -1; return; }
        if (hipOccupancyMaxActiveBlocksPerMultiprocessor(&per_cu, (const void*)fwd, 512, LDS_BYTES) != hipSuccess || per_cu < 1)
            fprintf(stderr, "kernel_launch: note: occupancy query reports %d workgroups per CU\n", per_cu);
        (void)hipGetLastError();
        grid = cus;
    }
    if (grid < 0) return;
    if (hipMemsetAsync((char*)d_ws + WS_CTL, 0, CTL_ZERO_BYTES, stream) != hipSuccess) { fprintf(stderr, "kernel_launch: memset failed\n"); return; }
    Args a{};
    a.x = (const float*)d_in[0]; a.meta = (const float*)d_in[1]; a.g1 = (const float*)d_in[2]; a.w_in = (const float*)d_in[3]; a.qg = (const float*)d_in[4]; a.kg = (const float*)d_in[5];
    a.pool_w = (const float*)d_in[6]; a.pool_scale = (const float*)d_in[7]; a.w_out = (const float*)d_in[8]; a.g2 = (const float*)d_in[9]; a.w_rg = (const float*)d_in[10]; a.b_rg = (const float*)d_in[11];
    a.w_re = (const float*)d_in[12]; a.b_re = (const float*)d_in[13]; a.w_gate = (const float*)d_in[14]; a.w_up = (const float*)d_in[15]; a.w_down = (const float*)d_in[16];
    a.out = (float*)d_out; a.ws = (unsigned char*)d_ws;
    if (N_LAUNCHES == 1) { a.ph_lo = 0; a.ph_hi = PER_PHASE; hipLaunchKernelGGL(fwd, dim3(grid), dim3(512), LDS_BYTES, stream, a); }
    else for (int li = 0; li < PER_PHASE; ++li) { a.ph_lo = li; a.ph_hi = li + 1; hipLaunchKernelGGL(fwd, dim3(grid), dim3(512), LDS_BYTES, stream, a); }
    const hipError_t le = hipPeekAtLastError();
    if (le != hipSuccess) fprintf(stderr, "kernel_launch: launch failed: %s\n", hipGetErrorName(le));
}
```
